# Optimizing an MI355X kernel written in HIP

```python
import math
import jax, jax.numpy as jnp
from jax import lax
import numpy as np

D_MODEL = 1024
BATCH = 4
SEQ = 4096
DEPTH = 4
DEC_BATCH = 128
DEC_SEQ = 4
PAST_LEN = 2048
PAGE_SIZE = 128

N_A_LAYERS = DEPTH // 2
N_B_LAYERS = DEPTH - N_A_LAYERS
NORM_EPS = 1e-6
DN_HEADS = 8
DN_HEAD_K = D_MODEL // DN_HEADS
DN_HEAD_V = D_MODEL // DN_HEADS
DN_KEY_DIM = DN_HEADS * DN_HEAD_K
DN_VAL_DIM = DN_HEADS * DN_HEAD_V
DN_QKV_DIM = 2 * DN_KEY_DIM + DN_VAL_DIM
DN_IN_DIM = DN_QKV_DIM + DN_VAL_DIM + 2 * DN_HEADS
DN_CONV = 4
DN_CHUNK = 64
NSA_HEADS = 16
NSA_HEAD_DIM = D_MODEL // NSA_HEADS
NSA_DIM = NSA_HEADS * NSA_HEAD_DIM
NSA_KV_HEADS = 4
NSA_GROUP = NSA_HEADS // NSA_KV_HEADS
NSA_IN_DIM = NSA_DIM + 3 * NSA_HEADS
NSA_KV_DIM = 6 * NSA_KV_HEADS * NSA_HEAD_DIM
CMP_STRIDE = 16
CMP_BLOCK = 2 * CMP_STRIDE
SEL_BLOCK = 64
N_SEL = 16
WINDOW = 512
Q_BLOCK = 128
REL_BUCKETS = 32
REL_MAX_EXACT = REL_BUCKETS // 2
REL_MAX_DIST = 1024
D_FF = ((8 * D_MODEL + 3 * 256 - 1) // (3 * 256)) * 256

kernel_name = 'yoco_gdn_nsa_decoder_step'


def rmsnorm(x, w):
    xf = x.astype(jnp.float32)
    y = xf * lax.rsqrt(jnp.mean(xf * xf, axis=-1, keepdims=True) + NORM_EPS)
    return y.astype(x.dtype) * w


def l2norm(x):
    xf = x.astype(jnp.float32)
    return xf * lax.rsqrt(jnp.sum(xf * xf, axis=-1, keepdims=True) + NORM_EPS)


def swiglu_ffn(h, w_in, w_out):
    gate, up = jnp.split(h @ w_in, 2, axis=-1)
    return (jax.nn.silu(gate) * up) @ w_out


def causal_short_conv(x, buf, w):
    t = x.shape[1]
    xp = jnp.concatenate([buf.astype(x.dtype), x], axis=1)
    y = xp[:, 0:t] * w[0]
    for i in range(1, DN_CONV):
        y = y + xp[:, i:i + t] * w[i]
    return jax.nn.silu(y), xp[:, xp.shape[1] - (DN_CONV - 1):]


def gated_delta_rule(q, k, v, g, beta, S0):
    B_, T, H, DK = q.shape
    DV = v.shape[-1]
    C = math.gcd(T, DN_CHUNK)
    N = T // C

    def to_chunks(a):
        return jnp.swapaxes(a.reshape((B_, N, C) + a.shape[2:]), 2, 3)

    qc, kc, vc, gc, bc = to_chunks(q), to_chunks(k), to_chunks(v), to_chunks(g), to_chunks(beta)
    G = jnp.cumsum(gc, axis=-1)
    ii = jnp.arange(C)
    strict = ii[:, None] > ii[None, :]
    incl = ii[:, None] >= ii[None, :]
    diff = G[..., :, None] - G[..., None, :]
    dec = jnp.where(incl, jnp.exp(jnp.where(incl, diff, 0.0)), 0.0)
    kk = jnp.einsum('bnhid,bnhjd->bnhij', kc, kc)
    A = jnp.where(strict, bc[..., :, None] * dec * kk, 0.0)
    L = A + jnp.eye(C, dtype=A.dtype)
    eG = jnp.exp(G)
    wv = lax.linalg.triangular_solve(L, bc[..., None] * vc, left_side=True, lower=True, unit_diagonal=True)
    wk = lax.linalg.triangular_solve(L, (bc * eG)[..., None] * kc, left_side=True, lower=True, unit_diagonal=True)
    aqk = dec * jnp.einsum('bnhid,bnhjd->bnhij', qc, kc)
    qg = eG[..., None] * qc
    kdec = jnp.exp(G[..., -1:] - G)[..., None] * kc
    glast = jnp.exp(G[..., -1])
    xs = tuple(jnp.swapaxes(a, 0, 1) for a in (wv, wk, aqk, qg, kdec, glast))

    def step(S, xc):
        wv_n, wk_n, aqk_n, qg_n, kdec_n, gl_n = xc
        U = wv_n - jnp.einsum('bhik,bhkv->bhiv', wk_n, S)
        O = jnp.einsum('bhik,bhkv->bhiv', qg_n, S) + jnp.einsum('bhij,bhjv->bhiv', aqk_n, U)
        S = gl_n[..., None, None] * S + jnp.einsum('bhik,bhiv->bhkv', kdec_n, U)
        return S, O

    S_fin, O = lax.scan(step, S0, xs)
    O = O.transpose(1, 0, 3, 2, 4).reshape(B_, T, H, DV)
    return O, S_fin


def deltanet_mixer(h, conv_buf, S0, w_in, conv_w, A_log, dt_bias, out_norm, w_out):
    f32 = jnp.float32
    B_, T, _ = h.shape
    qkv, z, a, b = jnp.split(h @ w_in, [DN_QKV_DIM, DN_QKV_DIM + DN_VAL_DIM, DN_QKV_DIM + DN_VAL_DIM + DN_HEADS], axis=-1)
    qkv, new_buf = causal_short_conv(qkv, conv_buf, conv_w)
    q, k, v = jnp.split(qkv, [DN_KEY_DIM, 2 * DN_KEY_DIM], axis=-1)
    q = l2norm(q.reshape(B_, T, DN_HEADS, DN_HEAD_K)) * (DN_HEAD_K ** -0.5)
    k = l2norm(k.reshape(B_, T, DN_HEADS, DN_HEAD_K))
    v = v.reshape(B_, T, DN_HEADS, DN_HEAD_V).astype(f32)
    beta = jax.nn.sigmoid(b.astype(f32))
    g = -jnp.exp(A_log.astype(f32)) * jax.nn.softplus(a.astype(f32) + dt_bias.astype(f32))
    o, S = gated_delta_rule(q, k, v, g, beta, S0.astype(f32))
    o = rmsnorm(o, out_norm) * jax.nn.silu(z.reshape(B_, T, DN_HEADS, DN_HEAD_V).astype(f32))
    return o.reshape(B_, T, DN_VAL_DIM).astype(h.dtype) @ w_out, new_buf, S


def shared_rows(x, norm_w, w_kv):
    B_, T, _ = x.shape
    return (rmsnorm(x, norm_w) @ w_kv).reshape(B_, T, 6, NSA_KV_HEADS, NSA_HEAD_DIM)


def nsa_context(hist, cmp_pos_w, w_cmp):
    B_, L = hist.shape[:2]
    L_pad = ((L + SEL_BLOCK - 1) // SEL_BLOCK) * SEL_BLOCK
    hist = jnp.pad(hist, ((0, 0), (0, L_pad - L), (0, 0), (0, 0), (0, 0)))
    n_sub = L_pad // CMP_STRIDE
    sub = hist[:, :, :2].reshape(B_, n_sub, CMP_STRIDE, 2, NSA_KV_HEADS, NSA_HEAD_DIM)
    lo = jnp.einsum('bmrckd,crkd->bmckd', sub, cmp_pos_w[:, :CMP_STRIDE])
    hi = jnp.einsum('bmrckd,crkd->bmckd', sub, cmp_pos_w[:, CMP_STRIDE:])
    blocks = lo[:, :-1] + hi[:, 1:]
    cmp = jnp.einsum('bnckd,ckde->bncke', blocks, w_cmp)
    cmp_end = jnp.arange(n_sub - 1, dtype=jnp.int32) * CMP_STRIDE + (CMP_BLOCK - 1)
    n_sel_blocks = L_pad // SEL_BLOCK
    sel = hist[:, :, 2:].reshape(B_, n_sel_blocks, SEL_BLOCK, 2, NSA_KV_HEADS, NSA_HEAD_DIM).transpose(3, 0, 4, 1, 2, 5)
    return (cmp[:, :, 0], cmp[:, :, 1], cmp_end, sel[0], sel[1])


def rel_bucket(dist):
    n = jnp.maximum(dist, 0)
    nf = jnp.maximum(n, 1).astype(jnp.float32)
    large = REL_MAX_EXACT + (jnp.log(nf / REL_MAX_EXACT) / math.log(REL_MAX_DIST / REL_MAX_EXACT) * (REL_BUCKETS - REL_MAX_EXACT)).astype(jnp.int32)
    large = jnp.minimum(large, REL_BUCKETS - 1)
    return jnp.where(n < REL_MAX_EXACT, n, large)


def masked_softmax(logits, mask):
    l = jnp.where(mask, logits.astype(jnp.float32), -1e30)
    m = jnp.max(l, axis=-1, keepdims=True)
    e = jnp.where(mask, jnp.exp(l - m), 0.0)
    return e / jnp.maximum(jnp.sum(e, axis=-1, keepdims=True), 1e-30)


def nsa_attend(q, gates, q_pos, k_cmp, v_cmp, cmp_end, k_sel, v_sel, k_win, v_win, w_pos, rel_bias):
    f32 = jnp.float32
    B_, Tq = q.shape[:2]
    table = rel_bias.astype(f32)
    qg = q.reshape(B_, Tq, NSA_KV_HEADS, NSA_GROUP, NSA_HEAD_DIM)
    d_c = q_pos[:, None] - cmp_end[None, :]
    bias_c = table[rel_bucket(d_c)].reshape(Tq, -1, NSA_KV_HEADS, NSA_GROUP).transpose(2, 3, 0, 1)
    p_c = masked_softmax(jnp.einsum('bqkgd,bckd->bkgqc', qg, k_cmp).astype(f32) + bias_c, d_c >= 0)
    o_cmp = jnp.einsum('bkgqc,bckd->bqkgd', p_c.astype(v_cmp.dtype), v_cmp)
    n_blocks = k_sel.shape[2]
    n_pick = min(N_SEL, n_blocks)
    imp = jnp.pad(jnp.sum(p_c, axis=2), ((0, 0), (0, 0), (0, 0), (0, 1)))
    cover = imp + jnp.pad(imp[..., :-1], ((0, 0), (0, 0), (0, 0), (1, 0)))
    p_slc = cover.reshape(B_, NSA_KV_HEADS, Tq, n_blocks, SEL_BLOCK // CMP_STRIDE).sum(-1)
    blk = jnp.arange(n_blocks, dtype=jnp.int32)[None, :]
    cur = (q_pos // SEL_BLOCK)[:, None]
    forced = (blk == 0) | (blk == cur) | (blk == cur - 1)
    valid = blk * SEL_BLOCK <= q_pos[:, None]
    score = jnp.where(forced, 1e4, jnp.where(valid, p_slc, -1.0))
    _, idx = lax.top_k(score, n_pick)
    b_ix = jnp.arange(B_)[:, None, None, None]
    h_ix = jnp.arange(NSA_KV_HEADS)[None, :, None, None]
    k_g = k_sel[b_ix, h_ix, idx]
    v_g = v_sel[b_ix, h_ix, idx]
    key_pos = idx[..., None] * SEL_BLOCK + jnp.arange(SEL_BLOCK, dtype=jnp.int32)
    d_s = q_pos[None, None, :, None, None] - key_pos
    bias_s = table.reshape(REL_BUCKETS, NSA_KV_HEADS, NSA_GROUP)[rel_bucket(d_s), h_ix[..., None]]
    bias_s = jnp.moveaxis(bias_s, -1, 3)
    l_s = jnp.einsum('bqkgd,bkqsrd->bkqgsr', qg, k_g).astype(f32) + bias_s
    n_keys = n_pick * SEL_BLOCK
    p_s = masked_softmax(l_s.reshape(B_, NSA_KV_HEADS, Tq, NSA_GROUP, n_keys),
                         (d_s >= 0).reshape(B_, NSA_KV_HEADS, Tq, 1, n_keys)).reshape(l_s.shape)
    o_sel = jnp.einsum('bkqgsr,bkqsrd->bqkgd', p_s.astype(v_g.dtype), v_g)
    d_w = q_pos[:, None] - w_pos[None, :]
    mask_w = (d_w >= 0) & (d_w < WINDOW) & (w_pos[None, :] >= 0)
    bias_w = table[rel_bucket(d_w)].reshape(Tq, -1, NSA_KV_HEADS, NSA_GROUP).transpose(2, 3, 0, 1)
    p_w = masked_softmax(jnp.einsum('bqkgd,bwkd->bkgqw', qg, k_win).astype(f32) + bias_w, mask_w)
    o_win = jnp.einsum('bkgqw,bwkd->bqkgd', p_w.astype(v_win.dtype), v_win)
    o = jnp.stack([o_cmp, o_sel, o_win], axis=-1).reshape(B_, Tq, NSA_HEADS, NSA_HEAD_DIM, 3)
    return jnp.einsum('bqhdr,bqhr->bqhd', o.astype(f32), gates)


def nsa_mixer(h, q_pos, ctx, kw, vw, w_pos, sweep, w_in, w_out, rel_bias):
    B_, T, _ = h.shape
    proj = h @ w_in
    q = proj[..., :NSA_DIM].reshape(B_, T, NSA_HEADS, NSA_HEAD_DIM) * (NSA_HEAD_DIM ** -0.5)
    gates = jax.nn.sigmoid(proj[..., NSA_DIM:].astype(jnp.float32)).reshape(B_, T, NSA_HEADS, 3)
    if sweep:
        qb = min(Q_BLOCK, T)
        nb = T // qb
        band = WINDOW + qb
        q_b = jnp.swapaxes(q.reshape(B_, nb, qb, NSA_HEADS, NSA_HEAD_DIM), 0, 1)
        g_b = jnp.swapaxes(gates.reshape(B_, nb, qb, NSA_HEADS, 3), 0, 1)
        starts = jnp.arange(nb, dtype=jnp.int32) * qb

        def one_block(args):
            qi, gi, s = args
            pos = s + jnp.arange(qb, dtype=jnp.int32)
            kwi = lax.dynamic_slice_in_dim(kw, s, band, axis=1)
            vwi = lax.dynamic_slice_in_dim(vw, s, band, axis=1)
            wpi = s - WINDOW + jnp.arange(band, dtype=jnp.int32)
            return nsa_attend(qi, gi, pos, ctx[0], ctx[1], ctx[2], ctx[3], ctx[4], kwi, vwi, wpi, rel_bias)

        o = jnp.swapaxes(lax.map(one_block, (q_b, g_b, starts)), 0, 1)
    else:
        o = nsa_attend(q, gates, q_pos, ctx[0], ctx[1], ctx[2], ctx[3], ctx[4], kw, vw, w_pos, rel_bias)
    return o.reshape(B_, T, NSA_DIM).astype(h.dtype) @ w_out


def run_trunk(x, dn_S0, dn_conv0, past_rows, win_prev, pos0, P):
    B_, T, _ = x.shape
    prompt = past_rows is None
    q_pos = pos0 + jnp.arange(T, dtype=jnp.int32)
    new_S, new_conv = [], []
    ctx = kw = vw = w_pos = kv_rows = new_win = None
    for l in range(DEPTH):
        h = rmsnorm(x, P['norm_mix'][l])
        if l < N_A_LAYERS:
            y, cb, S = deltanet_mixer(h, dn_conv0[l], dn_S0[l], P['dn_w_in'][l], P['dn_conv_w'][l], P['dn_A_log'][l],
                                      P['dn_dt_bias'][l], P['dn_out_norm'][l], P['dn_w_out'][l])
            new_S.append(S)
            new_conv.append(cb)
        else:
            j = l - N_A_LAYERS
            y = nsa_mixer(h, q_pos, ctx, kw, vw, w_pos, prompt, P['nsa_w_in'][j], P['nsa_w_out'][j], P['rel_bias'])
        x = x + y
        x = x + swiglu_ffn(rmsnorm(x, P['norm_ffn'][l]), P['ffn_w_in'][l], P['ffn_w_out'][l])
        if l == N_A_LAYERS - 1:
            rows = shared_rows(x, P['norm_kv'], P['nsa_w_kv'])
            kv_rows = rows[:, :, :4]
            if prompt:
                hist = kv_rows
                win_rows = rows[:, :, 4:]
                pad = ((0, 0), (WINDOW, 0), (0, 0), (0, 0))
                kw = jnp.pad(win_rows[:, :, 0], pad)
                vw = jnp.pad(win_rows[:, :, 1], pad)
                new_win = win_rows[:, T - min(WINDOW, T):]
            else:
                hist = jnp.concatenate([past_rows.astype(kv_rows.dtype), kv_rows], axis=1)
                buf = win_prev.shape[1]
                wb = jnp.concatenate([win_prev.astype(rows.dtype), rows[:, :, 4:]], axis=1)
                kw, vw = wb[:, :, 0], wb[:, :, 1]
                w_pos = pos0 - buf + jnp.arange(buf + T, dtype=jnp.int32)
                new_win = wb[:, T:]
            ctx = nsa_context(hist, P['nsa_cmp_pos_w'], P['nsa_w_cmp'])
    y = rmsnorm(x, P['norm_final'])
    return y, jnp.stack(new_S), jnp.stack(new_conv), kv_rows, new_win


def setup_inputs(seed: int = 0) -> dict:
    key = jax.random.key(seed)
    ks = jax.random.split(key, 26)
    f32 = jnp.float32

    def normal(k, shape, scale):
        return jax.random.normal(k, shape, f32) * scale

    n_pages = PAST_LEN // PAGE_SIZE
    n_used = DEC_BATCH * n_pages
    n_pool = n_used + (n_used + 3) // 4
    win_buf = min(WINDOW, PAST_LEN)
    page_table = jax.random.permutation(ks[6], n_pool)[:n_used].reshape(DEC_BATCH, n_pages).astype(jnp.int32)
    dt = jnp.exp(jax.random.uniform(ks[15], (N_A_LAYERS, DN_HEADS), f32, math.log(1e-3), math.log(1e-1)))
    return {
        'x_prompt': normal(ks[0], (BATCH, SEQ, D_MODEL), 1.0),
        'x_sample': normal(ks[1], (DEC_BATCH, DEC_SEQ, D_MODEL), 1.0),
        'state_dn_S': normal(ks[2], (N_A_LAYERS, DEC_BATCH, DN_HEADS, DN_HEAD_K, DN_HEAD_V), 0.1),
        'state_dn_conv': normal(ks[3], (N_A_LAYERS, DEC_BATCH, DN_CONV - 1, DN_QKV_DIM), 1.0),
        'cache_kv': normal(ks[4], (n_pool, PAGE_SIZE, 4, NSA_KV_HEADS, NSA_HEAD_DIM), 1.0),
        'state_win_kv': normal(ks[5], (DEC_BATCH, win_buf, 2, NSA_KV_HEADS, NSA_HEAD_DIM), 1.0),
        'page_table': page_table,
        'norm_mix': 1.0 + normal(ks[7], (DEPTH, D_MODEL), 0.02),
        'norm_ffn': 1.0 + normal(ks[8], (DEPTH, D_MODEL), 0.02),
        'norm_kv': 1.0 + normal(ks[9], (D_MODEL,), 0.02),
        'norm_final': 1.0 + normal(ks[10], (D_MODEL,), 0.02),
        'ffn_w_in': normal(ks[11], (DEPTH, D_MODEL, 2 * D_FF), D_MODEL ** -0.5),
        'ffn_w_out': normal(ks[12], (DEPTH, D_FF, D_MODEL), D_FF ** -0.5),
        'dn_w_in': normal(ks[13], (N_A_LAYERS, D_MODEL, DN_IN_DIM), D_MODEL ** -0.5),
        'dn_conv_w': normal(ks[14], (N_A_LAYERS, DN_CONV, DN_QKV_DIM), DN_CONV ** -0.5),
        'dn_A_log': jnp.log(jax.random.uniform(ks[16], (N_A_LAYERS, DN_HEADS), f32, 1.0, 16.0)),
        'dn_dt_bias': dt + jnp.log(-jnp.expm1(-dt)),
        'dn_out_norm': 1.0 + normal(ks[17], (N_A_LAYERS, DN_HEAD_V), 0.02),
        'dn_w_out': normal(ks[18], (N_A_LAYERS, DN_VAL_DIM, D_MODEL), DN_VAL_DIM ** -0.5),
        'nsa_w_kv': normal(ks[19], (D_MODEL, NSA_KV_DIM), D_MODEL ** -0.5),
        'nsa_cmp_pos_w': (1.0 + normal(ks[20], (2, CMP_BLOCK, NSA_KV_HEADS, NSA_HEAD_DIM), 0.1)) * CMP_BLOCK ** -0.5,
        'nsa_w_cmp': normal(ks[21], (2, NSA_KV_HEADS, NSA_HEAD_DIM, NSA_HEAD_DIM), NSA_HEAD_DIM ** -0.5),
        'nsa_w_in': normal(ks[22], (N_B_LAYERS, D_MODEL, NSA_IN_DIM), D_MODEL ** -0.5),
        'nsa_w_out': normal(ks[23], (N_B_LAYERS, NSA_DIM, D_MODEL), NSA_DIM ** -0.5),
        'rel_bias': normal(ks[24], (REL_BUCKETS, NSA_HEADS), 0.5),
    }


def reference(x_prompt, x_sample, state_dn_S, state_dn_conv, cache_kv, state_win_kv, page_table,
              norm_mix, norm_ffn, norm_kv, norm_final, ffn_w_in, ffn_w_out,
              dn_w_in, dn_conv_w, dn_A_log, dn_dt_bias, dn_out_norm, dn_w_out,
              nsa_w_kv, nsa_cmp_pos_w, nsa_w_cmp, nsa_w_in, nsa_w_out, rel_bias):
    P = {'norm_mix': norm_mix, 'norm_ffn': norm_ffn, 'norm_kv': norm_kv, 'norm_final': norm_final,
         'ffn_w_in': ffn_w_in, 'ffn_w_out': ffn_w_out, 'dn_w_in': dn_w_in, 'dn_conv_w': dn_conv_w,
         'dn_A_log': dn_A_log, 'dn_dt_bias': dn_dt_bias, 'dn_out_norm': dn_out_norm, 'dn_w_out': dn_w_out,
         'nsa_w_kv': nsa_w_kv, 'nsa_cmp_pos_w': nsa_cmp_pos_w, 'nsa_w_cmp': nsa_w_cmp,
         'nsa_w_in': nsa_w_in, 'nsa_w_out': nsa_w_out, 'rel_bias': rel_bias}
    bp = x_prompt.shape[0]
    p_S0 = jnp.zeros((N_A_LAYERS, bp, DN_HEADS, DN_HEAD_K, DN_HEAD_V), jnp.float32)
    p_conv0 = jnp.zeros((N_A_LAYERS, bp, DN_CONV - 1, DN_QKV_DIM), x_prompt.dtype)
    y_prompt, p_dn_S, p_dn_conv, p_kv_rows, p_win_kv = run_trunk(x_prompt, p_S0, p_conv0, None, None, 0, P)
    past = cache_kv[page_table]
    past = past.reshape(page_table.shape[0], page_table.shape[1] * PAGE_SIZE, 4, NSA_KV_HEADS, NSA_HEAD_DIM)
    y_sample, s_dn_S, s_dn_conv, s_kv_rows, s_win_kv = run_trunk(x_sample, state_dn_S, state_dn_conv, past, state_win_kv, PAST_LEN, P)
    return (y_prompt, y_sample, p_dn_S, p_dn_conv, p_kv_rows, p_win_kv, s_dn_S, s_dn_conv, s_kv_rows, s_win_kv)
```

```cpp
#include <hip/hip_runtime.h>
#include <cstdio>
#include <cstdint>

#ifndef MK_PER_PHASE
#define MK_PER_PHASE 0
#endif

#define DI __device__ __forceinline__
#define LAS __attribute__((address_space(3)))
typedef unsigned short bf16_t;
typedef short bf16x8 __attribute__((ext_vector_type(8)));
typedef float f32x4 __attribute__((ext_vector_type(4)));
typedef float f32x2 __attribute__((ext_vector_type(2)));
typedef unsigned u32x4 __attribute__((ext_vector_type(4)));
typedef unsigned u32x2 __attribute__((ext_vector_type(2)));
typedef __bf16 bf16v2 __attribute__((ext_vector_type(2)));

constexpr int D = 1024, TP = 16384, TS = 512, TT = TP + TS, SEQ = 4096, DFF = 2816;
constexpr int N_DNIN = 4352, N_DNIN_REAL = 4112, N_NSAIN = 1280, N_NSAIN_REAL = 1072, N_KV = 1536;
constexpr int NWAVES = 8, NTHR = 512;
constexpr float EPS = 1e-6f;
constexpr size_t O_Y = 0, O_PS = 17301504, O_PC = 18350080, O_PKV = 18423808, O_PW = 35201024, O_SS = 36249600, O_SC = 69804032, O_SKV = 72163328, O_SW = 72687616;
constexpr size_t al256(size_t x) { return (x + 255) & ~(size_t)255; }
constexpr size_t WS_CTL = 0, CTL_BYTES = 1u << 20;
constexpr size_t SZ_WDNIN = (size_t)N_DNIN * D * 2, SZ_WSQ = (size_t)D * D * 2, SZ_WFFNIN = (size_t)2 * DFF * D * 2, SZ_WFFNOUT = (size_t)D * DFF * 2, SZ_WKV = (size_t)N_KV * D * 2, SZ_WNSAIN = (size_t)N_NSAIN * D * 2;
constexpr size_t WS_WDNIN = CTL_BYTES;
constexpr size_t WS_WDNOUT = WS_WDNIN + 2 * SZ_WDNIN;
constexpr size_t WS_WFFNIN = WS_WDNOUT + 2 * SZ_WSQ;
constexpr size_t WS_WFFNOUT = WS_WFFNIN + 4 * SZ_WFFNIN;
constexpr size_t WS_WKV = WS_WFFNOUT + 4 * SZ_WFFNOUT;
constexpr size_t WS_WNSAIN = WS_WKV + SZ_WKV;
constexpr size_t WS_WNSAOUT = WS_WNSAIN + 2 * SZ_WNSAIN;
constexpr size_t WS_X = al256(WS_WNSAOUT + 2 * SZ_WSQ);
constexpr size_t WS_XB = WS_X + (size_t)TT * D * 4;
constexpr size_t WS_STATS = WS_XB + (size_t)TT * D * 2;
constexpr size_t WS_QKVB = WS_STATS + (size_t)TT * 16 * 4;
constexpr size_t WS_ZB = WS_QKVB + (size_t)TT * 3072 * 2;
constexpr size_t WS_AB = WS_ZB + (size_t)TT * D * 2;
constexpr size_t WS_QN = WS_AB + (size_t)TT * 16 * 4;
constexpr size_t WS_KN = WS_QN + (size_t)TT * D * 2;
constexpr size_t WS_VB = WS_KN + (size_t)TT * D * 2;
constexpr size_t WS_GG = WS_VB + (size_t)TT * D * 2;
constexpr size_t WS_BETA = WS_GG + (size_t)TT * 8 * 4;
constexpr size_t PK_WKF = 0, PK_QF = 16384, PK_AQK = 32768, PK_KDF = 40960, PK_WVC = 57344, PK_SIZE = 73728;
constexpr size_t WS_PACK = WS_BETA + (size_t)TT * 8 * 4;
constexpr size_t WS_EG = WS_PACK + (size_t)2048 * PK_SIZE;
constexpr size_t WS_GL = WS_EG + (size_t)2048 * 64 * 4;
constexpr size_t WS_OB = al256(WS_GL + 2048 * 4);
constexpr size_t WS_ACT = WS_OB + (size_t)TT * D * 2;
constexpr size_t SZ_KVP = (size_t)4 * 4 * 64 * 4096 * 2;
constexpr size_t WS_KSELP = WS_ACT + (size_t)TT * DFF * 2;
constexpr size_t WS_VSELP = WS_KSELP + SZ_KVP;
constexpr size_t WS_KWINP = WS_VSELP + SZ_KVP;
constexpr size_t WS_VWINP = WS_KWINP + SZ_KVP;
constexpr size_t SZ_KSELS = (size_t)128 * 4 * 33 * 4096 * 2, SZ_KWINS = (size_t)128 * 4 * 9 * 4096 * 2;
constexpr size_t WS_KSELS = WS_VWINP + SZ_KVP;
constexpr size_t WS_VSELS = WS_KSELS + SZ_KSELS;
constexpr size_t WS_KWINS = WS_VSELS + SZ_KSELS;
constexpr size_t WS_VWINS = WS_KWINS + SZ_KWINS;
constexpr size_t WS_CKP = WS_VWINS + SZ_KWINS;
constexpr size_t WS_CVP = WS_CKP + (size_t)16 * 256 * 64 * 2;
constexpr size_t WS_CKS = WS_CVP + (size_t)16 * 256 * 64 * 2;
constexpr size_t WS_CVS = WS_CKS + (size_t)512 * 128 * 64 * 2;
constexpr size_t WS_QB = WS_CVS + (size_t)512 * 128 * 64 * 2;
constexpr size_t WS_GATES = WS_QB + (size_t)TT * D * 2;
constexpr int BT_STRIDE = 1224, BT_OFF = 80;
constexpr size_t WS_BT = WS_GATES + (size_t)TT * 48 * 4;
constexpr size_t WS_END = al256(WS_BT + 16 * BT_STRIDE * 4);
constexpr int LDS_MAIN = 131072, LDS_MISC = 131072, LDS_BYTES = 147456;
constexpr int LDS_BARW = LDS_BYTES - 16;

DI unsigned pk2(float a, float b) { f32x2 v = {a, b}; bf16v2 r = __builtin_convertvector(v, bf16v2); return __builtin_bit_cast(unsigned, r); }
DI float bflo(unsigned u) { return __uint_as_float(u << 16); }
DI float bfhi(unsigned u) { return __uint_as_float(u & 0xffff0000u); }
DI float bf2f(bf16_t b) { return __uint_as_float(((unsigned)b) << 16); }
DI bf16_t f2bf(float f) { return (bf16_t)(pk2(f, 0.f) & 0xffffu); }
DI float wave_sum(float v) {
#pragma unroll
    for (int o = 1; o < 64; o <<= 1) v += __shfl_xor(v, o);
    return v;
}
DI float sigmoidf_(float x) { return 1.0f / (1.0f + __expf(-x)); }
DI float siluf_(float x) { return x / (1.0f + __expf(-x)); }
#define LDS_WAIT() asm volatile("s_waitcnt lgkmcnt(0)" ::: "memory")
#define MFMA16(a, b, c) __builtin_amdgcn_mfma_f32_16x16x32_bf16((a), (b), (c), 0, 0, 0)
DI bf16x8 pack8(const f32x4& a, const f32x4& b) { u32x4 p; p.x = pk2(a.x, a.y); p.y = pk2(a.z, a.w); p.z = pk2(b.x, b.y); p.w = pk2(b.z, b.w); return __builtin_bit_cast(bf16x8, p); }
namespace pg8 {
#define PG8_LAS __attribute__((address_space(3)))
typedef unsigned short bf16_t;
typedef short bf16x8 __attribute__((ext_vector_type(8)));
typedef float f32x4 __attribute__((ext_vector_type(4)));
typedef unsigned u32x4 __attribute__((ext_vector_type(4)));
constexpr int BM = 256, BK = 64, HALF = 128, HTB = HALF * BK * 2  , STAGE_BYTES = 8 * HTB, NXCD = 8, WGM = 8;

__host__ __device__ __forceinline__ int lds_byte(int r, int c) { const int st = (r >> 4) * 2 + (c >> 5), rr = r & 15, cc = c & 31, ob = rr * 64 + cc * 2; return st * 1024 + (ob ^ (((ob >> 9) & 1) << 5)); }
__host__ __device__ __forceinline__ void stage_rc(int b, int& R, int& C) { const int st = b / 1024, sb = b % 1024, swz = sb ^ (((sb >> 9) & 1) << 5); R = (st >> 1) * 16 + swz / 64; C = (st & 1) * 32 + (swz % 64) / 2; }
__host__ __device__ __forceinline__ int perm32(int rho) { const int n = rho >> 4, i = rho & 15; return 8 * (i >> 2) + 4 * n + (i & 3); }

struct Unit { int pm, pn; };
struct Gemm { const bf16_t* A; const bf16_t* Bt; int M, N, K; };

struct StaticOrder {
    int nM, nN, nwg, G, c;
    __host__ __device__ void init(int M, int N, int G_, int c_) { nM = M / BM; nN = N / BM; nwg = nM * nN; G = G_; c = c_; }
    __host__ __device__ bool next(int i, Unit& u) const {
        const long L = (long)i * G + c; if (L >= nwg) return false;
        int wgid = (int)L; { const int q = nwg / NXCD, r = nwg % NXCD, xcd = wgid % NXCD, off = wgid / NXCD; wgid = (xcd < r ? xcd * (q + 1) : r * (q + 1) + (xcd - r) * q) + off; }
        const int nig = WGM * nN, gid = wgid / nig, fm = gid * WGM, gsz = (nM - fm) < WGM ? (nM - fm) : WGM;
        u.pm = fm + ((wgid % nig) % gsz); u.pn = (wgid % nig) / gsz; return true;
    }
    __device__ __forceinline__ void a_ready(const Unit&) const {}
    __device__ __forceinline__ void done(const Unit&) const {}
};
struct CountedOrder : StaticOrder {
    const unsigned* ready; unsigned need; unsigned* tmo;
    __device__ __forceinline__ void a_ready(const Unit& u) const {
        if (threadIdx.x < 64) {
            const unsigned long long t0 = __builtin_amdgcn_s_memrealtime(); unsigned polls = 0;
            while ((unsigned)__builtin_amdgcn_readfirstlane(__hip_atomic_load(ready + 64 * u.pm, __ATOMIC_RELAXED, __HIP_MEMORY_SCOPE_AGENT)) < need) {
                if ((++polls & 255u) == 0u && __builtin_amdgcn_readfirstlane(__hip_atomic_load(tmo, __ATOMIC_RELAXED, __HIP_MEMORY_SCOPE_AGENT)) != 0u) break;
                if (__builtin_amdgcn_s_memrealtime() - t0 > 2000000ull) {
                    if (threadIdx.x == 0) { unsigned expect = 0u; __hip_atomic_compare_exchange_strong(tmo + 1, &expect, 0x600u | (unsigned)(u.pm & 0xff), __ATOMIC_RELAXED, __ATOMIC_RELAXED, __HIP_MEMORY_SCOPE_AGENT); __hip_atomic_store(tmo, 1u, __ATOMIC_RELAXED, __HIP_MEMORY_SCOPE_AGENT); }
                    break; }
                __builtin_amdgcn_s_sleep(2); }
            __builtin_amdgcn_fence(__ATOMIC_ACQUIRE, "agent");
            asm volatile("s_waitcnt vmcnt(0)" ::: "memory");
        }
#if !defined(BROKEN_HOOK_NO_BARRIER)
        asm volatile("" ::: "memory"); __builtin_amdgcn_s_barrier(); asm volatile("" ::: "memory");
#endif
    }
};

__device__ __forceinline__ unsigned cvt_pk_bf16(float lo, float hi) { unsigned r; asm volatile("v_cvt_pk_bf16_f32 %0, %1, %2" : "=v"(r) : "v"(lo), "v"(hi)); return r; }
typedef float f32x2 __attribute__((ext_vector_type(2)));
__device__ __forceinline__ f32x2 gelu_pk(f32x2 v) {
    const f32x2 av = __builtin_elementwise_abs(v), d = av * 0.2316418882f + 1.0f;
    f32x2 t; t.x = __builtin_amdgcn_rcpf(d.x); t.y = __builtin_amdgcn_rcpf(d.y);
    f32x2 q = t * 0.5307027145f + (-0.7265760135f); q = q * t + 0.7107068705f; q = q * t + (-0.142248368f); q = q * t + 0.127414796f; q = q * t;
    const f32x2 s = (v * v) * (-0.72134752044f);
    f32x2 e; e.x = __builtin_amdgcn_exp2f(s.x); e.y = __builtin_amdgcn_exp2f(s.y);
    const f32x2 m = v * (q * e), r = v - m;
    f32x2 o; o.x = v.x < 0.f ? m.x : r.x; o.y = v.y < 0.f ? m.y : r.y; return o;
}

struct EpiF32 {
    static constexpr bool PERM = false, AFTER_DRAIN = false;
    float* C; int ldc; const float* bias;
    __device__ __forceinline__ void operator()(const f32x4 (&acc)[2][2][4][2], const Unit& u, int wr, int wc, int fr, int fq) const {
        const int row0 = u.pm * BM + wr * 64 + fr, col0 = u.pn * BM + wc * 32 + 4 * fq;
        f32x4 bv[2][2];
#pragma unroll
        for (int bj = 0; bj < 2; ++bj)
#pragma unroll
            for (int n = 0; n < 2; ++n) bv[bj][n] = bias ? *(const f32x4*)(bias + col0 + bj * HALF + n * 16) : (f32x4){0.f, 0.f, 0.f, 0.f};
#pragma unroll
        for (int ai = 0; ai < 2; ++ai)
#pragma unroll
            for (int m = 0; m < 4; ++m) { float* rowp = C + (size_t)(row0 + ai * HALF + m * 16) * ldc + col0;
#pragma unroll
                for (int bj = 0; bj < 2; ++bj)
#pragma unroll
                    for (int n = 0; n < 2; ++n) *(f32x4*)(rowp + bj * HALF + n * 16) = acc[ai][bj][m][n] + bv[bj][n]; }
    }
};
template <int ACT  > struct EpiBf16 {
    static constexpr bool PERM = true, AFTER_DRAIN = false;
    bf16_t* O; int ldc; const float* bias; int split_cols; size_t split_stride;
    __device__ __forceinline__ void operator()(const f32x4 (&acc)[2][2][4][2], const Unit& u, int wr, int wc, int fr, int fq) const {
        const int row0 = u.pm * BM + wr * 64 + fr; int colt = u.pn * BM; bf16_t* base = O;
        if (split_cols) { const int t = colt / split_cols; base += (size_t)t * split_stride; colt -= t * split_cols; }
        const int col0 = colt + wc * 32 + 8 * fq, bcol0 = u.pn * BM + wc * 32 + 8 * fq;
        f32x4 bv[2][2];
#pragma unroll
        for (int bj = 0; bj < 2; ++bj)
#pragma unroll
            for (int n = 0; n < 2; ++n) bv[bj][n] = bias ? *(const f32x4*)(bias + bcol0 + bj * HALF + 4 * n) : (f32x4){0.f, 0.f, 0.f, 0.f};
#pragma unroll
        for (int ai = 0; ai < 2; ++ai)
#pragma unroll
            for (int m = 0; m < 4; ++m) { bf16_t* rowp = base + (size_t)(row0 + ai * HALF + m * 16) * ldc + col0;
#pragma unroll
                for (int bj = 0; bj < 2; ++bj) { f32x4 v0 = acc[ai][bj][m][0] + bv[bj][0], v1 = acc[ai][bj][m][1] + bv[bj][1];
                    if (ACT == 1) { f32x2 a = gelu_pk((f32x2){v0[0], v0[1]}), b = gelu_pk((f32x2){v0[2], v0[3]}), c = gelu_pk((f32x2){v1[0], v1[1]}), d = gelu_pk((f32x2){v1[2], v1[3]});
                        v0 = (f32x4){a.x, a.y, b.x, b.y}; v1 = (f32x4){c.x, c.y, d.x, d.y}; }
                    if (ACT == 2) {
#pragma unroll
                        for (int j = 0; j < 4; ++j) { v0[j] = 0.5f * v0[j] * (1.0f + erff(v0[j] * 0.70710678f)); v1[j] = 0.5f * v1[j] * (1.0f + erff(v1[j] * 0.70710678f)); } }
                    u32x4 w; w.x = cvt_pk_bf16(v0[0], v0[1]); w.y = cvt_pk_bf16(v0[2], v0[3]); w.z = cvt_pk_bf16(v1[0], v1[1]); w.w = cvt_pk_bf16(v1[2], v1[3]);
                    *(u32x4*)(rowp + bj * HALF) = w; } }
    }
};

template <class Epi, class Sched, bool STAMP = false>
__device__ __forceinline__ void gemm_phase(PG8_LAS unsigned char* lds, const Gemm g, const Sched& S, const Epi& E, unsigned long long* stamps) {
    int tid_o = threadIdx.x; asm volatile("" : "+v"(tid_o));
    const int tid = tid_o, wid = __builtin_amdgcn_readfirstlane(tid >> 6), lane = tid & 63, wr = wid >> 2, wc = wid & 3, fr = lane & 15, fq = lane >> 4;
    const int K = g.K, nt = K / BK;
    int ts_lo = 0, ts_hi = 0, nts = 0; const unsigned long long rt_entry = STAMP ? (unsigned long long)wall_clock64() : 0ull;
#define PG8_STAMP() do { if (STAMP && wid == 0 && nts < 64) { const unsigned long long _c = (unsigned long long)clock64(); \
        ts_lo = (lane == nts) ? (int)(unsigned)_c : ts_lo; ts_hi = (lane == nts) ? (int)(unsigned)(_c >> 32) : ts_hi; ++nts; } } while (0)
    PG8_STAMP();
    unsigned voffA[2], voffB[2];
#pragma unroll
    for (int i = 0; i < 2; ++i) { int R, C; stage_rc(tid * 16 + i * 8192, R, C); const int Rb = Epi::PERM ? ((R & ~31) + perm32(R & 31)) : R;
        voffA[i] = (unsigned)(R * K + C) * 2u; voffB[i] = (unsigned)(Rb * K + C) * 2u; }
    const size_t kstep = (size_t)(BK * 2);
    const size_t hstep = (size_t)HALF * K * 2;
    const size_t tstep = 2 * hstep;
    const unsigned ldsw = (unsigned)wid * 1024u;
    const int aoff = lds_byte(wr * 64 + fr, fq * 8), boff = lds_byte(wc * 32 + fr, fq * 8);
#define PG8_SA(b, h) (((b) * 2 + (h)) * HTB)
#define PG8_SB(b, h) ((4 + (b) * 2 + (h)) * HTB)
#define PG8_STAGE(bufoff, gbase, voff) do { _Pragma("unroll") for (int _i = 0; _i < 2; ++_i) \
        __builtin_amdgcn_global_load_lds((const unsigned*)((const char*)(gbase) + (voff)[_i]), (PG8_LAS unsigned*)(lds + (bufoff) + ldsw + _i * 8192), 16, 0, 0); } while (0)
#define PG8_LDA(dst, b, h) do { _Pragma("unroll") for (int m = 0; m < 4; ++m) _Pragma("unroll") for (int k = 0; k < 2; ++k) dst[m][k] = *(const PG8_LAS bf16x8*)(lds + PG8_SA(b, h) + aoff + m * 2048 + k * 1024); } while (0)
#define PG8_LDB(dst, b, h) do { _Pragma("unroll") for (int n = 0; n < 2; ++n) _Pragma("unroll") for (int k = 0; k < 2; ++k) dst[n][k] = *(const PG8_LAS bf16x8*)(lds + PG8_SB(b, h) + boff + n * 2048 + k * 1024); } while (0)
#define PG8_MMA(ai, bj, At, Bt) do { __builtin_amdgcn_s_setprio(1); _Pragma("unroll") for (int m = 0; m < 4; ++m) _Pragma("unroll") for (int n = 0; n < 2; ++n) _Pragma("unroll") for (int k = 0; k < 2; ++k) \
        acc[ai][bj][m][n] = __builtin_amdgcn_mfma_f32_16x16x32_bf16(Bt[n][k], At[m][k], acc[ai][bj][m][n], 0, 0, 0); __builtin_amdgcn_s_setprio(0); } while (0)
#define PG8_WAIT_V(n) asm volatile("s_waitcnt vmcnt(" #n ")" ::: "memory")
#define PG8_WAIT_L(n) asm volatile("s_waitcnt lgkmcnt(" #n ")" ::: "memory")
#define PG8_BAR __builtin_amdgcn_s_barrier()
#define PG8_SCHED __builtin_amdgcn_sched_barrier(0)
    Unit cur, nxt; int ui = 0;
    if (!S.next(0, cur)) return;
    f32x4 acc[2][2][4][2];
#pragma unroll
    for (int a = 0; a < 2; ++a)
#pragma unroll
        for (int b = 0; b < 2; ++b)
#pragma unroll
            for (int m = 0; m < 4; ++m)
#pragma unroll
                for (int n = 0; n < 2; ++n) acc[a][b][m][n] = (f32x4){0.f, 0.f, 0.f, 0.f};
    bf16x8 At[4][2], B0[2][2], B1[2][2];
    const char* cA = (const char*)g.A + (size_t)cur.pm * tstep; const char* cB = (const char*)g.Bt + (size_t)cur.pn * tstep;
    S.a_ready(cur);
    PG8_STAGE(PG8_SB(0, 0), cB, voffB); PG8_STAGE(PG8_SA(0, 0), cA, voffA); PG8_STAGE(PG8_SB(0, 1), cB + hstep, voffB); PG8_STAGE(PG8_SA(0, 1), cA + hstep, voffA);
    if (wr == 1) PG8_BAR;
    PG8_WAIT_V(4); PG8_BAR;
    PG8_STAGE(PG8_SB(1, 0), cB + kstep, voffB); PG8_STAGE(PG8_SA(1, 0), cA + kstep, voffA); PG8_STAGE(PG8_SB(1, 1), cB + hstep + kstep, voffB);
    PG8_WAIT_V(6); PG8_BAR;
    PG8_STAMP();
    for (;;) {
        const bool has_next = S.next(ui + 1, nxt);
        const char* nA = has_next ? (const char*)g.A + (size_t)nxt.pm * tstep : cA; const char* nB = has_next ? (const char*)g.Bt + (size_t)nxt.pn * tstep : cB;
        for (int t = 0; t < nt; t += 2) {
            const bool last = (t == nt - 2);
            const char* a1 = cA + (size_t)(t + 1) * kstep;
            const char* a2 = last ? nA : cA + (size_t)(t + 2) * kstep; const char* b2 = last ? nB : cB + (size_t)(t + 2) * kstep;
            const char* a3 = a2 + kstep; const char* b3 = b2 + kstep;
            if (last && has_next) S.a_ready(nxt);
            PG8_LDB(B0, 0, 0); PG8_SCHED; PG8_LDA(At, 0, 0); PG8_STAGE(PG8_SA(1, 1), a1 + hstep, voffA);
            PG8_WAIT_L(8); PG8_BAR; PG8_WAIT_L(0); PG8_MMA(0, 0, At, B0); PG8_BAR; PG8_SCHED;
            PG8_LDB(B1, 0, 1); PG8_STAGE(PG8_SB(0, 0), b2, voffB);
            PG8_BAR; PG8_WAIT_L(0); PG8_MMA(0, 1, At, B1); PG8_BAR;
            PG8_LDA(At, 0, 1); PG8_STAGE(PG8_SA(0, 0), a2, voffA);
            PG8_BAR; PG8_WAIT_L(0); PG8_MMA(1, 0, At, B0); PG8_BAR; PG8_SCHED;
            PG8_STAGE(PG8_SB(0, 1), b2 + hstep, voffB);
            PG8_WAIT_V(6); PG8_BAR; PG8_MMA(1, 1, At, B1); PG8_BAR;
            PG8_LDB(B0, 1, 0); PG8_SCHED; PG8_LDA(At, 1, 0); PG8_STAGE(PG8_SA(0, 1), a2 + hstep, voffA);
            PG8_WAIT_L(8); PG8_BAR; PG8_WAIT_L(0); PG8_MMA(0, 0, At, B0); PG8_BAR; PG8_SCHED;
            PG8_LDB(B1, 1, 1); PG8_STAGE(PG8_SB(1, 0), b3, voffB);
            PG8_BAR; PG8_WAIT_L(0); PG8_MMA(0, 1, At, B1); PG8_BAR;
            PG8_LDA(At, 1, 1); PG8_STAGE(PG8_SA(1, 0), a3, voffA);
            PG8_BAR; PG8_WAIT_L(0); PG8_MMA(1, 0, At, B0); PG8_BAR; PG8_SCHED;
            PG8_STAGE(PG8_SB(1, 1), b3 + hstep, voffB);
            PG8_WAIT_V(6); PG8_BAR; PG8_MMA(1, 1, At, B1); PG8_BAR;
        }
        PG8_STAMP();
        if constexpr (!Epi::AFTER_DRAIN) { E(acc, cur, wr, wc, fr, fq); S.done(cur); }
        PG8_STAMP();
        if (!has_next) break;
#pragma unroll
        for (int a = 0; a < 2; ++a)
#pragma unroll
            for (int b = 0; b < 2; ++b)
#pragma unroll
                for (int m = 0; m < 4; ++m)
#pragma unroll
                    for (int n = 0; n < 2; ++n) acc[a][b][m][n] = (f32x4){0.f, 0.f, 0.f, 0.f};
        cur = nxt; cA = nA; cB = nB; ++ui;
    }
    PG8_WAIT_V(0);
    if (wr == 0) PG8_BAR;
    PG8_BAR;
    if constexpr (Epi::AFTER_DRAIN) { E.fused(acc, cur, wr, wc, fr, fq, lds, wid, lane); S.done(cur); }
    PG8_STAMP();
    if (STAMP && wid == 0) { stamps[lane] = lane < nts ? (((unsigned long long)(unsigned)ts_hi << 32) | (unsigned)ts_lo) : 0ull;
        if (lane == 62) stamps[62] = rt_entry; if (lane == 63) stamps[63] = (unsigned long long)wall_clock64(); }
#undef PG8_STAMP
#undef PG8_SA
#undef PG8_SB
#undef PG8_STAGE
#undef PG8_LDA
#undef PG8_LDB
#undef PG8_MMA
#undef PG8_WAIT_V
#undef PG8_WAIT_L
#undef PG8_BAR
#undef PG8_SCHED
}
}
#define XB_TMO      128
#define XB_XCNT(j)  (256  + 64 * (j))
#define XB_XSUB(j)  (1280 + 64 * (j))
#define XB_XGEN(j)  (2304 + 64 * (j))
#define XB_TOP      3328
#define XB_TOPGEN   3392
#define XCD_BAR_WORDS 3456
#define XB_SPIN_CAP (1u << 18)

__device__ __forceinline__ unsigned xb_ld(unsigned* p)              { return __hip_atomic_load(p, __ATOMIC_RELAXED, __HIP_MEMORY_SCOPE_AGENT); }
__device__ __forceinline__ unsigned xb_add(unsigned* p, unsigned v) { return __hip_atomic_fetch_add(p, v, __ATOMIC_RELAXED, __HIP_MEMORY_SCOPE_AGENT); }
__device__ __forceinline__ unsigned xb_xcc_id() { return (unsigned)__builtin_amdgcn_s_getreg((3 << 11) | 20) & 0xFu; }
#define XB_SPIN(cond, bar) do { unsigned _sp = 0; while (cond) { __builtin_amdgcn_s_sleep(1); \
    if ((++_sp & 255u) == 0u) { if (xb_ld(&(bar)[XB_TMO])) break; if (_sp > XB_SPIN_CAP) { atomicAdd(&(bar)[XB_TMO], 1u); break; } } } } while (0)

struct XcdBarrier {
    unsigned* bar; unsigned x;
    volatile LAS unsigned* st;
};

__device__ __forceinline__ XcdBarrier xcd_barrier_post(unsigned* bar, volatile LAS unsigned* st) {
    XcdBarrier b; b.bar = bar; b.x = xb_xcc_id(); b.st = st;
    if (threadIdx.x == 0) (void)xb_add(&bar[XB_XCNT(b.x)], 1u);
    return b;
}
__device__ __forceinline__ void xcd_barrier_complete(unsigned* bar, unsigned x, unsigned& nloc, unsigned& nx) {
    const unsigned G = gridDim.x * gridDim.y * gridDim.z;
    unsigned sum, cnt, mine, sp = 0u;
    for (;;) {
        sum = 0u; cnt = 0u; mine = 0u;
#pragma unroll
        for (unsigned j = 0; j < 16; ++j) { const unsigned c = xb_ld(&bar[XB_XCNT(j)]); sum += c; cnt += (c > 0u) ? 1u : 0u; mine = (j == x) ? c : mine; }
        if (sum == G) break;
        __builtin_amdgcn_s_sleep(1);
        if ((++sp & 255u) == 0u) { if (xb_ld(&bar[XB_TMO])) break; if (sp > XB_SPIN_CAP) { atomicAdd(&bar[XB_TMO], 1u); break; } }
    }
    nloc = mine > 0u ? mine : 1u; nx = cnt > 0u ? cnt : 1u;
}

__device__ __forceinline__ void xcd_barrier(const XcdBarrier& b) {
    asm volatile("s_waitcnt vmcnt(0)" ::: "memory");
    __syncthreads();
    if (threadIdx.x == 0) {
        unsigned* bar = b.bar;
        __builtin_amdgcn_s_waitcnt(0);
        unsigned nloc = b.st[0], nx = b.st[1];
        if (nloc == 0u) { xcd_barrier_complete(bar, b.x, nloc, nx); b.st[0] = nloc; b.st[1] = nx; }
        const unsigned old = xb_add(&bar[XB_XSUB(b.x)], 1u);
        const unsigned gen = old / nloc;
        if (old + 1u == (gen + 1u) * nloc) {
            __builtin_amdgcn_fence(__ATOMIC_RELEASE, "agent");
            asm volatile("s_waitcnt vmcnt(0)" ::: "memory");
            const unsigned og = xb_add(&bar[XB_TOP], 1u);
            const unsigned tg = og / nx;
            if (og + 1u == (tg + 1u) * nx) xb_add(&bar[XB_TOPGEN], 1u);
            else XB_SPIN(xb_ld(&bar[XB_TOPGEN]) == tg, bar);
            __builtin_amdgcn_fence(__ATOMIC_ACQUIRE, "agent");
            xb_add(&bar[XB_XGEN(b.x)], 1u);
            asm volatile("s_waitcnt vmcnt(0)" ::: "memory");
        } else {
            XB_SPIN(xb_ld(&bar[XB_XGEN(b.x)]) == gen, bar);
            __builtin_amdgcn_fence(__ATOMIC_ACQUIRE, "agent");
            asm volatile("s_waitcnt vmcnt(0)" ::: "memory");
        }
    }
    __syncthreads();
}

using pg8::Unit;
DI float row_rs(const float* stats, int row) {
    const f32x4* p = (const f32x4*)(stats + (size_t)row * 16);
    const f32x4 a = p[0], b = p[1], c = p[2], d = p[3];
    const float s = ((a.x + a.y) + (a.z + a.w)) + ((b.x + b.y) + (b.z + b.w)) + ((c.x + c.y) + (c.z + c.w)) + ((d.x + d.y) + (d.z + d.w));
    return rsqrtf(s * (1.0f / 1024.0f) + EPS);
}
struct EpiDnIn {
    static constexpr bool PERM = true, AFTER_DRAIN = false;
    const float* stats; bf16_t* qkvb; bf16_t* zb; float* ab;
    DI void operator()(const f32x4 (&acc)[2][2][4][2], const Unit& u, int wr, int wc, int fr, int fq) const {
        const int row0 = u.pm * 256 + wr * 64 + fr;
        asm volatile("" ::: "memory");
#pragma unroll
        for (int ai = 0; ai < 2; ++ai)
#pragma unroll
            for (int m = 0; m < 4; ++m) {
                if ((m & 1) == 0) asm volatile("" ::: "memory");
                const int row = row0 + ai * 128 + m * 16; const float rs = row_rs(stats, row);
#pragma unroll
                for (int bj = 0; bj < 2; ++bj) {
                    const int c0 = u.pn * 256 + bj * 128 + wc * 32 + 8 * fq;
                    const f32x4 v0 = acc[ai][bj][m][0] * rs, v1 = acc[ai][bj][m][1] * rs;
                    if (u.pn < 16) {
                        u32x4 w; w.x = pk2(v0.x, v0.y); w.y = pk2(v0.z, v0.w); w.z = pk2(v1.x, v1.y); w.w = pk2(v1.z, v1.w);
                        if (u.pn < 12) *(u32x4*)(qkvb + (size_t)row * 3072 + c0) = w;
                        else *(u32x4*)(zb + (size_t)row * 1024 + (c0 - 3072)) = w;
                    } else if (c0 < 4096 + 16) {
                        float* o = ab + (size_t)row * 16 + (c0 - 4096);
                        *(f32x4*)o = v0; *(f32x4*)(o + 4) = v1;
                    }
                }
            }
    }
};
struct EpiRes {
    static constexpr bool PERM = false, AFTER_DRAIN = false;
    const float* xp; const float* xs; float* X; bf16_t* XB; float* stats; int first;
    DI void operator()(const f32x4 (&acc)[2][2][4][2], const Unit& u, int wr, int wc, int fr, int fq) const {
        const int row0 = u.pm * 256 + wr * 64 + fr, col0 = u.pn * 256 + wc * 32 + 4 * fq;
        asm volatile("" ::: "memory");
#pragma unroll
        for (int ai = 0; ai < 2; ++ai)
#pragma unroll
            for (int m = 0; m < 4; ++m) {
                if ((m & 1) == 0) asm volatile("" ::: "memory");
                const int row = row0 + ai * 128 + m * 16;
                const float* bp = first ? (row < TP ? xp + (size_t)row * D : xs + (size_t)(row - TP) * D) : X + (size_t)row * D;
                float ss = 0.f;
#pragma unroll
                for (int bj = 0; bj < 2; ++bj)
#pragma unroll
                    for (int n = 0; n < 2; ++n) {
                        const int c = col0 + bj * 128 + n * 16;
                        const f32x4 o = *(const f32x4*)(bp + c) + acc[ai][bj][m][n];
                        *(f32x4*)(X + (size_t)row * D + c) = o;
                        u32x2 w; w.x = pk2(o.x, o.y); w.y = pk2(o.z, o.w);
                        *(u32x2*)(XB + (size_t)row * D + c) = w;
                        ss += (o.x * o.x + o.y * o.y) + (o.z * o.z + o.w * o.w);
                    }
                ss += __shfl_xor(ss, 16); ss += __shfl_xor(ss, 32);
                if (fq == 0) stats[(size_t)row * 16 + u.pn * 4 + wc] = ss;
            }
    }
};
struct EpiFfnIn {
    static constexpr bool PERM = true, AFTER_DRAIN = false;
    const float* stats; bf16_t* act;
    DI void operator()(const f32x4 (&acc)[2][2][4][2], const Unit& u, int wr, int wc, int fr, int fq) const {
        const int row0 = u.pm * 256 + wr * 64 + fr, c0 = u.pn * 128 + wc * 32 + 8 * fq;
        asm volatile("" ::: "memory");
#pragma unroll
        for (int ai = 0; ai < 2; ++ai)
#pragma unroll
            for (int m = 0; m < 4; ++m) {
                if ((m & 1) == 0) asm volatile("" ::: "memory");
                const int row = row0 + ai * 128 + m * 16; const float rs = row_rs(stats, row);
                float o[8];
#pragma unroll
                for (int n = 0; n < 2; ++n)
#pragma unroll
                    for (int j = 0; j < 4; ++j) { const float g = acc[ai][0][m][n][j] * rs, up = acc[ai][1][m][n][j] * rs; o[4 * n + j] = siluf_(g) * up; }
                u32x4 w; w.x = pk2(o[0], o[1]); w.y = pk2(o[2], o[3]); w.z = pk2(o[4], o[5]); w.w = pk2(o[6], o[7]);
                *(u32x4*)(act + (size_t)row * DFF + c0) = w;
            }
    }
};
DI int permkey(int key) { return (key & ~31) + 8 * ((key >> 2) & 3) + 4 * ((key >> 4) & 1) + (key & 3); }
struct EpiKV {
    static constexpr bool PERM = false, AFTER_DRAIN = false;
    const float* stats; float* out; unsigned char* ws;
    DI void operator()(const f32x4 (&acc)[2][2][4][2], const Unit& u, int wr, int wc, int fr, int fq) const {
        const int row0 = u.pm * 256 + wr * 64 + fr, part = u.pn;
        asm volatile("" ::: "memory");
#pragma unroll
        for (int ai = 0; ai < 2; ++ai)
#pragma unroll
            for (int m = 0; m < 4; ++m) {
                if ((m & 1) == 0) asm volatile("" ::: "memory");
                const int row = row0 + ai * 128 + m * 16; const float rs = row_rs(stats, row);
                const bool prm = row < TP;
                const int b = prm ? (row >> 12) : ((row - TP) >> 2), pos = prm ? (row & 4095) : (2048 + ((row - TP) & 3));
                const int blk = pos >> 6, key = pos & 63;
#pragma unroll
                for (int bj = 0; bj < 2; ++bj)
#pragma unroll
                    for (int n = 0; n < 2; ++n) {
                        const int lc = bj * 128 + wc * 32 + n * 16 + 4 * fq, kvh = lc >> 6, d = lc & 63;
                        const f32x4 v = acc[ai][bj][m][n] * rs;
                        if (part < 4) {
                            float* o = prm ? out + O_PKV + (size_t)row * 1024 : out + O_SKV + (size_t)(row - TP) * 1024;
                            *(f32x4*)(o + part * 256 + lc) = v;
                        } else {
                            if (prm) { if (pos >= 3584) *(f32x4*)(out + O_PW + ((size_t)(b * 512 + (pos - 3584)) * 2 + (part - 4)) * 256 + lc) = v; }
                            else *(f32x4*)(out + O_SW + ((size_t)(b * 512 + 508 + (pos - 2048)) * 2 + (part - 4)) * 256 + lc) = v;
                        }
                        if (part == 2 || part == 4) {
                            bf16_t* kb = prm ? (bf16_t*)(ws + (part == 2 ? WS_KSELP : WS_KWINP)) + ((size_t)((b * 4 + kvh) * 64 + blk)) * 4096
                                             : (part == 2 ? (bf16_t*)(ws + WS_KSELS) + ((size_t)((b * 4 + kvh) * 33 + 32)) * 4096 : (bf16_t*)(ws + WS_KWINS) + ((size_t)((b * 4 + kvh) * 9 + 8)) * 4096);
                            u32x2 w; w.x = pk2(v.x, v.y); w.y = pk2(v.z, v.w);
                            *(u32x2*)(kb + key * 64 + d) = w;
                        } else if (part == 3 || part == 5) {
                            bf16_t* vb = prm ? (bf16_t*)(ws + (part == 3 ? WS_VSELP : WS_VWINP)) + ((size_t)((b * 4 + kvh) * 64 + blk)) * 4096
                                             : (part == 3 ? (bf16_t*)(ws + WS_VSELS) + ((size_t)((b * 4 + kvh) * 33 + 32)) * 4096 : (bf16_t*)(ws + WS_VWINS) + ((size_t)((b * 4 + kvh) * 9 + 8)) * 4096);
                            const int pk = permkey(key);
                            vb[(d + 0) * 64 + pk] = f2bf(v.x); vb[(d + 1) * 64 + pk] = f2bf(v.y); vb[(d + 2) * 64 + pk] = f2bf(v.z); vb[(d + 3) * 64 + pk] = f2bf(v.w);
                        }
                    }
            }
    }
};
struct EpiNsaIn {
    static constexpr bool PERM = true, AFTER_DRAIN = false;
    const float* stats; bf16_t* qb; float* gates;
    DI void operator()(const f32x4 (&acc)[2][2][4][2], const Unit& u, int wr, int wc, int fr, int fq) const {
        const int row0 = u.pm * 256 + wr * 64 + fr;
        asm volatile("" ::: "memory");
#pragma unroll
        for (int ai = 0; ai < 2; ++ai)
#pragma unroll
            for (int m = 0; m < 4; ++m) {
                if ((m & 1) == 0) asm volatile("" ::: "memory");
                const int row = row0 + ai * 128 + m * 16; const float rs = row_rs(stats, row);
#pragma unroll
                for (int bj = 0; bj < 2; ++bj) {
                    const int c0 = u.pn * 256 + bj * 128 + wc * 32 + 8 * fq;
                    const f32x4 v0 = acc[ai][bj][m][0] * rs, v1 = acc[ai][bj][m][1] * rs;
                    if (u.pn < 4) {
                        const float s = 0.125f;
                        u32x4 w; w.x = pk2(v0.x * s, v0.y * s); w.y = pk2(v0.z * s, v0.w * s); w.z = pk2(v1.x * s, v1.y * s); w.w = pk2(v1.z * s, v1.w * s);
                        *(u32x4*)(qb + (size_t)row * 1024 + c0) = w;
                    } else if (c0 < 1024 + 48) {
                        float* o = gates + (size_t)row * 48 + (c0 - 1024);
                        f32x4 g0, g1;
                        g0.x = sigmoidf_(v0.x); g0.y = sigmoidf_(v0.y); g0.z = sigmoidf_(v0.z); g0.w = sigmoidf_(v0.w);
                        g1.x = sigmoidf_(v1.x); g1.y = sigmoidf_(v1.y); g1.z = sigmoidf_(v1.z); g1.w = sigmoidf_(v1.w);
                        *(f32x4*)o = g0; *(f32x4*)(o + 4) = g1;
                    }
                }
            }
    }
};
struct Args { const void* in[25]; float* out; unsigned char* ws; int ph_lo, ph_hi; };
typedef const __attribute__((address_space(4))) Args CArgs;
#define IN_F(i) ((const float*)A.in[i])
enum { I_XP = 0, I_XS, I_SDNS, I_SDNC, I_CACHE, I_SWIN, I_PT, I_NMIX, I_NFFN, I_NKV, I_NFIN, I_FFNWIN, I_FFNWOUT, I_DNWIN, I_DNCONVW, I_DNALOG, I_DNDTB, I_DNONORM, I_DNWOUT, I_NSAWKV, I_CMPPOSW, I_WCMP, I_NSAWIN, I_NSAWOUT, I_RELB };

DI void p0_tr_item(const float* W, int Nsrc, int K, int N, int Nreal, int kind, const float* scale, bf16_t* WT, LAS float* scr, int item, int lane) {
    const int nblk = N >> 5, kb = item / nblk, nb = item - kb * nblk, k0 = kb * 64, n0 = nb * 32;
    const int n = n0 + (lane & 31);
    int src;
    if (kind == 1) { const int pn = n >> 8, lc = n & 255; src = lc < 128 ? 128 * pn + lc : DFF + 128 * pn + (lc - 128); }
    else src = n < Nreal ? n : -1;
#pragma unroll 8
    for (int i = 0; i < 32; ++i) {
        const int kk = 2 * i + (lane >> 5); float v = 0.f;
        if (src >= 0) { v = W[(size_t)(k0 + kk) * Nsrc + src]; if (scale) v *= scale[k0 + kk]; }
        scr[kk * 33 + (lane & 31)] = v;
    }
    LDS_WAIT();
    const int c = lane & 7;
#pragma unroll
    for (int j = 0; j < 4; ++j) {
        const int nn = (lane >> 3) + 8 * j; const LAS float* s = scr + (8 * c) * 33 + nn;
        u32x4 o; o.x = pk2(s[0 * 33], s[1 * 33]); o.y = pk2(s[2 * 33], s[3 * 33]); o.z = pk2(s[4 * 33], s[5 * 33]); o.w = pk2(s[6 * 33], s[7 * 33]);
        *(u32x4*)(WT + (size_t)(n0 + nn) * K + k0 + 8 * c) = o;
    }
    LDS_WAIT();
}
DI void p0_row(const float* xrow, bf16_t* xb, float* st, int lane) {
    const f32x4* xr = (const f32x4*)xrow + lane; f32x4 v[4]; float s = 0.f;
#pragma unroll
    for (int j = 0; j < 4; ++j) { v[j] = xr[64 * j]; s += (v[j].x * v[j].x + v[j].y * v[j].y) + (v[j].z * v[j].z + v[j].w * v[j].w); }
    s = wave_sum(s);
    u32x2* o = (u32x2*)xb + lane;
#pragma unroll
    for (int j = 0; j < 4; ++j) { u32x2 w; w.x = pk2(v[j].x, v[j].y); w.y = pk2(v[j].z, v[j].w); o[64 * j] = w; }
    if (lane < 16) st[lane] = lane == 0 ? s : 0.f;
}
DI int rel_bucket_dev(int dist) {
    const int n = dist > 0 ? dist : 0;
    if (n < 16) return n;
    if (n >= 1024) return 31;
    const double v = (log2((double)n) - 4.0) * (8.0 / 3.0);
    int k = (int)(v + 1e-9); k = 16 + k;
    return k < 31 ? k : 31;
}
DI void conv_rows128(const float* src, int pitch, int koff, int voff, bf16_t* kdst, bf16_t* vdst, int NB, LAS float* tile, int tid) {
#pragma unroll 2
    for (int i = 0; i < 8; ++i) {
        const int tt = tid + 512 * i, rr = tt >> 5, c8 = tt & 31, kvh = c8 >> 3, d0 = (c8 & 7) * 8;
        const f32x4* p = (const f32x4*)(src + (size_t)rr * pitch + koff + kvh * 64 + d0); const f32x4 a = p[0], b = p[1];
        u32x4 o; o.x = pk2(a.x, a.y); o.y = pk2(a.z, a.w); o.z = pk2(b.x, b.y); o.w = pk2(b.z, b.w);
        *(u32x4*)(kdst + ((size_t)(kvh * NB + (rr >> 6)) * 64 + (rr & 63)) * 64 + d0) = o;
    }
    for (int hb = 0; hb < 2; ++hb) {
#pragma unroll 2
        for (int i = 0; i < 4; ++i) {
            const int tt = tid + 512 * i, rr = tt >> 5, c8 = tt & 31, kvh = c8 >> 3, d0 = (c8 & 7) * 8;
            const f32x4* p = (const f32x4*)(src + (size_t)(64 * hb + rr) * pitch + voff + kvh * 64 + d0); const f32x4 a = p[0], b = p[1];
            LAS float* t = tile + (kvh * 64 + rr) * 65 + d0;
            t[0] = a.x; t[1] = a.y; t[2] = a.z; t[3] = a.w; t[4] = b.x; t[5] = b.y; t[6] = b.z; t[7] = b.w;
        }
        __syncthreads();
#pragma unroll 2
        for (int i = 0; i < 4; ++i) {
            const int tt = tid + 512 * i, kvh = tt >> 9, d = (tt >> 3) & 63, ch = tt & 7, k0 = 32 * (ch >> 2) + 4 * (ch & 3);
            const LAS float* t = tile + (kvh * 64) * 65 + d;
            u32x4 o; o.x = pk2(t[(k0 + 0) * 65], t[(k0 + 1) * 65]); o.y = pk2(t[(k0 + 2) * 65], t[(k0 + 3) * 65]);
            o.z = pk2(t[(k0 + 16) * 65], t[(k0 + 17) * 65]); o.w = pk2(t[(k0 + 18) * 65], t[(k0 + 19) * 65]);
            *(u32x4*)(vdst + ((size_t)(kvh * NB + hb) * 64 + d) * 64 + 8 * ch) = o;
        }
        __syncthreads();
    }
}
DI void cmp_item(const float* srcA, const float* srcB, int pitch, int nsub, const float* posw, const float* wcmp, bf16_t* ck, bf16_t* cvt, int NK, int j0, LAS float* blkS, int tid) {
    const int col = tid, c = col >> 8, kvh = (col >> 6) & 3, d = col & 63;
    float pw[32];
#pragma unroll
    for (int r = 0; r < 32; ++r) pw[r] = posw[((c * 32 + r) * 4 + kvh) * 64 + d];
    asm volatile("" ::: "memory");
    float lo_prev = 0.f;
#pragma unroll 1
    for (int m = 0; m < nsub; ++m) {
        const float* rp = m < 8 ? srcA + (size_t)(16 * m) * pitch + col : srcB + col;
        float lo = 0.f, hi = 0.f;
#pragma unroll
        for (int r = 0; r < 16; ++r) { const float x = rp[(size_t)r * pitch]; lo += pw[r] * x; hi += pw[16 + r] * x; }
        if (m >= 1) blkS[(m - 1) * 512 + col] = lo_prev + hi;
        lo_prev = lo;
    }
    if (nsub < 9) blkS[7 * 512 + col] = 0.f;
    __syncthreads();
    float out[8];
#pragma unroll
    for (int j = 0; j < 8; ++j) out[j] = 0.f;
    const float* w = wcmp + (size_t)((c * 4 + kvh) * 64) * 64 + d;
    const LAS float* bs = blkS + (col & ~63);
#pragma unroll 4
    for (int dd = 0; dd < 64; ++dd) {
        const float wv = w[dd * 64];
#pragma unroll
        for (int j = 0; j < 8; ++j) out[j] += bs[j * 512 + dd] * wv;
    }
    const int nj = nsub - 1;
#pragma unroll
    for (int j = 0; j < 8; ++j) {
        const float val = j < nj ? out[j] : 0.f; const int key = j0 + j;
        if (c == 0) ck[((size_t)(kvh * NK + key)) * 64 + d] = f2bf(val);
        else cvt[((size_t)(kvh * 64 + d)) * NK + permkey(key)] = f2bf(val);
    }
    __syncthreads();
}
DI void phase_p0(CArgs& A, LAS unsigned char* lds, int tid, int wave, int lane) {
    unsigned char* ws = A.ws;
    const int gw = blockIdx.x * NWAVES + wave, NGW = gridDim.x * NWAVES;
    LAS float* scr = (LAS float*)(lds + wave * 16384);
    constexpr int I_DNIN = 16 * (N_DNIN / 32), I_SQ = 16 * 32, I_FIN = 16 * (2 * DFF / 32), I_FOUT = (DFF / 64) * 32, I_KV = 16 * (N_KV / 32), I_NIN = 16 * (N_NSAIN / 32);
    constexpr int NITEMS = 2 * I_DNIN + 2 * I_SQ + 4 * I_FIN + 4 * I_FOUT + I_KV + 2 * I_NIN + 2 * I_SQ;
    for (int it = gw; it < NITEMS; it += NGW) {
        int r = it;
        if (r < 2 * I_DNIN) { const int l = r / I_DNIN; r -= l * I_DNIN;
            p0_tr_item(IN_F(I_DNWIN) + (size_t)l * D * N_DNIN_REAL, N_DNIN_REAL, D, N_DNIN, N_DNIN_REAL, 0, IN_F(I_NMIX) + l * D, (bf16_t*)(ws + WS_WDNIN + l * SZ_WDNIN), scr, r, lane); continue; }
        r -= 2 * I_DNIN;
        if (r < 2 * I_SQ) { const int l = r / I_SQ; r -= l * I_SQ;
            p0_tr_item(IN_F(I_DNWOUT) + (size_t)l * D * D, D, D, D, D, 0, nullptr, (bf16_t*)(ws + WS_WDNOUT + l * SZ_WSQ), scr, r, lane); continue; }
        r -= 2 * I_SQ;
        if (r < 4 * I_FIN) { const int l = r / I_FIN; r -= l * I_FIN;
            p0_tr_item(IN_F(I_FFNWIN) + (size_t)l * D * 2 * DFF, 2 * DFF, D, 2 * DFF, 2 * DFF, 1, IN_F(I_NFFN) + l * D, (bf16_t*)(ws + WS_WFFNIN + l * SZ_WFFNIN), scr, r, lane); continue; }
        r -= 4 * I_FIN;
        if (r < 4 * I_FOUT) { const int l = r / I_FOUT; r -= l * I_FOUT;
            p0_tr_item(IN_F(I_FFNWOUT) + (size_t)l * DFF * D, D, DFF, D, D, 0, nullptr, (bf16_t*)(ws + WS_WFFNOUT + l * SZ_WFFNOUT), scr, r, lane); continue; }
        r -= 4 * I_FOUT;
        if (r < I_KV) { p0_tr_item(IN_F(I_NSAWKV), N_KV, D, N_KV, N_KV, 0, IN_F(I_NKV), (bf16_t*)(ws + WS_WKV), scr, r, lane); continue; }
        r -= I_KV;
        if (r < 2 * I_NIN) { const int l = r / I_NIN; r -= l * I_NIN;
            p0_tr_item(IN_F(I_NSAWIN) + (size_t)l * D * N_NSAIN_REAL, N_NSAIN_REAL, D, N_NSAIN, N_NSAIN_REAL, 0, IN_F(I_NMIX) + (2 + l) * D, (bf16_t*)(ws + WS_WNSAIN + l * SZ_WNSAIN), scr, r, lane); continue; }
        r -= 2 * I_NIN;
        { const int l = r / I_SQ; r -= l * I_SQ;
            p0_tr_item(IN_F(I_NSAWOUT) + (size_t)l * D * D, D, D, D, D, 0, nullptr, (bf16_t*)(ws + WS_WNSAOUT + l * SZ_WSQ), scr, r, lane); }
    }
    for (int m = gw; m < TT; m += NGW) {
        const float* xr = m < TP ? IN_F(I_XP) + (size_t)m * D : IN_F(I_XS) + (size_t)(m - TP) * D;
        p0_row(xr, (bf16_t*)(ws + WS_XB) + (size_t)m * D, (float*)(ws + WS_STATS) + (size_t)m * 16, lane);
    }
    for (int i = blockIdx.x * NTHR + tid; i < 16 * BT_STRIDE; i += gridDim.x * NTHR) {
        const int h = i / BT_STRIDE, o = i - h * BT_STRIDE;
        ((float*)(ws + WS_BT))[i] = IN_F(I_RELB)[rel_bucket_dev(o - BT_OFF) * 16 + h];
    }
    for (int i = blockIdx.x * NTHR + tid; i < 512 * 512 * 4; i += gridDim.x * NTHR) {
        const int arr = i >> 18, rem = i & 262143, bk = rem >> 9, ch = rem & 511;
        bf16_t* base = arr == 0 ? (bf16_t*)(ws + WS_KSELS) + ((size_t)(bk * 33 + 32)) * 4096 : arr == 1 ? (bf16_t*)(ws + WS_VSELS) + ((size_t)(bk * 33 + 32)) * 4096
                     : arr == 2 ? (bf16_t*)(ws + WS_KWINS) + ((size_t)(bk * 9 + 8)) * 4096 : (bf16_t*)(ws + WS_VWINS) + ((size_t)(bk * 9 + 8)) * 4096;
        *(u32x4*)(base + ch * 8) = (u32x4){0u, 0u, 0u, 0u};
    }
    __syncthreads();
    LAS float* tile = (LAS float*)lds;
    LAS float* blkS = (LAS float*)(lds + 66560);
    const int* pt = (const int*)A.in[I_PT];
    for (int it = blockIdx.x; it < 2048 + 512; it += gridDim.x) {
        if (it < 2048) {
            const int b = it >> 4, p = it & 15;
            const float* pg = IN_F(I_CACHE) + (size_t)pt[b * 16 + p] * 131072;
            const float* pg2 = p < 15 ? IN_F(I_CACHE) + (size_t)pt[b * 16 + p + 1] * 131072 : pg;
            conv_rows128(pg, 1024, 512, 768, (bf16_t*)(ws + WS_KSELS) + ((size_t)(b * 4) * 33 + 2 * p) * 4096, (bf16_t*)(ws + WS_VSELS) + ((size_t)(b * 4) * 33 + 2 * p) * 4096, 33, tile, tid);
            cmp_item(pg, pg2, 1024, p < 15 ? 9 : 8, IN_F(I_CMPPOSW), IN_F(I_WCMP), (bf16_t*)(ws + WS_CKS) + (size_t)b * 4 * 128 * 64, (bf16_t*)(ws + WS_CVS) + (size_t)b * 4 * 64 * 128, 128, 8 * p, blkS, tid);
        } else {
            const int r = it - 2048, b = r >> 2, q = r & 3;
            const float* src = IN_F(I_SWIN) + ((size_t)b * 512 + 128 * q) * 512;
            conv_rows128(src, 512, 0, 256, (bf16_t*)(ws + WS_KWINS) + ((size_t)(b * 4) * 9 + 2 * q) * 4096, (bf16_t*)(ws + WS_VWINS) + ((size_t)(b * 4) * 9 + 2 * q) * 4096, 9, tile, tid);
            float* dst = A.out + O_SW + (size_t)b * 512 * 512;
            for (int e = tid; e < 128 * 128; e += NTHR) {
                const int rr = e >> 7, c4 = e & 127, i = 128 * q + rr;
                if (i >= 4) *(f32x4*)(dst + (size_t)(i - 4) * 512 + 4 * c4) = *(const f32x4*)(src + (size_t)rr * 512 + 4 * c4);
            }
        }
    }
}
DI void unpack8(const u32x4& u, float (&x)[8]) { x[0] = bflo(u.x); x[1] = bfhi(u.x); x[2] = bflo(u.y); x[3] = bfhi(u.y); x[4] = bflo(u.z); x[5] = bfhi(u.z); x[6] = bflo(u.w); x[7] = bfhi(u.w); }
DI void phase_d2(CArgs& A, int l, int wave, int lane) {
    unsigned char* ws = A.ws;
    const int gw = blockIdx.x * NWAVES + wave, NGW = gridDim.x * NWAVES;
    const bf16_t* qkvb = (const bf16_t*)(ws + WS_QKVB);
    const float* convw = IN_F(I_DNCONVW) + (size_t)l * 4 * 3072;
    for (int it = gw; it < 2048 + 128; it += NGW) {
        const bool prm = it < 2048;
        const int tok0 = prm ? 8 * it : TP + 4 * (it - 2048), len = prm ? 8 : 4;
        const int pos0 = tok0 & 4095, b = prm ? (tok0 >> 12) : (it - 2048);
#pragma unroll 1
        for (int chunk = 0; chunk < 6; ++chunk) {
            const int part = chunk >> 1, half = chunk & 1, col = part * 1024 + half * 512 + 8 * lane;
            float w[4][8];
#pragma unroll
            for (int t = 0; t < 4; ++t) { const f32x4* p = (const f32x4*)(convw + t * 3072 + col); const f32x4 a = p[0], c = p[1]; w[t][0] = a.x; w[t][1] = a.y; w[t][2] = a.z; w[t][3] = a.w; w[t][4] = c.x; w[t][5] = c.y; w[t][6] = c.z; w[t][7] = c.w; }
            float x0[8], x1[8], x2[8];
            if (prm) {
                if (pos0 == 0) {
#pragma unroll
                    for (int e = 0; e < 8; ++e) { x0[e] = 0.f; x1[e] = 0.f; x2[e] = 0.f; }
                } else {
                    unpack8(*(const u32x4*)(qkvb + (size_t)(tok0 - 3) * 3072 + col), x0);
                    unpack8(*(const u32x4*)(qkvb + (size_t)(tok0 - 2) * 3072 + col), x1);
                    unpack8(*(const u32x4*)(qkvb + (size_t)(tok0 - 1) * 3072 + col), x2);
                }
            } else {
                const float* st = IN_F(I_SDNC) + ((size_t)(l * 128 + b) * 3) * 3072 + col;
#pragma unroll
                for (int e = 0; e < 8; ++e) { x0[e] = st[e]; x1[e] = st[3072 + e]; x2[e] = st[2 * 3072 + e]; }
            }
            bf16_t* dst = (bf16_t*)(ws + (part == 0 ? WS_QN : part == 1 ? WS_KN : WS_VB));
#pragma unroll 1
            for (int t = 0; t < len; ++t) {
                float xc[8]; unpack8(*(const u32x4*)(qkvb + (size_t)(tok0 + t) * 3072 + col), xc);
                if (prm) { if (pos0 + t >= 4093) { float* o = A.out + O_PC + ((size_t)(l * 4 + b) * 3 + (pos0 + t - 4093)) * 3072 + col;
                        *(f32x4*)o = (f32x4){xc[0], xc[1], xc[2], xc[3]}; *(f32x4*)(o + 4) = (f32x4){xc[4], xc[5], xc[6], xc[7]}; } }
                else if (t >= 1) { float* o = A.out + O_SC + ((size_t)(l * 128 + b) * 3 + (t - 1)) * 3072 + col;
                        *(f32x4*)o = (f32x4){xc[0], xc[1], xc[2], xc[3]}; *(f32x4*)(o + 4) = (f32x4){xc[4], xc[5], xc[6], xc[7]}; }
                float y[8]; float ss = 0.f;
#pragma unroll
                for (int e = 0; e < 8; ++e) { const float v = w[0][e] * x0[e] + w[1][e] * x1[e] + w[2][e] * x2[e] + w[3][e] * xc[e]; y[e] = siluf_(v); ss += y[e] * y[e]; }
                if (part < 2) {
                    ss += __shfl_xor(ss, 1); ss += __shfl_xor(ss, 2); ss += __shfl_xor(ss, 4); ss += __shfl_xor(ss, 8);
                    const float sc = rsqrtf(ss + EPS) * (part == 0 ? 0.08838834764831845f : 1.0f);
#pragma unroll
                    for (int e = 0; e < 8; ++e) y[e] *= sc;
                }
                u32x4 o; o.x = pk2(y[0], y[1]); o.y = pk2(y[2], y[3]); o.z = pk2(y[4], y[5]); o.w = pk2(y[6], y[7]);
                *(u32x4*)(dst + (size_t)(tok0 + t) * 1024 + half * 512 + 8 * lane) = o;
#pragma unroll
                for (int e = 0; e < 8; ++e) { x0[e] = x1[e]; x1[e] = x2[e]; x2[e] = xc[e]; }
            }
        }
        if (lane < 8) {
            const float al = __expf(IN_F(I_DNALOG)[l * 8 + lane]), dtb = IN_F(I_DNDTB)[l * 8 + lane];
            for (int t = 0; t < len; ++t) {
                const float* ab = (const float*)(ws + WS_AB) + (size_t)(tok0 + t) * 16;
                const float xa = ab[lane] + dtb, xb = ab[8 + lane];
                const float sp = fmaxf(xa, 0.f) + log1pf(__expf(-fabsf(xa)));
                ((float*)(ws + WS_GG))[(size_t)(tok0 + t) * 8 + lane] = -al * sp;
                ((float*)(ws + WS_BETA))[(size_t)(tok0 + t) * 8 + lane] = sigmoidf_(xb);
            }
        }
    }
}
DI void phase_d3(CArgs& A, LAS unsigned char* lds, int wave, int lane) {
    unsigned char* ws = A.ws;
    const int gw = blockIdx.x * NWAVES + wave, NGW = gridDim.x * NWAVES;
    const int fr = lane & 15, fq = lane >> 4;
    LAS float* As = (LAS float*)(lds + wave * 16384);
    LAS bf16_t* Tp = (LAS bf16_t*)(lds + wave * 16384);
    LAS float* sc = (LAS float*)(lds + LDS_MISC + wave * 1024);
    bf16x8 I0, I1;
#pragma unroll
    for (int jj = 0; jj < 8; ++jj) { I0[jj] = (8 * fq + jj == fr) ? (short)0x3F80 : (short)0; I1[jj] = (8 * fq + jj == 16 + fr) ? (short)0x3F80 : (short)0; }
    const f32x4 zero4 = {0.f, 0.f, 0.f, 0.f};
    for (int idx = gw; idx < 2048; idx += NGW) {
        const int b = idx >> 9, n = (idx >> 3) & 63, h = idx & 7, tok0 = b * 4096 + 64 * n;
        unsigned char* pack = ws + WS_PACK + (size_t)idx * PK_SIZE;
        float G = ((const float*)(ws + WS_GG))[(size_t)(tok0 + lane) * 8 + h];
        const float bt = ((const float*)(ws + WS_BETA))[(size_t)(tok0 + lane) * 8 + h];
#pragma unroll
        for (int o = 1; o < 64; o <<= 1) { const float t = __shfl_up(G, o); if (lane >= o) G += t; }
        const float Glast = __shfl(G, 63), eG = __expf(G), kd = __expf(Glast - G);
        sc[lane] = G; sc[64 + lane] = bt; sc[128 + lane] = eG; sc[192 + lane] = kd;
        ((float*)(ws + WS_EG))[(size_t)idx * 64 + lane] = eG;
        if (lane == 0) ((float*)(ws + WS_GL))[idx] = __expf(Glast);
        LDS_WAIT();
        bf16x8 Kf[4][4], Qf[4][4];
#pragma unroll
        for (int t = 0; t < 4; ++t)
#pragma unroll
            for (int ks = 0; ks < 4; ++ks) {
                const size_t off = (size_t)(tok0 + 16 * t + fr) * 1024 + h * 128 + 32 * ks + 8 * fq;
                Kf[t][ks] = *(const bf16x8*)((const bf16_t*)(ws + WS_KN) + off);
                Qf[t][ks] = *(const bf16x8*)((const bf16_t*)(ws + WS_QN) + off);
            }
#pragma unroll
        for (int it = 0; it < 4; ++it)
#pragma unroll
            for (int ks = 0; ks < 4; ++ks) {
                const f32x4 c0 = MFMA16(I0, Qf[it][ks], zero4), c1 = MFMA16(I1, Qf[it][ks], zero4);
                *(bf16x8*)(pack + PK_QF + ((size_t)((it * 4 + ks) * 64 + lane)) * 16) = pack8(c0, c1);
            }
#pragma unroll
        for (int it = 0; it < 4; ++it) {
            const float Gi = sc[16 * it + fr];
#pragma unroll
            for (int ks2 = 0; ks2 < 2; ++ks2) {
                f32x4 tl[2];
#pragma unroll
                for (int hh = 0; hh < 2; ++hh) {
                    const int jt = 2 * ks2 + hh;
                    f32x4 c = zero4;
                    if (jt <= it) {
#pragma unroll
                        for (int ks = 0; ks < 4; ++ks) c = MFMA16(Kf[jt][ks], Qf[it][ks], c);
#pragma unroll
                        for (int r = 0; r < 4; ++r) { const int j = 16 * jt + 4 * fq + r, i = 16 * it + fr; const float dc = __expf(Gi - sc[j]); c[r] = (i >= j) ? dc * c[r] : 0.f; }
                    }
                    tl[hh] = c;
                }
                *(bf16x8*)(pack + PK_AQK + ((size_t)((it * 2 + ks2) * 64 + lane)) * 16) = pack8(tl[0], tl[1]);
            }
        }
#pragma unroll
        for (int it = 0; it < 4; ++it)
#pragma unroll
            for (int jt = 0; jt < 4; ++jt) {
                if (jt <= it) {
                    f32x4 c = zero4;
#pragma unroll
                    for (int ks = 0; ks < 4; ++ks) c = MFMA16(Kf[it][ks], Kf[jt][ks], c);
                    const float Gj = sc[16 * jt + fr];
#pragma unroll
                    for (int r = 0; r < 4; ++r) { const int i = 16 * it + 4 * fq + r, j = 16 * jt + fr; const float v = sc[64 + i] * __expf(sc[i] - Gj) * c[r]; As[i * 64 + j] = (i > j) ? v : 0.f; }
                }
            }
        LDS_WAIT();
        asm volatile("" ::: "memory");
        float t[64];
        int lane_o = lane; asm volatile("" : "+v"(lane_o));
        float arow_nx = As[lane];
#pragma unroll
        for (int i = 0; i < 64; ++i) {
            const float arow = arow_nx;
            if (i < 63) arow_nx = As[(i + 1) * 64 + lane];
            asm volatile("" ::: "memory");
            float a0 = (lane_o == i) ? 1.f : 0.f, a1 = 0.f, a2 = 0.f, a3 = 0.f;
#pragma unroll
            for (int j = 0; j < i; ++j) {
                const float s = __builtin_bit_cast(float, __builtin_amdgcn_readlane(__builtin_bit_cast(int, arow), j));
                if ((j & 3) == 0) a0 -= s * t[j]; else if ((j & 3) == 1) a1 -= s * t[j]; else if ((j & 3) == 2) a2 -= s * t[j]; else a3 -= s * t[j];
            }
            t[i] = (a0 + a1) + (a2 + a3);
        }
        { const float bcol = sc[64 + lane];
#pragma unroll
          for (int i = 0; i < 64; ++i) Tp[i * 64 + lane] = f2bf(t[i] * bcol); }
        LDS_WAIT();
        bf16x8 Tf[4][2];
#pragma unroll
        for (int it = 0; it < 4; ++it)
#pragma unroll
            for (int ks2 = 0; ks2 < 2; ++ks2) {
                const LAS bf16_t* rp = Tp + (16 * it + fr) * 64 + 32 * ks2 + 4 * fq;
                const u32x2 lo = *(const LAS u32x2*)rp, hi = *(const LAS u32x2*)(rp + 16);
                u32x4 v; v.x = lo.x; v.y = lo.y; v.z = hi.x; v.w = hi.y; Tf[it][ks2] = __builtin_bit_cast(bf16x8, v);
            }
        asm volatile("" ::: "memory");
        bf16x8 Kg[4][4];
#pragma unroll
        for (int t2 = 0; t2 < 4; ++t2)
#pragma unroll
            for (int ks = 0; ks < 4; ++ks)
                Kg[t2][ks] = *(const bf16x8*)((const bf16_t*)(ws + WS_KN) + (size_t)(tok0 + 16 * t2 + fr) * 1024 + h * 128 + 32 * ks + 8 * fq);
#pragma unroll
        for (int ks = 0; ks < 4; ++ks) {
            bf16x8 R2f[2][2];
#pragma unroll
            for (int hh = 0; hh < 2; ++hh) {
                const int dkt = 2 * ks + hh;
#pragma unroll
                for (int ks2 = 0; ks2 < 2; ++ks2) {
                    f32x4 r2[2], r3[2];
#pragma unroll
                    for (int g = 0; g < 2; ++g) {
                        const int jt = 2 * ks2 + g;
                        const f32x4 kc = MFMA16(Kg[jt][ks], hh ? I1 : I0, zero4);
#pragma unroll
                        for (int r = 0; r < 4; ++r) { const int j = 16 * jt + 4 * fq + r; r2[g][r] = kc[r] * sc[128 + j]; r3[g][r] = kc[r] * sc[192 + j]; }
                    }
                    R2f[hh][ks2] = pack8(r2[0], r2[1]);
                    *(bf16x8*)(pack + PK_KDF + ((size_t)((dkt * 2 + ks2) * 64 + lane)) * 16) = pack8(r3[0], r3[1]);
                }
            }
#pragma unroll
            for (int it = 0; it < 4; ++it) {
                f32x4 c0 = zero4, c1 = zero4;
#pragma unroll
                for (int ks2 = 0; ks2 < 2; ++ks2) { c0 = MFMA16(R2f[0][ks2], Tf[it][ks2], c0); c1 = MFMA16(R2f[1][ks2], Tf[it][ks2], c1); }
                *(bf16x8*)(pack + PK_WKF + ((size_t)((it * 4 + ks) * 64 + lane)) * 16) = pack8(-c0, -c1);
            }
        }
        asm volatile("" ::: "memory");
        bf16x8 Vf[4][4];
#pragma unroll
        for (int t2 = 0; t2 < 4; ++t2)
#pragma unroll
            for (int ks = 0; ks < 4; ++ks)
                Vf[t2][ks] = *(const bf16x8*)((const bf16_t*)(ws + WS_VB) + (size_t)(tok0 + 16 * t2 + fr) * 1024 + h * 128 + 32 * ks + 8 * fq);
#pragma unroll
        for (int dvt = 0; dvt < 8; ++dvt) {
            bf16x8 R1f[2];
#pragma unroll
            for (int ks2 = 0; ks2 < 2; ++ks2) {
                const f32x4 v0 = MFMA16(Vf[2 * ks2][dvt >> 1], (dvt & 1) ? I1 : I0, zero4), v1 = MFMA16(Vf[2 * ks2 + 1][dvt >> 1], (dvt & 1) ? I1 : I0, zero4);
                R1f[ks2] = pack8(v0, v1);
            }
#pragma unroll
            for (int it = 0; it < 4; ++it) {
                f32x4 c = zero4;
#pragma unroll
                for (int ks2 = 0; ks2 < 2; ++ks2) c = MFMA16(Tf[it][ks2], R1f[ks2], c);
                u32x2 w; w.x = pk2(c.x, c.y); w.y = pk2(c.z, c.w);
                *(u32x2*)(pack + PK_WVC + ((size_t)((it * 8 + dvt) * 64 + lane)) * 8) = w;
            }
        }
        LDS_WAIT();
    }
}
DI void d4_scan_prompt(CArgs& A, int l, int bh, int wave, int lane) {
    unsigned char* ws = A.ws;
    const int b = bh >> 3, h = bh & 7, fr = lane & 15, fq = lane >> 4, w = wave;
    f32x4 S[8];
#pragma unroll
    for (int i = 0; i < 8; ++i) S[i] = (f32x4){0.f, 0.f, 0.f, 0.f};
    const float* EGp = (const float*)(ws + WS_EG);
    const float* GLp = (const float*)(ws + WS_GL);
    bf16_t* ob = (bf16_t*)(ws + WS_OB);
#pragma unroll 1
    for (int n = 0; n < 64; ++n) {
        const int idx = (b * 64 + n) * 8 + h;
        const unsigned char* pack = ws + WS_PACK + (size_t)idx * PK_SIZE;
        const float gl = GLp[idx];
        bf16x8 Sb[4];
#pragma unroll
        for (int ks = 0; ks < 4; ++ks) Sb[ks] = pack8(S[2 * ks], S[2 * ks + 1]);
        f32x4 U[4];
#pragma unroll
        for (int it = 0; it < 4; ++it) {
            const u32x2 wv = *(const u32x2*)(pack + PK_WVC + ((size_t)((it * 8 + w) * 64 + lane)) * 8);
            f32x4 c = {bflo(wv.x), bfhi(wv.x), bflo(wv.y), bfhi(wv.y)};
#pragma unroll
            for (int ks = 0; ks < 4; ++ks) c = MFMA16(*(const bf16x8*)(pack + PK_WKF + ((size_t)((it * 4 + ks) * 64 + lane)) * 16), Sb[ks], c);
            U[it] = c;
        }
        bf16x8 Ub[2];
        Ub[0] = pack8(U[0], U[1]); Ub[1] = pack8(U[2], U[3]);
#pragma unroll
        for (int it = 0; it < 4; ++it) {
            f32x4 c = {0.f, 0.f, 0.f, 0.f};
#pragma unroll
            for (int ks = 0; ks < 4; ++ks) c = MFMA16(Sb[ks], *(const bf16x8*)(pack + PK_QF + ((size_t)((it * 4 + ks) * 64 + lane)) * 16), c);
            const float eg = EGp[(size_t)idx * 64 + 16 * it + fr];
            c = c * eg;
#pragma unroll
            for (int ks2 = 0; ks2 < 2; ++ks2) c = MFMA16(Ub[ks2], *(const bf16x8*)(pack + PK_AQK + ((size_t)((it * 2 + ks2) * 64 + lane)) * 16), c);
            u32x2 o; o.x = pk2(c.x, c.y); o.y = pk2(c.z, c.w);
            *(u32x2*)(ob + (size_t)(b * 4096 + 64 * n + 16 * it + fr) * 1024 + h * 128 + 16 * w + 4 * fq) = o;
        }
#pragma unroll
        for (int dkt = 0; dkt < 8; ++dkt) {
            f32x4 c = S[dkt] * gl;
#pragma unroll
            for (int ks2 = 0; ks2 < 2; ++ks2) c = MFMA16(*(const bf16x8*)(pack + PK_KDF + ((size_t)((dkt * 2 + ks2) * 64 + lane)) * 16), Ub[ks2], c);
            S[dkt] = c;
        }
    }
    float* so = A.out + O_PS + ((size_t)((l * 4 + b) * 8 + h)) * 16384;
#pragma unroll
    for (int dkt = 0; dkt < 8; ++dkt)
#pragma unroll
        for (int r = 0; r < 4; ++r) so[(size_t)(16 * dkt + 4 * fq + r) * 128 + 16 * w + fr] = S[dkt][r];
}
DI void d4_sample_item(CArgs& A, int l, int item, LAS float* L, int tid, int wave, int lane) {
    unsigned char* ws = A.ws;
    const int b = item >> 3, h = item & 7, tok0 = TP + 4 * b;
    LAS float* sq = L;
    LAS float* sk = L + 512;
    LAS float* sv = L + 1024;
    LAS float* sgb = L + 1536;
    LAS float* dots = L + 1544;
    LAS float* red = L + 1600;
    const int dv = tid & 127, dkq = tid >> 7;
    for (int i2 = tid; i2 < 1536; i2 += NTHR) {
        const int part = i2 >> 9, i = (i2 >> 7) & 3, d = i2 & 127;
        const bf16_t* src = (const bf16_t*)(ws + (part == 0 ? WS_QN : part == 1 ? WS_KN : WS_VB));
        L[i2] = bf2f(src[(size_t)(tok0 + i) * 1024 + h * 128 + d]);
    }
    if (tid < 4) { sgb[tid] = ((const float*)(ws + WS_GG))[(size_t)(tok0 + tid) * 8 + h]; sgb[4 + tid] = ((const float*)(ws + WS_BETA))[(size_t)(tok0 + tid) * 8 + h]; }
    const float* S0 = IN_F(I_SDNS) + ((size_t)((l * 128 + b) * 8 + h)) * 16384;
    float s0[32];
#pragma unroll
    for (int u = 0; u < 32; ++u) s0[u] = S0[(size_t)(32 * dkq + u) * 128 + dv];
    __syncthreads();
#pragma unroll
    for (int u = 0; u < 4; ++u) {
        const int p = 4 * wave + u, i = (p >> 2) & 3, j = p & 3;
        const LAS float* a = (p < 16) ? sk + i * 128 : sq + i * 128;
        float s = a[lane] * sk[j * 128 + lane] + a[lane + 64] * sk[j * 128 + lane + 64];
        s = wave_sum(s);
        if (lane == 0) dots[p] = s;
    }
    __syncthreads();
    float G[4], bt[4], eG[4];
    { float acc = 0.f;
#pragma unroll
      for (int i = 0; i < 4; ++i) { acc += sgb[i]; G[i] = acc; bt[i] = sgb[4 + i]; eG[i] = __expf(acc); } }
    float Am[4][4], T[4][4];
#pragma unroll
    for (int i = 0; i < 4; ++i)
#pragma unroll
        for (int j = 0; j < 4; ++j) { Am[i][j] = (i > j) ? bt[i] * __expf(G[i] - G[j]) * dots[i * 4 + j] : 0.f; T[i][j] = (i == j) ? 1.f : 0.f; }
#pragma unroll
    for (int i = 1; i < 4; ++i)
#pragma unroll
        for (int c = 0; c < i; ++c) { float acc = 0.f;
#pragma unroll
            for (int j = c; j < i; ++j) acc -= Am[i][j] * T[j][c];
            T[i][c] = acc; }
    float pU[4] = {0.f, 0.f, 0.f, 0.f}, pQ[4] = {0.f, 0.f, 0.f, 0.f};
#pragma unroll 4
    for (int u = 0; u < 32; ++u) {
        const int dk = 32 * dkq + u;
        float kj[4], qj[4];
#pragma unroll
        for (int j = 0; j < 4; ++j) { kj[j] = sk[j * 128 + dk]; qj[j] = sq[j * 128 + dk]; }
#pragma unroll
        for (int i = 0; i < 4; ++i) {
            float wk = 0.f;
#pragma unroll
            for (int j = 0; j <= i; ++j) wk += T[i][j] * bt[j] * eG[j] * kj[j];
            pU[i] += wk * s0[u]; pQ[i] += qj[i] * s0[u];
        }
    }
#pragma unroll
    for (int i = 0; i < 4; ++i) { red[(i * 4 + dkq) * 128 + dv] = pU[i]; red[((4 + i) * 4 + dkq) * 128 + dv] = pQ[i]; }
    __syncthreads();
    float U[4];
#pragma unroll
    for (int i = 0; i < 4; ++i) {
        float wv = 0.f;
#pragma unroll
        for (int j = 0; j <= i; ++j) wv += T[i][j] * bt[j] * sv[j * 128 + dv];
        U[i] = wv - ((red[(i * 4 + 0) * 128 + dv] + red[(i * 4 + 1) * 128 + dv]) + (red[(i * 4 + 2) * 128 + dv] + red[(i * 4 + 3) * 128 + dv]));
    }
    if (dkq == 0) {
#pragma unroll
        for (int i = 0; i < 4; ++i) {
            float o = eG[i] * ((red[((4 + i) * 4 + 0) * 128 + dv] + red[((4 + i) * 4 + 1) * 128 + dv]) + (red[((4 + i) * 4 + 2) * 128 + dv] + red[((4 + i) * 4 + 3) * 128 + dv]));
#pragma unroll
            for (int j = 0; j <= i; ++j) o += __expf(G[i] - G[j]) * dots[16 + i * 4 + j] * U[j];
            ((bf16_t*)(ws + WS_OB))[(size_t)(tok0 + i) * 1024 + h * 128 + dv] = f2bf(o);
        }
    }
    const float gl = eG[3];
    float* So = A.out + O_SS + ((size_t)((l * 128 + b) * 8 + h)) * 16384;
#pragma unroll 4
    for (int u = 0; u < 32; ++u) {
        const int dk = 32 * dkq + u;
        float acc = gl * s0[u];
#pragma unroll
        for (int i = 0; i < 4; ++i) acc += __expf(G[3] - G[i]) * sk[i * 128 + dk] * U[i];
        So[(size_t)dk * 128 + dv] = acc;
    }
    __syncthreads();
}
DI void phase_d4(CArgs& A, int l, LAS unsigned char* lds, int tid, int wave, int lane) {
    if (blockIdx.x < 32) d4_scan_prompt(A, l, blockIdx.x, wave, lane);
    else for (int it = blockIdx.x - 32; it < 1024; it += gridDim.x - 32) d4_sample_item(A, l, it, (LAS float*)lds, tid, wave, lane);
}
DI void phase_d5(CArgs& A, int l, int wave, int lane) {
    unsigned char* ws = A.ws;
    const int gw = blockIdx.x * NWAVES + wave, NGW = gridDim.x * NWAVES;
    const float* onw = IN_F(I_DNONORM) + l * 128;
    float wn[8];
#pragma unroll
    for (int e = 0; e < 8; ++e) wn[e] = onw[(8 * lane + e) & 127];
    for (int tok = gw; tok < TT; tok += NGW) {
#pragma unroll
        for (int half = 0; half < 2; ++half) {
            const size_t off = (size_t)tok * 1024 + half * 512 + 8 * lane;
            float o[8], z[8];
            unpack8(*(const u32x4*)((const bf16_t*)(ws + WS_OB) + off), o);
            unpack8(*(const u32x4*)((const bf16_t*)(ws + WS_ZB) + off), z);
            float ss = 0.f;
#pragma unroll
            for (int e = 0; e < 8; ++e) ss += o[e] * o[e];
            ss += __shfl_xor(ss, 1); ss += __shfl_xor(ss, 2); ss += __shfl_xor(ss, 4); ss += __shfl_xor(ss, 8);
            const float r = rsqrtf(ss * (1.0f / 128.0f) + EPS);
            float y[8];
#pragma unroll
            for (int e = 0; e < 8; ++e) y[e] = o[e] * r * wn[e] * siluf_(z[e]);
            u32x4 w; w.x = pk2(y[0], y[1]); w.y = pk2(y[2], y[3]); w.z = pk2(y[4], y[5]); w.w = pk2(y[6], y[7]);
            *(u32x4*)((bf16_t*)(ws + WS_OB) + off) = w;
        }
    }
}
DI void phase_n1(CArgs& A, LAS unsigned char* lds, int tid) {
    unsigned char* ws = A.ws;
    LAS float* blkS = (LAS float*)lds;
    for (int it = blockIdx.x; it < 128; it += gridDim.x) {
        const int b = it >> 5, g = it & 31;
        const float* src = A.out + O_PKV + ((size_t)b * 4096 + 128 * g) * 1024;
        cmp_item(src, src + 128 * 1024, 1024, g < 31 ? 9 : 8, IN_F(I_CMPPOSW), IN_F(I_WCMP), (bf16_t*)(ws + WS_CKP) + (size_t)b * 4 * 256 * 64, (bf16_t*)(ws + WS_CVP) + (size_t)b * 4 * 64 * 256, 256, 8 * g, blkS, tid);
    }
}
struct AttnState { float m, l; f32x4 o[4]; };
template <int MODE>
DI void attend_block(const bf16_t* Kb, const bf16_t* Vb, const bf16x8 (&Qf)[2], int dist0, bool colsel, bool far, float biasfar, const LAS float* bp, AttnState& st, int fr, int fq) {
    f32x4 s[4];
#pragma unroll
    for (int kt = 0; kt < 4; ++kt) {
        const bf16_t* kp = Kb + (16 * kt + fr) * 64 + 8 * fq;
        f32x4 z = {0.f, 0.f, 0.f, 0.f};
        z = MFMA16(*(const bf16x8*)kp, Qf[0], z); z = MFMA16(*(const bf16x8*)(kp + 32), Qf[1], z);
        s[kt] = z;
    }
    float bm = -1e30f;
#pragma unroll
    for (int kt = 0; kt < 4; ++kt)
#pragma unroll
        for (int r = 0; r < 4; ++r) {
            const int dist = dist0 - 16 * kt - r;
            const bool valid = (MODE == 0) ? (colsel && dist >= 0) : (dist >= 0 && dist < 512);
            const float bias = far ? biasfar : bp[-(16 * kt + r)];
            const float v = valid ? s[kt][r] + bias : -1e30f;
            s[kt][r] = v; bm = fmaxf(bm, v);
        }
    bm = fmaxf(bm, __shfl_xor(bm, 16)); bm = fmaxf(bm, __shfl_xor(bm, 32));
    const float mn = fmaxf(st.m, bm), alpha = __expf(st.m - mn);
    st.m = mn;
    float ps = 0.f;
#pragma unroll
    for (int kt = 0; kt < 4; ++kt)
#pragma unroll
        for (int r = 0; r < 4; ++r) { const float p = (s[kt][r] > -1e29f) ? __expf(s[kt][r] - mn) : 0.f; s[kt][r] = p; ps += p; }
    st.l = st.l * alpha + ps;
    bf16x8 Pf[2]; Pf[0] = pack8(s[0], s[1]); Pf[1] = pack8(s[2], s[3]);
#pragma unroll
    for (int dt = 0; dt < 4; ++dt) {
        f32x4 c = st.o[dt] * alpha;
        const bf16_t* vp = Vb + (16 * dt + fr) * 64 + 8 * fq;
        c = MFMA16(*(const bf16x8*)vp, Pf[0], c); c = MFMA16(*(const bf16x8*)(vp + 32), Pf[1], c);
        st.o[dt] = c;
    }
}
DI void phase_attn(CArgs& A, LAS unsigned char* lds, int tid, int wave, int lane) {
    unsigned char* ws = A.ws;
    const int fr = lane & 15, fq = lane >> 4, qa = fr >> 2, hh = fr & 3;
    LAS float* BTl = (LAS float*)lds;
    LAS float* scoreL = (LAS float*)(lds + 16 * BT_STRIDE * 4 + wave * 1024);
    for (int i = tid; i < 16 * BT_STRIDE; i += NTHR) BTl[i] = ((const float*)(ws + WS_BT))[i];
    __syncthreads();
    const int gw = blockIdx.x * NWAVES + wave, NGW = gridDim.x * NWAVES;
    const bf16_t* QB = (const bf16_t*)(ws + WS_QB);
    for (int wi = gw; wi < 512 + 16384; wi += NGW) {
        const bool smp = wi < 512;
        int b, kvh, tok0, qpos0;
        if (smp) { b = wi >> 2; kvh = wi & 3; tok0 = TP + 4 * b; qpos0 = 2048; }
        else { const int id = wi - 512, g4 = id >> 4, bk = id & 15; b = bk >> 2; kvh = bk & 3; tok0 = b * 4096 + 4 * g4; qpos0 = 4 * g4; }
        const int NK = smp ? 128 : 256, nblk = smp ? 33 : 64;
        const bf16_t* CK = smp ? (const bf16_t*)(ws + WS_CKS) + (size_t)(b * 4 + kvh) * 128 * 64 : (const bf16_t*)(ws + WS_CKP) + (size_t)(b * 4 + kvh) * 256 * 64;
        const bf16_t* CV = smp ? (const bf16_t*)(ws + WS_CVS) + (size_t)(b * 4 + kvh) * 64 * 128 : (const bf16_t*)(ws + WS_CVP) + (size_t)(b * 4 + kvh) * 64 * 256;
        const bf16_t* KS = smp ? (const bf16_t*)(ws + WS_KSELS) + (size_t)(b * 4 + kvh) * 33 * 4096 : (const bf16_t*)(ws + WS_KSELP) + (size_t)(b * 4 + kvh) * 64 * 4096;
        const bf16_t* VS = smp ? (const bf16_t*)(ws + WS_VSELS) + (size_t)(b * 4 + kvh) * 33 * 4096 : (const bf16_t*)(ws + WS_VSELP) + (size_t)(b * 4 + kvh) * 64 * 4096;
        const bf16_t* KW = smp ? (const bf16_t*)(ws + WS_KWINS) + ((ptrdiff_t)(b * 4 + kvh) * 9 - 24) * 4096 : (const bf16_t*)(ws + WS_KWINP) + (size_t)(b * 4 + kvh) * 64 * 4096;
        const bf16_t* VW = smp ? (const bf16_t*)(ws + WS_VWINS) + ((ptrdiff_t)(b * 4 + kvh) * 9 - 24) * 4096 : (const bf16_t*)(ws + WS_VWINP) + (size_t)(b * 4 + kvh) * 64 * 4096;
        const int qpos = qpos0 + qa, qmax = qpos0 + 3, qmin = qpos0, hg = 4 * kvh + hh, tok = tok0 + qa;
        const LAS float* bth = BTl + hg * BT_STRIDE + BT_OFF;
        const float biasfar = bth[1024];
        bf16x8 Qf[2];
        Qf[0] = *(const bf16x8*)(QB + (size_t)tok * 1024 + hg * 64 + 8 * fq);
        Qf[1] = *(const bf16x8*)(QB + (size_t)tok * 1024 + hg * 64 + 32 + 8 * fq);
        const float* gp = (const float*)(ws + WS_GATES) + (size_t)tok * 48 + hg * 3;
        const float g_cmp = gp[0], g_sel = gp[1], g_win = gp[2];
        f32x4 OUT[4];
        const int ncv = qmax >= 31 ? ((qmax - 31) >> 4) + 1 : 0;
        const int ntile = (ncv + 15) >> 4;
        f32x4 lg[16];
#pragma unroll
        for (int kt = 0; kt < 16; ++kt) {
            if (kt < ntile) {
                const bf16_t* kp = CK + (size_t)(16 * kt + fr) * 64 + 8 * fq;
                f32x4 z = {0.f, 0.f, 0.f, 0.f};
                z = MFMA16(*(const bf16x8*)kp, Qf[0], z); z = MFMA16(*(const bf16x8*)(kp + 32), Qf[1], z);
#pragma unroll
                for (int r = 0; r < 4; ++r) {
                    const int c = 16 * kt + 4 * fq + r, dist = qpos - (16 * c + 31);
                    int di = dist < -BT_OFF ? -BT_OFF : dist; di = di > 1100 ? 1100 : di;
                    z[r] = dist >= 0 ? z[r] + bth[di] : -1e30f;
                }
                lg[kt] = z;
            } else lg[kt] = (f32x4){-1e30f, -1e30f, -1e30f, -1e30f};
        }
        float mx = -1e30f;
#pragma unroll
        for (int kt = 0; kt < 16; ++kt) mx = fmaxf(fmaxf(fmaxf(mx, lg[kt][0]), fmaxf(lg[kt][1], lg[kt][2])), lg[kt][3]);
        mx = fmaxf(mx, __shfl_xor(mx, 16)); mx = fmaxf(mx, __shfl_xor(mx, 32));
        float sm = 0.f;
#pragma unroll
        for (int kt = 0; kt < 16; ++kt)
#pragma unroll
            for (int r = 0; r < 4; ++r) { const float p = lg[kt][r] > -1e29f ? __expf(lg[kt][r] - mx) : 0.f; lg[kt][r] = p; sm += p; }
        sm += __shfl_xor(sm, 16); sm += __shfl_xor(sm, 32);
        const float inv = 1.0f / fmaxf(sm, 1e-30f);
#pragma unroll
        for (int kt = 0; kt < 16; ++kt) lg[kt] = lg[kt] * inv;
#pragma unroll
        for (int dt = 0; dt < 4; ++dt) OUT[dt] = (f32x4){0.f, 0.f, 0.f, 0.f};
#pragma unroll
        for (int s2 = 0; s2 < 8; ++s2) {
            if (2 * s2 < ntile) {
                const bf16x8 Pf = pack8(lg[2 * s2], lg[2 * s2 + 1]);
#pragma unroll
                for (int dt = 0; dt < 4; ++dt) OUT[dt] = MFMA16(*(const bf16x8*)(CV + (size_t)(16 * dt + fr) * NK + 32 * s2 + 8 * fq), Pf, OUT[dt]);
            }
        }
#pragma unroll
        for (int dt = 0; dt < 4; ++dt) OUT[dt] = OUT[dt] * g_cmp;
        const int cur = qpos >> 6;
        {
            float prevx3 = 0.f;
#pragma unroll
            for (int kt = 0; kt < 16; ++kt) {
                f32x4 x = lg[kt];
#pragma unroll
                for (int r = 0; r < 4; ++r) { x[r] += __shfl_xor(x[r], 1); x[r] += __shfl_xor(x[r], 2); }
                const float up = __shfl(x[3], (lane + 48) & 63);
                const float pv = fq > 0 ? up : prevx3;
                prevx3 = __shfl(x[3], fr + 48);
                const float pslc = 2.0f * (x[0] + x[1] + x[2]) + x[3] + pv;
                const int blk = 4 * kt + fq;
                const bool forced = (blk == 0) | (blk == cur) | (blk == cur - 1);
                float sc = forced ? 1e4f : (blk <= cur ? pslc : -1.0f);
                if (blk >= nblk) sc = -3e38f;
                if (hh == 0) scoreL[qa * 64 + blk] = sc;
            }
        }
        LDS_WAIT();
        unsigned long long msel[4];
#pragma unroll
        for (int q = 0; q < 4; ++q) {
            const float s = scoreL[q * 64 + lane];
            int rank = 0;
#pragma unroll
            for (int p4 = 0; p4 < 16; ++p4) {
                const f32x4 v = *(const LAS f32x4*)(scoreL + q * 64 + 4 * p4);
#pragma unroll
                for (int e = 0; e < 4; ++e) { const int p = 4 * p4 + e; rank += (v[e] > s || (v[e] == s && p < lane)) ? 1 : 0; }
            }
            const int curq = (qpos0 + q) >> 6;
            const unsigned long long vm = curq >= 63 ? ~0ull : ((1ull << (curq + 1)) - 1ull);
            msel[q] = __ballot(rank < 16) & vm;
        }
        LDS_WAIT();
        const unsigned long long mymask = qa == 0 ? msel[0] : qa == 1 ? msel[1] : qa == 2 ? msel[2] : msel[3];
        {
            AttnState st; st.m = -1e30f; st.l = 0.f;
#pragma unroll
            for (int dt = 0; dt < 4; ++dt) st.o[dt] = (f32x4){0.f, 0.f, 0.f, 0.f};
            unsigned long long um = msel[0] | msel[1] | msel[2] | msel[3];
            while (um) {
                const int blk = __builtin_ctzll(um); um &= um - 1ull;
                const int bpos = 64 * blk;
                const bool far = (qmin - bpos - 63) >= 1024;
                const int dist0 = qpos - bpos - 4 * fq;
                attend_block<0>(KS + (size_t)blk * 4096, VS + (size_t)blk * 4096, Qf, dist0, ((mymask >> blk) & 1ull) != 0ull, far, biasfar, bth + dist0, st, fr, fq);
            }
            float l = st.l; l += __shfl_xor(l, 16); l += __shfl_xor(l, 32);
            const float sc = g_sel / fmaxf(l, 1e-30f);
#pragma unroll
            for (int dt = 0; dt < 4; ++dt) OUT[dt] += st.o[dt] * sc;
        }
        {
            AttnState st; st.m = -1e30f; st.l = 0.f;
#pragma unroll
            for (int dt = 0; dt < 4; ++dt) st.o[dt] = (f32x4){0.f, 0.f, 0.f, 0.f};
            const int lo = qmin - 511 > 0 ? (qmin - 511) >> 6 : 0, hi = qmax >> 6;
            for (int blk = lo; blk <= hi; ++blk) {
                const int bpos = 64 * blk, dist0 = qpos - bpos - 4 * fq;
                attend_block<1>(KW + (size_t)blk * 4096, VW + (size_t)blk * 4096, Qf, dist0, true, false, biasfar, bth + dist0, st, fr, fq);
            }
            float l = st.l; l += __shfl_xor(l, 16); l += __shfl_xor(l, 32);
            const float sc = g_win / fmaxf(l, 1e-30f);
#pragma unroll
            for (int dt = 0; dt < 4; ++dt) OUT[dt] += st.o[dt] * sc;
        }
        bf16_t* op = (bf16_t*)(ws + WS_OB) + (size_t)tok * 1024 + hg * 64 + 4 * fq;
#pragma unroll
        for (int dt = 0; dt < 4; ++dt) { u32x2 w; w.x = pk2(OUT[dt].x, OUT[dt].y); w.y = pk2(OUT[dt].z, OUT[dt].w); *(u32x2*)(op + 16 * dt) = w; }
    }
}
DI void phase_final(CArgs& A, int wave, int lane) {
    unsigned char* ws = A.ws;
    const int gw = blockIdx.x * NWAVES + wave, NGW = gridDim.x * NWAVES;
    const float* nw = IN_F(I_NFIN);
    f32x4 w4[4];
#pragma unroll
    for (int j = 0; j < 4; ++j) w4[j] = *((const f32x4*)nw + lane + 64 * j);
    for (int m = gw; m < TT; m += NGW) {
        const f32x4* xr = (const f32x4*)((const float*)(ws + WS_X) + (size_t)m * D) + lane; f32x4 v[4]; float s = 0.f;
#pragma unroll
        for (int j = 0; j < 4; ++j) { v[j] = xr[64 * j]; s += (v[j].x * v[j].x + v[j].y * v[j].y) + (v[j].z * v[j].z + v[j].w * v[j].w); }
        s = wave_sum(s);
        const float rs = rsqrtf(s * (1.0f / 1024.0f) + EPS);
        f32x4* o = (f32x4*)(A.out + O_Y + (size_t)m * D) + lane;
#pragma unroll
        for (int j = 0; j < 4; ++j) o[64 * j] = v[j] * rs * w4[j];
    }
}
constexpr int NPH = 30;
__global__ void __launch_bounds__(NTHR, 2) mk_fwd(Args A_) {
    CArgs& A = *(CArgs*)__builtin_amdgcn_kernarg_segment_ptr();
    extern __shared__ __attribute__((aligned(16))) unsigned char lds_raw[];
    LAS unsigned char* lds = (LAS unsigned char*)lds_raw;
    const int tid = threadIdx.x, lane = tid & 63, wave = __builtin_amdgcn_readfirstlane(tid >> 6);
    unsigned char* ws = A.ws;
    volatile LAS unsigned* bw = (volatile LAS unsigned*)(lds + LDS_BARW);
    if (tid == 0) { bw[0] = 0u; bw[1] = 0u; bw[2] = 0u; bw[3] = 0u; }
    __syncthreads();
#if MK_PER_PHASE
    XcdBarrier bar; bar.bar = (unsigned*)(ws + WS_CTL); bar.x = 0; bar.st = bw;
#else
    XcdBarrier bar = xcd_barrier_post((unsigned*)(ws + WS_CTL), bw);
#endif
    const int lo = A.ph_lo, hi = A.ph_hi;
#define RUN(k) (lo <= (k) && (k) < hi)
#if MK_PER_PHASE
#define SEAM(k) do { } while (0)
#else
#define SEAM(k) do { if ((k) + 1 < hi) xcd_barrier(bar); } while (0)
#endif

    if (RUN(0)) { phase_p0(A, lds, tid, wave, lane); SEAM(0); }
#pragma unroll 1
    for (int l = 0; l < 4; ++l) {
        int tid_o = threadIdx.x; asm volatile("" : "+v"(tid_o));
        const int tid = tid_o, lane = tid & 63, wave = __builtin_amdgcn_readfirstlane(tid >> 6);
        unsigned char* ws = A.ws; asm volatile("" : "+s"(ws));
        float* stats = (float*)(ws + WS_STATS); bf16_t* XB = (bf16_t*)(ws + WS_XB); bf16_t* OB = (bf16_t*)(ws + WS_OB); float* X = (float*)(ws + WS_X);
        const int bx = __builtin_amdgcn_readfirstlane(blockIdx.x + (tid_o >> 20));
        const int pb = l < 2 ? 1 + 8 * l : 19 + 5 * (l - 2);
        if (l < 2) {
            if (RUN(pb)) {
                pg8::Gemm g{XB, (const bf16_t*)(ws + WS_WDNIN + l * SZ_WDNIN), TT, N_DNIN, D};
                pg8::StaticOrder S; S.init(TT, N_DNIN, gridDim.x, bx);
                EpiDnIn E{stats, (bf16_t*)(ws + WS_QKVB), (bf16_t*)(ws + WS_ZB), (float*)(ws + WS_AB)};
                pg8::gemm_phase<EpiDnIn, pg8::StaticOrder>(lds, g, S, E, nullptr);
                SEAM(pb);
            }
            if (RUN(pb + 1)) { phase_d2(A, l, wave, lane); SEAM(pb + 1); }
            if (RUN(pb + 2)) { phase_d3(A, lds, wave, lane); SEAM(pb + 2); }
            if (RUN(pb + 3)) { phase_d4(A, l, lds, tid, wave, lane); SEAM(pb + 3); }
            if (RUN(pb + 4)) { phase_d5(A, l, wave, lane); SEAM(pb + 4); }
        } else {
            if (RUN(pb)) {
                pg8::Gemm g{XB, (const bf16_t*)(ws + WS_WNSAIN + (l - 2) * SZ_WNSAIN), TT, N_NSAIN, D};
                pg8::StaticOrder S; S.init(TT, N_NSAIN, gridDim.x, bx);
                EpiNsaIn E{stats, (bf16_t*)(ws + WS_QB), (float*)(ws + WS_GATES)};
                pg8::gemm_phase<EpiNsaIn, pg8::StaticOrder>(lds, g, S, E, nullptr);
                SEAM(pb);
            }
            if (RUN(pb + 1)) { phase_attn(A, lds, tid, wave, lane); SEAM(pb + 1); }
        }
        const int pm = l < 2 ? pb + 5 : pb + 2;
        if (RUN(pm)) {
            pg8::Gemm g{OB, (const bf16_t*)(ws + (l < 2 ? WS_WDNOUT + l * SZ_WSQ : WS_WNSAOUT + (l - 2) * SZ_WSQ)), TT, D, D};
            pg8::StaticOrder S; S.init(TT, D, gridDim.x, bx);
            EpiRes E{IN_F(I_XP), IN_F(I_XS), X, XB, stats, l == 0 ? 1 : 0};
            pg8::gemm_phase<EpiRes, pg8::StaticOrder>(lds, g, S, E, nullptr);
            SEAM(pm);
        }
        if (RUN(pm + 1)) {
            pg8::Gemm g{XB, (const bf16_t*)(ws + WS_WFFNIN + l * SZ_WFFNIN), TT, 2 * DFF, D};
            pg8::StaticOrder S; S.init(TT, 2 * DFF, gridDim.x, bx);
            EpiFfnIn E{stats, (bf16_t*)(ws + WS_ACT)};
            pg8::gemm_phase<EpiFfnIn, pg8::StaticOrder>(lds, g, S, E, nullptr);
            SEAM(pm + 1);
        }
        if (RUN(pm + 2)) {
            pg8::Gemm g{(const bf16_t*)(ws + WS_ACT), (const bf16_t*)(ws + WS_WFFNOUT + l * SZ_WFFNOUT), TT, D, DFF};
            pg8::StaticOrder S; S.init(TT, D, gridDim.x, bx);
            EpiRes E{IN_F(I_XP), IN_F(I_XS), X, XB, stats, 0};
            pg8::gemm_phase<EpiRes, pg8::StaticOrder>(lds, g, S, E, nullptr);
            SEAM(pm + 2);
        }
        if (l == 1) {
            if (RUN(17)) {
                pg8::Gemm g{XB, (const bf16_t*)(ws + WS_WKV), TT, N_KV, D};
                pg8::StaticOrder S; S.init(TT, N_KV, gridDim.x, bx);
                EpiKV E{stats, A.out, ws};
                pg8::gemm_phase<EpiKV, pg8::StaticOrder>(lds, g, S, E, nullptr);
                SEAM(17);
            }
            if (RUN(18)) { phase_n1(A, lds, tid); SEAM(18); }
        }
    }
    if (RUN(29)) {
        int tid_f = threadIdx.x; asm volatile("" : "+v"(tid_f));
        phase_final(A, __builtin_amdgcn_readfirstlane(tid_f >> 6), tid_f & 63);
    }
#undef RUN
#undef SEAM
}

extern "C" void kernel_launch(void* const* d_in, const int* in_sizes, int n_in, void* d_out, int out_size, void* d_ws, size_t ws_size, hipStream_t stream) {
    static int grid = 0;
    if (grid == 0) {
        if (n_in != 25 || ws_size < WS_END) { fprintf(stderr, "kernel_launch: expected 25 inputs and >= %zu bytes of workspace (got %d, %zu)\n", (size_t)WS_END, n_in, ws_size); grid = -1; return; }
        int dev = 0, cus = 0, per_cu = 0;
        if (hipGetDevice(&dev) != hipSuccess || hipDeviceGetAttribute(&cus, hipDeviceAttributeMultiprocessorCount, dev) != hipSuccess) { grid = -1; return; }
        if (hipFuncSetAttribute((const void*)mk_fwd, hipFuncAttributeMaxDynamicSharedMemorySize, LDS_BYTES) != hipSuccess) { fprintf(stderr, "kernel_launch: hipFuncSetAttribute failed\n"); grid = -1; return; }
        if (hipOccupancyMaxActiveBlocksPerMultiprocessor(&per_cu, (const void*)mk_fwd, NTHR, LDS_BYTES) != hipSuccess || per_cu < 1)
            fprintf(stderr, "kernel_launch: occupancy query reports %d workgroups per CU\n", per_cu);
        (void)hipGetLastError();
        grid = cus > 0 ? cus : 256;
    }
    if (grid < 0) return;
    if (hipMemsetAsync((char*)d_ws + WS_CTL, 0, 65536, stream) != hipSuccess) { fprintf(stderr, "kernel_launch: memset failed\n"); return; }
    Args a{};
    for (int i = 0; i < 25; ++i) a.in[i] = d_in[i];
    a.out = (float*)d_out; a.ws = (unsigned char*)d_ws;
#if MK_PER_PHASE
    for (int k = 0; k < NPH; ++k) { a.ph_lo = k; a.ph_hi = k + 1; hipLaunchKernelGGL(mk_fwd, dim3(grid), dim3(NTHR), LDS_BYTES, stream, a); }
#else
    a.ph_lo = 0; a.ph_hi = NPH;
    hipLaunchKernelGGL(mk_fwd, dim3(grid), dim3(NTHR), LDS_BYTES, stream, a);
#endif
    const hipError_t le = hipPeekAtLastError();
    if (le != hipSuccess) fprintf(stderr, "kernel_launch: launch failed: %s\n", hipGetErrorName(le));
}
```

```cpp
#include <hip/hip_runtime.h>
#include <cstdio>
#include <cstdint>

#ifndef MK_DUP_MASK
#define MK_DUP_MASK 0u
#endif
#ifndef MK_PROBE
#define MK_PROBE 0
#endif
#ifndef MK_XTRA_PH
#define MK_XTRA_PH (-1)
#define MK_XTRA_MASK 0u
#endif
#ifndef MK_PER_PHASE
#define MK_PER_PHASE 0
#endif

#define DI __device__ __forceinline__
#define LAS __attribute__((address_space(3)))
typedef unsigned short bf16_t;
typedef short bf16x8 __attribute__((ext_vector_type(8)));
typedef float f32x4 __attribute__((ext_vector_type(4)));
typedef float f32x2 __attribute__((ext_vector_type(2)));
typedef unsigned u32x4 __attribute__((ext_vector_type(4)));
typedef unsigned u32x2 __attribute__((ext_vector_type(2)));
typedef __bf16 bf16v2 __attribute__((ext_vector_type(2)));

constexpr int D = 1024, TP = 16384, TS = 512, TT = TP + TS, SEQ = 4096, DFF = 2816;
constexpr int N_DNIN = 4352, N_DNIN_REAL = 4112, N_NSAIN = 1280, N_NSAIN_REAL = 1072, N_KV = 1536;
constexpr int NWAVES = 8, NTHR = 512;
constexpr float EPS = 1e-6f;
constexpr size_t O_Y = 0, O_PS = 17301504, O_PC = 18350080, O_PKV = 18423808, O_PW = 35201024, O_SS = 36249600, O_SC = 69804032, O_SKV = 72163328, O_SW = 72687616;
constexpr size_t al256(size_t x) { return (x + 255) & ~(size_t)255; }
constexpr size_t WS_CTL = 0, CTL_BYTES = 1u << 20;
constexpr size_t SZ_WDNIN = (size_t)N_DNIN * D * 2, SZ_WSQ = (size_t)D * D * 2, SZ_WFFNIN = (size_t)2 * DFF * D * 2, SZ_WFFNOUT = (size_t)D * DFF * 2, SZ_WKV = (size_t)N_KV * D * 2, SZ_WNSAIN = (size_t)N_NSAIN * D * 2;
constexpr size_t WS_WDNIN = CTL_BYTES;
constexpr size_t WS_WDNOUT = WS_WDNIN + 2 * SZ_WDNIN;
constexpr size_t WS_WFFNIN = WS_WDNOUT + 2 * SZ_WSQ;
constexpr size_t WS_WFFNOUT = WS_WFFNIN + 4 * SZ_WFFNIN;
constexpr size_t WS_WKV = WS_WFFNOUT + 4 * SZ_WFFNOUT;
constexpr size_t WS_WNSAIN = WS_WKV + SZ_WKV;
constexpr size_t WS_WNSAOUT = WS_WNSAIN + 2 * SZ_WNSAIN;
constexpr size_t WS_X = al256(WS_WNSAOUT + 2 * SZ_WSQ);
constexpr size_t WS_XB = WS_X + (size_t)TT * D * 4;
constexpr size_t WS_STATS = WS_XB + (size_t)TT * D * 2;
constexpr size_t WS_QKVB = WS_STATS + (size_t)TT * 16 * 4;
constexpr size_t WS_ZB = WS_QKVB + (size_t)TT * 3072 * 2;
constexpr size_t WS_AB = WS_ZB + (size_t)TT * D * 2;
constexpr size_t WS_QN = WS_AB + (size_t)TT * 16 * 4;
constexpr size_t WS_KN = WS_QN + (size_t)TT * D * 2;
constexpr size_t WS_VB = WS_KN + (size_t)TT * D * 2;
constexpr size_t WS_GG = WS_VB + (size_t)TT * D * 2;
constexpr size_t WS_BETA = WS_GG + (size_t)TT * 8 * 4;
constexpr size_t PK_WKF = 0, PK_QF = 16384, PK_AQK = 32768, PK_KDF = 40960, PK_WVC = 57344, PK_SIZE = 73728;
constexpr size_t WS_PACK = WS_BETA + (size_t)TT * 8 * 4;
constexpr size_t WS_EG = WS_PACK + (size_t)2048 * PK_SIZE;
constexpr size_t WS_GL = WS_EG + (size_t)2048 * 64 * 4;
constexpr size_t WS_OB = al256(WS_GL + 2048 * 4);
constexpr size_t WS_ACT = WS_OB + (size_t)TT * D * 2;
constexpr size_t SZ_KVP = (size_t)4 * 4 * 64 * 4096 * 2;
constexpr size_t WS_KSELP = WS_ACT + (size_t)TT * DFF * 2;
constexpr size_t WS_VSELP = WS_KSELP + SZ_KVP;
constexpr size_t WS_KWINP = WS_VSELP + SZ_KVP;
constexpr size_t WS_VWINP = WS_KWINP + SZ_KVP;
constexpr size_t SZ_KSELS = (size_t)128 * 4 * 33 * 4096 * 2, SZ_KWINS = (size_t)128 * 4 * 9 * 4096 * 2;
constexpr size_t WS_KSELS = WS_VWINP + SZ_KVP;
constexpr size_t WS_VSELS = WS_KSELS + SZ_KSELS;
constexpr size_t WS_KWINS = WS_VSELS + SZ_KSELS;
constexpr size_t WS_VWINS = WS_KWINS + SZ_KWINS;
constexpr size_t WS_CKP = WS_VWINS + SZ_KWINS;
constexpr size_t WS_CVP = WS_CKP + (size_t)16 * 256 * 64 * 2;
constexpr size_t WS_CKS = WS_CVP + (size_t)16 * 256 * 64 * 2;
constexpr size_t WS_CVS = WS_CKS + (size_t)512 * 128 * 64 * 2;
constexpr size_t WS_QB = WS_CVS + (size_t)512 * 128 * 64 * 2;
constexpr size_t WS_GATES = WS_QB + (size_t)TT * D * 2;
constexpr int BT_STRIDE = 1224, BT_OFF = 80;
constexpr size_t WS_BT = WS_GATES + (size_t)TT * 48 * 4;
constexpr size_t WS_END = al256(WS_BT + 16 * BT_STRIDE * 4);
constexpr int LDS_MAIN = 131072, LDS_MISC = 131072, LDS_BYTES = 147456;
constexpr int LDS_BARW = LDS_BYTES - 16;

DI int lane_id() { int l; asm volatile("v_mbcnt_lo_u32_b32 %0, -1, 0\n\tv_mbcnt_hi_u32_b32 %0, -1, %0" : "=&v"(l)); return l; }
DI unsigned pk2(float a, float b) { f32x2 v = {a, b}; bf16v2 r = __builtin_convertvector(v, bf16v2); return __builtin_bit_cast(unsigned, r); }
DI float bflo(unsigned u) { return __uint_as_float(u << 16); }
DI float bfhi(unsigned u) { return __uint_as_float(u & 0xffff0000u); }
DI float bf2f(bf16_t b) { return __uint_as_float(((unsigned)b) << 16); }
DI bf16_t f2bf(float f) { return (bf16_t)(pk2(f, 0.f) & 0xffffu); }
template <int CTRL> DI float dpp_f(float x) { return __builtin_bit_cast(float, __builtin_amdgcn_update_dpp(0, __builtin_bit_cast(int, x), CTRL, 0xF, 0xF, true)); }
DI float quad_sum(float x) { x += dpp_f<0xB1>(x); x += dpp_f<0x4E>(x); return x; }
DI float row16_sum(float x) { x = quad_sum(x); x += dpp_f<0x141>(x); x += dpp_f<0x140>(x); return x; }
DI float max3f(float a, float b, float c) { return fmaxf(fmaxf(a, b), c); }
DI float max2f(float a, float b) { return fmaxf(a, b); }
typedef unsigned u32x2s __attribute__((ext_vector_type(2)));
DI float rows_max(float x) {
    u32x2s r = __builtin_amdgcn_permlane16_swap(__float_as_uint(x), __float_as_uint(x), false, false);
    const float y = fmaxf(__uint_as_float(r.x), __uint_as_float(r.y));
    r = __builtin_amdgcn_permlane32_swap(__float_as_uint(y), __float_as_uint(y), false, false);
    return fmaxf(__uint_as_float(r.x), __uint_as_float(r.y));
}
DI float rows_sum(float x) {
    u32x2s r = __builtin_amdgcn_permlane16_swap(__float_as_uint(x), __float_as_uint(x), false, false);
    const float y = __uint_as_float(r.x) + __uint_as_float(r.y);
    r = __builtin_amdgcn_permlane32_swap(__float_as_uint(y), __float_as_uint(y), false, false);
    return __uint_as_float(r.x) + __uint_as_float(r.y);
}
DI float wave_sum(float v) { return rows_sum(row16_sum(v)); }
DI float sigmoidf_(float x) { return __builtin_amdgcn_rcpf(1.0f + __expf(-x)); }
DI float siluf_(float x) { return x * __builtin_amdgcn_rcpf(1.0f + __expf(-x)); }
#define LDS_WAIT() asm volatile("s_waitcnt lgkmcnt(0)" ::: "memory")
#define MFMA16(a, b, c) __builtin_amdgcn_mfma_f32_16x16x32_bf16((a), (b), (c), 0, 0, 0)
DI bf16x8 pack8(const f32x4& a, const f32x4& b) { u32x4 p; p.x = pk2(a.x, a.y); p.y = pk2(a.z, a.w); p.z = pk2(b.x, b.y); p.w = pk2(b.z, b.w); return __builtin_bit_cast(bf16x8, p); }
namespace pg8 {
#define PG8_LAS __attribute__((address_space(3)))
typedef unsigned short bf16_t;
typedef short bf16x8 __attribute__((ext_vector_type(8)));
typedef float f32x4 __attribute__((ext_vector_type(4)));
typedef unsigned u32x4 __attribute__((ext_vector_type(4)));
constexpr int BM = 256, BK = 64, HALF = 128, HTB = HALF * BK * 2  , STAGE_BYTES = 8 * HTB, NXCD = 8, WGM = 8;

__host__ __device__ __forceinline__ int lds_byte(int r, int c) { const int st = (r >> 4) * 2 + (c >> 5), rr = r & 15, cc = c & 31, ob = rr * 64 + cc * 2; return st * 1024 + (ob ^ (((ob >> 9) & 1) << 5)); }
__host__ __device__ __forceinline__ void stage_rc(int b, int& R, int& C) { const int st = b / 1024, sb = b % 1024, swz = sb ^ (((sb >> 9) & 1) << 5); R = (st >> 1) * 16 + swz / 64; C = (st & 1) * 32 + (swz % 64) / 2; }
__host__ __device__ __forceinline__ int perm32(int rho) { const int n = rho >> 4, i = rho & 15; return 8 * (i >> 2) + 4 * n + (i & 3); }

struct Unit { int pm, pn; };
struct Gemm { const bf16_t* A; const bf16_t* Bt; int M, N, K; };

struct StaticOrder {
    int nM, nN, nwg, G, c, lo, hi;
    __host__ __device__ void init(int M, int N, int G_, int c_) { nM = M / BM; nN = N / BM; nwg = nM * nN; G = G_; c = c_; lo = 0; hi = nwg; }
    __host__ __device__ void slice(int lo_, int hi_) { lo = lo_; hi = hi_; }
    __host__ __device__ bool next(int i, Unit& u) const {
        const long L = (long)lo + (long)i * G + c; if (L >= hi) return false;
        int wgid = (int)L; { const int q = nwg / NXCD, r = nwg % NXCD, xcd = wgid % NXCD, off = wgid / NXCD; wgid = (xcd < r ? xcd * (q + 1) : r * (q + 1) + (xcd - r) * q) + off; }
        const int nig = WGM * nN, gid = wgid / nig, fm = gid * WGM, gsz = (nM - fm) < WGM ? (nM - fm) : WGM;
        u.pm = fm + ((wgid % nig) % gsz); u.pn = (wgid % nig) / gsz; return true;
    }
    __device__ __forceinline__ void a_ready(const Unit&) const {}
    __device__ __forceinline__ void done(const Unit&) const {}
};
struct CountedOrder : StaticOrder {
    const unsigned* ready; unsigned need; unsigned* tmo;
    __device__ __forceinline__ void a_ready(const Unit& u) const {
        if (threadIdx.x < 64) {
            const unsigned long long t0 = __builtin_amdgcn_s_memrealtime(); unsigned polls = 0;
            while ((unsigned)__builtin_amdgcn_readfirstlane(__hip_atomic_load(ready + 64 * u.pm, __ATOMIC_RELAXED, __HIP_MEMORY_SCOPE_AGENT)) < need) {
                if ((++polls & 255u) == 0u && __builtin_amdgcn_readfirstlane(__hip_atomic_load(tmo, __ATOMIC_RELAXED, __HIP_MEMORY_SCOPE_AGENT)) != 0u) break;
                if (__builtin_amdgcn_s_memrealtime() - t0 > 2000000ull) {
                    if (threadIdx.x == 0) { unsigned expect = 0u; __hip_atomic_compare_exchange_strong(tmo + 1, &expect, 0x600u | (unsigned)(u.pm & 0xff), __ATOMIC_RELAXED, __ATOMIC_RELAXED, __HIP_MEMORY_SCOPE_AGENT); __hip_atomic_store(tmo, 1u, __ATOMIC_RELAXED, __HIP_MEMORY_SCOPE_AGENT); }
                    break; }
                __builtin_amdgcn_s_sleep(2); }
            __builtin_amdgcn_fence(__ATOMIC_ACQUIRE, "agent");
            asm volatile("s_waitcnt vmcnt(0)" ::: "memory");
        }
#if !defined(BROKEN_HOOK_NO_BARRIER)
        asm volatile("" ::: "memory"); __builtin_amdgcn_s_barrier(); asm volatile("" ::: "memory");
#endif
    }
};

__device__ __forceinline__ unsigned cvt_pk_bf16(float lo, float hi) { unsigned r; asm volatile("v_cvt_pk_bf16_f32 %0, %1, %2" : "=v"(r) : "v"(lo), "v"(hi)); return r; }
typedef float f32x2 __attribute__((ext_vector_type(2)));
__device__ __forceinline__ f32x2 gelu_pk(f32x2 v) {
    const f32x2 av = __builtin_elementwise_abs(v), d = av * 0.2316418882f + 1.0f;
    f32x2 t; t.x = __builtin_amdgcn_rcpf(d.x); t.y = __builtin_amdgcn_rcpf(d.y);
    f32x2 q = t * 0.5307027145f + (-0.7265760135f); q = q * t + 0.7107068705f; q = q * t + (-0.142248368f); q = q * t + 0.127414796f; q = q * t;
    const f32x2 s = (v * v) * (-0.72134752044f);
    f32x2 e; e.x = __builtin_amdgcn_exp2f(s.x); e.y = __builtin_amdgcn_exp2f(s.y);
    const f32x2 m = v * (q * e), r = v - m;
    f32x2 o; o.x = v.x < 0.f ? m.x : r.x; o.y = v.y < 0.f ? m.y : r.y; return o;
}

struct EpiF32 {
    static constexpr bool PERM = false, AFTER_DRAIN = false;
    float* C; int ldc; const float* bias;
    __device__ __forceinline__ void operator()(const f32x4 (&acc)[2][2][4][2], const Unit& u, int wr, int wc, int fr, int fq) const {
        const int row0 = u.pm * BM + wr * 64 + fr, col0 = u.pn * BM + wc * 32 + 4 * fq;
        f32x4 bv[2][2];
#pragma unroll
        for (int bj = 0; bj < 2; ++bj)
#pragma unroll
            for (int n = 0; n < 2; ++n) bv[bj][n] = bias ? *(const f32x4*)(bias + col0 + bj * HALF + n * 16) : (f32x4){0.f, 0.f, 0.f, 0.f};
#pragma unroll
        for (int ai = 0; ai < 2; ++ai)
#pragma unroll
            for (int m = 0; m < 4; ++m) { float* rowp = C + (size_t)(row0 + ai * HALF + m * 16) * ldc + col0;
#pragma unroll
                for (int bj = 0; bj < 2; ++bj)
#pragma unroll
                    for (int n = 0; n < 2; ++n) *(f32x4*)(rowp + bj * HALF + n * 16) = acc[ai][bj][m][n] + bv[bj][n]; }
    }
};
template <int ACT  > struct EpiBf16 {
    static constexpr bool PERM = true, AFTER_DRAIN = false;
    bf16_t* O; int ldc; const float* bias; int split_cols; size_t split_stride;
    __device__ __forceinline__ void operator()(const f32x4 (&acc)[2][2][4][2], const Unit& u, int wr, int wc, int fr, int fq) const {
        const int row0 = u.pm * BM + wr * 64 + fr; int colt = u.pn * BM; bf16_t* base = O;
        if (split_cols) { const int t = colt / split_cols; base += (size_t)t * split_stride; colt -= t * split_cols; }
        const int col0 = colt + wc * 32 + 8 * fq, bcol0 = u.pn * BM + wc * 32 + 8 * fq;
        f32x4 bv[2][2];
#pragma unroll
        for (int bj = 0; bj < 2; ++bj)
#pragma unroll
            for (int n = 0; n < 2; ++n) bv[bj][n] = bias ? *(const f32x4*)(bias + bcol0 + bj * HALF + 4 * n) : (f32x4){0.f, 0.f, 0.f, 0.f};
#pragma unroll
        for (int ai = 0; ai < 2; ++ai)
#pragma unroll
            for (int m = 0; m < 4; ++m) { bf16_t* rowp = base + (size_t)(row0 + ai * HALF + m * 16) * ldc + col0;
#pragma unroll
                for (int bj = 0; bj < 2; ++bj) { f32x4 v0 = acc[ai][bj][m][0] + bv[bj][0], v1 = acc[ai][bj][m][1] + bv[bj][1];
                    if (ACT == 1) { f32x2 a = gelu_pk((f32x2){v0[0], v0[1]}), b = gelu_pk((f32x2){v0[2], v0[3]}), c = gelu_pk((f32x2){v1[0], v1[1]}), d = gelu_pk((f32x2){v1[2], v1[3]});
                        v0 = (f32x4){a.x, a.y, b.x, b.y}; v1 = (f32x4){c.x, c.y, d.x, d.y}; }
                    if (ACT == 2) {
#pragma unroll
                        for (int j = 0; j < 4; ++j) { v0[j] = 0.5f * v0[j] * (1.0f + erff(v0[j] * 0.70710678f)); v1[j] = 0.5f * v1[j] * (1.0f + erff(v1[j] * 0.70710678f)); } }
                    u32x4 w; w.x = cvt_pk_bf16(v0[0], v0[1]); w.y = cvt_pk_bf16(v0[2], v0[3]); w.z = cvt_pk_bf16(v1[0], v1[1]); w.w = cvt_pk_bf16(v1[2], v1[3]);
                    *(u32x4*)(rowp + bj * HALF) = w; } }
    }
};

template <class Epi, class Sched, bool STAMP = false>
__device__ __forceinline__ void gemm_phase(PG8_LAS unsigned char* lds, const Gemm g, const Sched& S, const Epi& E, unsigned long long* stamps, int wid_in) {
    int tid_o; asm volatile("v_mbcnt_lo_u32_b32 %0, -1, 0\n\tv_mbcnt_hi_u32_b32 %0, -1, %0" : "=&v"(tid_o)); tid_o += wid_in * 64;
    const int tid = tid_o, wid = __builtin_amdgcn_readfirstlane(tid >> 6), lane = tid & 63, wr = wid >> 2, wc = wid & 3, fr = lane & 15, fq = lane >> 4;
    const int K = g.K, nt = K / BK;
    int ts_lo = 0, ts_hi = 0, nts = 0; const unsigned long long rt_entry = STAMP ? (unsigned long long)wall_clock64() : 0ull;
#define PG8_STAMP() do { if (STAMP && wid == 0 && nts < 64) { const unsigned long long _c = (unsigned long long)clock64(); \
        ts_lo = (lane == nts) ? (int)(unsigned)_c : ts_lo; ts_hi = (lane == nts) ? (int)(unsigned)(_c >> 32) : ts_hi; ++nts; } } while (0)
    PG8_STAMP();
    unsigned voffA[2], voffB[2];
#pragma unroll
    for (int i = 0; i < 2; ++i) { int R, C; stage_rc(tid * 16 + i * 8192, R, C); const int Rb = Epi::PERM ? ((R & ~31) + perm32(R & 31)) : R;
        voffA[i] = (unsigned)(R * K + C) * 2u; voffB[i] = (unsigned)(Rb * K + C) * 2u; }
    const size_t kstep = (size_t)(BK * 2);
    const size_t hstep = (size_t)HALF * K * 2;
    const size_t tstep = 2 * hstep;
    const unsigned ldsw = (unsigned)wid * 1024u;
    const int aoff = lds_byte(wr * 64 + fr, fq * 8), boff = lds_byte(wc * 32 + fr, fq * 8);
#define PG8_SA(b, h) (((b) * 2 + (h)) * HTB)
#define PG8_SB(b, h) ((4 + (b) * 2 + (h)) * HTB)
#define PG8_STAGE(bufoff, gbase, voff) do { _Pragma("unroll") for (int _i = 0; _i < 2; ++_i) \
        __builtin_amdgcn_global_load_lds((const unsigned*)((const char*)(gbase) + (voff)[_i]), (PG8_LAS unsigned*)(lds + (bufoff) + ldsw + _i * 8192), 16, 0, 0); } while (0)
#define PG8_LDA(dst, b, h) do { _Pragma("unroll") for (int m = 0; m < 4; ++m) _Pragma("unroll") for (int k = 0; k < 2; ++k) dst[m][k] = *(const PG8_LAS bf16x8*)(lds + PG8_SA(b, h) + aoff + m * 2048 + k * 1024); } while (0)
#define PG8_LDB(dst, b, h) do { _Pragma("unroll") for (int n = 0; n < 2; ++n) _Pragma("unroll") for (int k = 0; k < 2; ++k) dst[n][k] = *(const PG8_LAS bf16x8*)(lds + PG8_SB(b, h) + boff + n * 2048 + k * 1024); } while (0)
#define PG8_MMA(ai, bj, At, Bt) do { __builtin_amdgcn_s_setprio(1); _Pragma("unroll") for (int m = 0; m < 4; ++m) _Pragma("unroll") for (int n = 0; n < 2; ++n) _Pragma("unroll") for (int k = 0; k < 2; ++k) \
        acc[ai][bj][m][n] = __builtin_amdgcn_mfma_f32_16x16x32_bf16(Bt[n][k], At[m][k], acc[ai][bj][m][n], 0, 0, 0); __builtin_amdgcn_s_setprio(0); } while (0)
#define PG8_WAIT_V(n) asm volatile("s_waitcnt vmcnt(" #n ")" ::: "memory")
#define PG8_WAIT_L(n) asm volatile("s_waitcnt lgkmcnt(" #n ")" ::: "memory")
#define PG8_BAR __builtin_amdgcn_s_barrier()
#define PG8_SCHED __builtin_amdgcn_sched_barrier(0)
    Unit cur, nxt; int ui = 0;
    if (!S.next(0, cur)) return;
    f32x4 acc[2][2][4][2];
#pragma unroll
    for (int a = 0; a < 2; ++a)
#pragma unroll
        for (int b = 0; b < 2; ++b)
#pragma unroll
            for (int m = 0; m < 4; ++m)
#pragma unroll
                for (int n = 0; n < 2; ++n) acc[a][b][m][n] = (f32x4){0.f, 0.f, 0.f, 0.f};
    bf16x8 At[4][2], B0[2][2], B1[2][2];
    const char* cA = (const char*)g.A + (size_t)cur.pm * tstep; const char* cB = (const char*)g.Bt + (size_t)cur.pn * tstep;
    S.a_ready(cur);
    PG8_STAGE(PG8_SB(0, 0), cB, voffB); PG8_STAGE(PG8_SA(0, 0), cA, voffA); PG8_STAGE(PG8_SB(0, 1), cB + hstep, voffB); PG8_STAGE(PG8_SA(0, 1), cA + hstep, voffA);
    if (wr == 1) PG8_BAR;
    PG8_WAIT_V(4); PG8_BAR;
    PG8_STAGE(PG8_SB(1, 0), cB + kstep, voffB); PG8_STAGE(PG8_SA(1, 0), cA + kstep, voffA); PG8_STAGE(PG8_SB(1, 1), cB + hstep + kstep, voffB);
    PG8_WAIT_V(6); PG8_BAR;
    PG8_STAMP();
    for (;;) {
        const bool has_next = S.next(ui + 1, nxt);
        const char* nA = has_next ? (const char*)g.A + (size_t)nxt.pm * tstep : cA; const char* nB = has_next ? (const char*)g.Bt + (size_t)nxt.pn * tstep : cB;
        for (int t = 0; t < nt; t += 2) {
            const bool last = (t == nt - 2);
            const char* a1 = cA + (size_t)(t + 1) * kstep;
            const char* a2 = last ? nA : cA + (size_t)(t + 2) * kstep; const char* b2 = last ? nB : cB + (size_t)(t + 2) * kstep;
            const char* a3 = a2 + kstep; const char* b3 = b2 + kstep;
            if (last && has_next) S.a_ready(nxt);
            PG8_LDB(B0, 0, 0); PG8_SCHED; PG8_LDA(At, 0, 0); PG8_STAGE(PG8_SA(1, 1), a1 + hstep, voffA);
            PG8_WAIT_L(8); PG8_BAR; PG8_WAIT_L(0); PG8_MMA(0, 0, At, B0); PG8_BAR; PG8_SCHED;
            PG8_LDB(B1, 0, 1); PG8_STAGE(PG8_SB(0, 0), b2, voffB);
            PG8_BAR; PG8_WAIT_L(0); PG8_MMA(0, 1, At, B1); PG8_BAR;
            PG8_LDA(At, 0, 1); PG8_STAGE(PG8_SA(0, 0), a2, voffA);
            PG8_BAR; PG8_WAIT_L(0); PG8_MMA(1, 0, At, B0); PG8_BAR; PG8_SCHED;
            PG8_STAGE(PG8_SB(0, 1), b2 + hstep, voffB);
            PG8_WAIT_V(6); PG8_BAR; PG8_MMA(1, 1, At, B1); PG8_BAR;
            PG8_LDB(B0, 1, 0); PG8_SCHED; PG8_LDA(At, 1, 0); PG8_STAGE(PG8_SA(0, 1), a2 + hstep, voffA);
            PG8_WAIT_L(8); PG8_BAR; PG8_WAIT_L(0); PG8_MMA(0, 0, At, B0); PG8_BAR; PG8_SCHED;
            PG8_LDB(B1, 1, 1); PG8_STAGE(PG8_SB(1, 0), b3, voffB);
            PG8_BAR; PG8_WAIT_L(0); PG8_MMA(0, 1, At, B1); PG8_BAR;
            PG8_LDA(At, 1, 1); PG8_STAGE(PG8_SA(1, 0), a3, voffA);
            PG8_BAR; PG8_WAIT_L(0); PG8_MMA(1, 0, At, B0); PG8_BAR; PG8_SCHED;
            PG8_STAGE(PG8_SB(1, 1), b3 + hstep, voffB);
            PG8_WAIT_V(6); PG8_BAR; PG8_MMA(1, 1, At, B1); PG8_BAR;
        }
        PG8_STAMP();
        if constexpr (!Epi::AFTER_DRAIN) { E(acc, cur, wr, wc, fr, fq); S.done(cur); }
        PG8_STAMP();
        if (!has_next) break;
#pragma unroll
        for (int a = 0; a < 2; ++a)
#pragma unroll
            for (int b = 0; b < 2; ++b)
#pragma unroll
                for (int m = 0; m < 4; ++m)
#pragma unroll
                    for (int n = 0; n < 2; ++n) acc[a][b][m][n] = (f32x4){0.f, 0.f, 0.f, 0.f};
        cur = nxt; cA = nA; cB = nB; ++ui;
    }
    PG8_WAIT_V(0);
    if (wr == 0) PG8_BAR;
    PG8_BAR;
    if constexpr (Epi::AFTER_DRAIN) { E.fused(acc, cur, wr, wc, fr, fq, lds, wid, lane); S.done(cur); }
    PG8_STAMP();
    if (STAMP && wid == 0) { stamps[lane] = lane < nts ? (((unsigned long long)(unsigned)ts_hi << 32) | (unsigned)ts_lo) : 0ull;
        if (lane == 62) stamps[62] = rt_entry; if (lane == 63) stamps[63] = (unsigned long long)wall_clock64(); }
#undef PG8_STAMP
#undef PG8_SA
#undef PG8_SB
#undef PG8_STAGE
#undef PG8_LDA
#undef PG8_LDB
#undef PG8_MMA
#undef PG8_WAIT_V
#undef PG8_WAIT_L
#undef PG8_BAR
#undef PG8_SCHED
}
}
#define XB_TMO      128
#define XB_XCNT(j)  (256  + 64 * (j))
#define XB_XSUB(j)  (1280 + 64 * (j))
#define XB_XGEN(j)  (2304 + 64 * (j))
#define XB_TOP      3328
#define XB_TOPGEN   3392
#define XCD_BAR_WORDS 3456
#define XB_SPIN_CAP (1u << 18)

__device__ __forceinline__ unsigned xb_ld(unsigned* p)              { return __hip_atomic_load(p, __ATOMIC_RELAXED, __HIP_MEMORY_SCOPE_AGENT); }
__device__ __forceinline__ unsigned xb_add(unsigned* p, unsigned v) { return __hip_atomic_fetch_add(p, v, __ATOMIC_RELAXED, __HIP_MEMORY_SCOPE_AGENT); }
__device__ __forceinline__ unsigned xb_xcc_id() { return (unsigned)__builtin_amdgcn_s_getreg((3 << 11) | 20) & 0xFu; }
#define XB_SPIN(cond, bar) do { unsigned _sp = 0; while (cond) { __builtin_amdgcn_s_sleep(1); \
    if ((++_sp & 255u) == 0u) { if (xb_ld(&(bar)[XB_TMO])) break; if (_sp > XB_SPIN_CAP) { atomicAdd(&(bar)[XB_TMO], 1u); break; } } } } while (0)

struct XcdBarrier {
    unsigned w0;
    unsigned* bar; unsigned x;
    volatile LAS unsigned* st;
};

__device__ __forceinline__ XcdBarrier xcd_barrier_post(unsigned* bar, volatile LAS unsigned* st, unsigned w0) {
    XcdBarrier b; b.w0 = w0; b.bar = bar; b.x = xb_xcc_id(); b.st = st;
    if (threadIdx.x == 0) (void)xb_add(&bar[XB_XCNT(b.x)], 1u);
    return b;
}
__device__ __forceinline__ void xcd_barrier_complete(unsigned* bar, unsigned x, unsigned& nloc, unsigned& nx) {
    const unsigned G = gridDim.x * gridDim.y * gridDim.z;
    unsigned sum, cnt, mine, sp = 0u;
    for (;;) {
        sum = 0u; cnt = 0u; mine = 0u;
#pragma unroll
        for (unsigned j = 0; j < 16; ++j) { const unsigned c = xb_ld(&bar[XB_XCNT(j)]); sum += c; cnt += (c > 0u) ? 1u : 0u; mine = (j == x) ? c : mine; }
        if (sum == G) break;
        __builtin_amdgcn_s_sleep(1);
        if ((++sp & 255u) == 0u) { if (xb_ld(&bar[XB_TMO])) break; if (sp > XB_SPIN_CAP) { atomicAdd(&bar[XB_TMO], 1u); break; } }
    }
    nloc = mine > 0u ? mine : 1u; nx = cnt > 0u ? cnt : 1u;
}

__device__ __forceinline__ void xcd_barrier(const XcdBarrier& b) {
    asm volatile("s_waitcnt vmcnt(0)" ::: "memory");
    __syncthreads();
    int xb_lane; asm volatile("v_mbcnt_lo_u32_b32 %0, -1, 0\n\tv_mbcnt_hi_u32_b32 %0, -1, %0" : "=&v"(xb_lane));
    if (b.w0 == 0u && xb_lane == 0) {
        unsigned* bar = b.bar;
        __builtin_amdgcn_s_waitcnt(0);
        unsigned nloc = b.st[0], nx = b.st[1];
        if (nloc == 0u) { xcd_barrier_complete(bar, b.x, nloc, nx); b.st[0] = nloc; b.st[1] = nx; }
        const unsigned old = xb_add(&bar[XB_XSUB(b.x)], 1u);
        const unsigned gen = old / nloc;
        if (old + 1u == (gen + 1u) * nloc) {
            __builtin_amdgcn_fence(__ATOMIC_RELEASE, "agent");
            asm volatile("s_waitcnt vmcnt(0)" ::: "memory");
            const unsigned og = xb_add(&bar[XB_TOP], 1u);
            const unsigned tg = og / nx;
            if (og + 1u == (tg + 1u) * nx) xb_add(&bar[XB_TOPGEN], 1u);
            else XB_SPIN(xb_ld(&bar[XB_TOPGEN]) == tg, bar);
            __builtin_amdgcn_fence(__ATOMIC_ACQUIRE, "agent");
            xb_add(&bar[XB_XGEN(b.x)], 1u);
            asm volatile("s_waitcnt vmcnt(0)" ::: "memory");
        } else {
            XB_SPIN(xb_ld(&bar[XB_XGEN(b.x)]) == gen, bar);
            __builtin_amdgcn_fence(__ATOMIC_ACQUIRE, "agent");
            asm volatile("s_waitcnt vmcnt(0)" ::: "memory");
        }
    }
    __syncthreads();
}

using pg8::Unit;
DI float row_rs(const float* stats, int row) {
    const f32x4* p = (const f32x4*)(stats + (size_t)row * 16);
    const f32x4 a = p[0], b = p[1], c = p[2], d = p[3];
    const float s = ((a.x + a.y) + (a.z + a.w)) + ((b.x + b.y) + (b.z + b.w)) + ((c.x + c.y) + (c.z + c.w)) + ((d.x + d.y) + (d.z + d.w));
    return rsqrtf(s * (1.0f / 1024.0f) + EPS);
}
DI void row_rs8(const float* stats, int row0, int fq, float (&rs)[2][4]) {
    f32x4 p[2][4];
#pragma unroll
    for (int ai = 0; ai < 2; ++ai)
#pragma unroll
        for (int m = 0; m < 4; ++m) p[ai][m] = *(const f32x4*)(stats + (size_t)(row0 + ai * 128 + m * 16) * 16 + 4 * fq);
#pragma unroll
    for (int ai = 0; ai < 2; ++ai)
#pragma unroll
        for (int m = 0; m < 4; ++m) rs[ai][m] = rsqrtf(rows_sum((p[ai][m].x + p[ai][m].y) + (p[ai][m].z + p[ai][m].w)) * (1.0f / 1024.0f) + EPS);
}
struct EpiDnIn {
    static constexpr bool PERM = true, AFTER_DRAIN = false;
    const float* stats; bf16_t* qkvb; bf16_t* zb; float* ab;
    DI void operator()(const f32x4 (&acc)[2][2][4][2], const Unit& u, int wr, int wc, int fr, int fq) const {
        const int row0 = u.pm * 256 + wr * 64 + fr;
        asm volatile("" ::: "memory");
        float rs8[2][4]; row_rs8(stats, row0, fq, rs8);
#pragma unroll
        for (int ai = 0; ai < 2; ++ai)
#pragma unroll
            for (int m = 0; m < 4; ++m) {
                const int row = row0 + ai * 128 + m * 16; const float rs = rs8[ai][m];
#pragma unroll
                for (int bj = 0; bj < 2; ++bj) {
                    const int c0 = u.pn * 256 + bj * 128 + wc * 32 + 8 * fq;
                    const f32x4 v0 = acc[ai][bj][m][0] * rs, v1 = acc[ai][bj][m][1] * rs;
                    if (u.pn < 16) {
                        u32x4 w; w.x = pk2(v0.x, v0.y); w.y = pk2(v0.z, v0.w); w.z = pk2(v1.x, v1.y); w.w = pk2(v1.z, v1.w);
                        if (u.pn < 12) *(u32x4*)(qkvb + (size_t)row * 3072 + c0) = w;
                        else *(u32x4*)(zb + (size_t)row * 1024 + (c0 - 3072)) = w;
                    } else if (c0 < 4096 + 16) {
                        float* o = ab + (size_t)row * 16 + (c0 - 4096);
                        *(f32x4*)o = v0; *(f32x4*)(o + 4) = v1;
                    }
                }
            }
    }
};
struct EpiRes {
    static constexpr bool PERM = true, AFTER_DRAIN = false;
    const float* xp; const float* xs; float* X; bf16_t* XB; float* stats; int first; float* Xw; bf16_t* XBw; float* statsw;
    DI void operator()(const f32x4 (&acc)[2][2][4][2], const Unit& u, int wr, int wc, int fr, int fq) const {
        const int row0 = u.pm * 256 + wr * 64 + fr, col0 = u.pn * 256 + wc * 32 + 8 * fq;
        asm volatile("" ::: "memory");
#pragma unroll
        for (int ai = 0; ai < 2; ++ai) {
            u32x4 bb[4][2];
            if (!first) {
#pragma unroll
                for (int m = 0; m < 4; ++m)
#pragma unroll
                    for (int bj = 0; bj < 2; ++bj) bb[m][bj] = *(const u32x4*)(XB + (size_t)(row0 + ai * 128 + m * 16) * D + col0 + bj * 128);
            }
#pragma unroll
            for (int m = 0; m < 4; ++m) {
                const int row = row0 + ai * 128 + m * 16;
                float ss = 0.f;
#pragma unroll
                for (int bj = 0; bj < 2; ++bj) {
                    const int c = col0 + bj * 128;
                    f32x4 b0, b1;
                    if (first) { const float* xr = (row < TP ? xp + (size_t)row * D : xs + (size_t)(row - TP) * D) + c; b0 = *(const f32x4*)xr; b1 = *(const f32x4*)(xr + 4); }
                    else { const u32x4 q = bb[m][bj]; b0 = (f32x4){bflo(q.x), bfhi(q.x), bflo(q.y), bfhi(q.y)}; b1 = (f32x4){bflo(q.z), bfhi(q.z), bflo(q.w), bfhi(q.w)}; }
                    const f32x4 o0 = b0 + acc[ai][bj][m][0], o1 = b1 + acc[ai][bj][m][1];
                    u32x4 w; w.x = pk2(o0.x, o0.y); w.y = pk2(o0.z, o0.w); w.z = pk2(o1.x, o1.y); w.w = pk2(o1.z, o1.w);
                    *(u32x4*)(XBw + (size_t)row * D + c) = w;
                    ss += ((o0.x * o0.x + o0.y * o0.y) + (o0.z * o0.z + o0.w * o0.w)) + ((o1.x * o1.x + o1.y * o1.y) + (o1.z * o1.z + o1.w * o1.w));
                }
                ss = rows_sum(ss);
                if (fq == 0) statsw[(size_t)row * 16 + u.pn * 4 + wc] = ss;
            }
        }
    }
};
struct EpiFfnIn {
    static constexpr bool PERM = true, AFTER_DRAIN = false;
    const float* stats; bf16_t* act;
    DI void operator()(const f32x4 (&acc)[2][2][4][2], const Unit& u, int wr, int wc, int fr, int fq) const {
        const int row0 = u.pm * 256 + wr * 64 + fr, c0 = u.pn * 128 + wc * 32 + 8 * fq;
        asm volatile("" ::: "memory");
        float rs8[2][4]; row_rs8(stats, row0, fq, rs8);
#pragma unroll
        for (int ai = 0; ai < 2; ++ai)
#pragma unroll
            for (int m = 0; m < 4; ++m) {
                const int row = row0 + ai * 128 + m * 16; const float rs = rs8[ai][m];
                float o[8];
#pragma unroll
                for (int n = 0; n < 2; ++n)
#pragma unroll
                    for (int j = 0; j < 4; ++j) { const float g = acc[ai][0][m][n][j] * rs, up = acc[ai][1][m][n][j] * rs; o[4 * n + j] = siluf_(g) * up; }
                u32x4 w; w.x = pk2(o[0], o[1]); w.y = pk2(o[2], o[3]); w.z = pk2(o[4], o[5]); w.w = pk2(o[6], o[7]);
                *(u32x4*)(act + (size_t)row * DFF + c0) = w;
            }
    }
};
DI int permkey(int key) { return (key & ~31) + 8 * ((key >> 2) & 3) + 4 * ((key >> 4) & 1) + (key & 3); }
struct EpiKV {
    static constexpr bool PERM = false, AFTER_DRAIN = false;
    const float* stats; float* out; unsigned char* ws;
    DI void operator()(const f32x4 (&acc)[2][2][4][2], const Unit& u, int wr, int wc, int fr, int fq) const {
        const int row0 = u.pm * 256 + wr * 64 + fr, part = u.pn;
        asm volatile("" ::: "memory");
        float rs8[2][4]; row_rs8(stats, row0, fq, rs8);
#pragma unroll
        for (int ai = 0; ai < 2; ++ai)
#pragma unroll
            for (int m = 0; m < 4; ++m) {
                const int row = row0 + ai * 128 + m * 16; const float rs = rs8[ai][m];
                const bool prm = row < TP;
                const int b = prm ? (row >> 12) : ((row - TP) >> 2), pos = prm ? (row & 4095) : (2048 + ((row - TP) & 3));
                const int blk = pos >> 6, key = pos & 63;
#pragma unroll
                for (int bj = 0; bj < 2; ++bj)
#pragma unroll
                    for (int n = 0; n < 2; ++n) {
                        const int lc = bj * 128 + wc * 32 + n * 16 + 4 * fq, kvh = lc >> 6, d = lc & 63;
                        const f32x4 v = acc[ai][bj][m][n] * rs;
                        if (part < 4) {
                            float* o = prm ? out + O_PKV + (size_t)row * 1024 : out + O_SKV + (size_t)(row - TP) * 1024;
                            *(f32x4*)(o + part * 256 + lc) = v;
                        } else {
                            if (prm) { if (pos >= 3584) *(f32x4*)(out + O_PW + ((size_t)(b * 512 + (pos - 3584)) * 2 + (part - 4)) * 256 + lc) = v; }
                            else *(f32x4*)(out + O_SW + ((size_t)(b * 512 + 508 + (pos - 2048)) * 2 + (part - 4)) * 256 + lc) = v;
                        }
                        if (part == 2 || part == 4) {
                            bf16_t* kb = prm ? (bf16_t*)(ws + (part == 2 ? WS_KSELP : WS_KWINP)) + ((size_t)((b * 4 + kvh) * 64 + blk)) * 4096
                                             : (part == 2 ? (bf16_t*)(ws + WS_KSELS) + ((size_t)((b * 4 + kvh) * 33 + 32)) * 4096 : (bf16_t*)(ws + WS_KWINS) + ((size_t)((b * 4 + kvh) * 9 + 8)) * 4096);
                            u32x2 w; w.x = pk2(v.x, v.y); w.y = pk2(v.z, v.w);
                            *(u32x2*)(kb + key * 64 + d) = w;
                        } else if (part == 3 || part == 5) {
                            bf16_t* vb = prm ? (bf16_t*)(ws + (part == 3 ? WS_VSELP : WS_VWINP)) + ((size_t)((b * 4 + kvh) * 64 + blk)) * 4096
                                             : (part == 3 ? (bf16_t*)(ws + WS_VSELS) + ((size_t)((b * 4 + kvh) * 33 + 32)) * 4096 : (bf16_t*)(ws + WS_VWINS) + ((size_t)((b * 4 + kvh) * 9 + 8)) * 4096);
                            const int pk = permkey(key);
                            vb[(d + 0) * 64 + pk] = f2bf(v.x); vb[(d + 1) * 64 + pk] = f2bf(v.y); vb[(d + 2) * 64 + pk] = f2bf(v.z); vb[(d + 3) * 64 + pk] = f2bf(v.w);
                        }
                    }
            }
    }
};
struct EpiNsaIn {
    static constexpr bool PERM = true, AFTER_DRAIN = false;
    const float* stats; bf16_t* qb; float* gates;
    DI void operator()(const f32x4 (&acc)[2][2][4][2], const Unit& u, int wr, int wc, int fr, int fq) const {
        const int row0 = u.pm * 256 + wr * 64 + fr;
        asm volatile("" ::: "memory");
        float rs8[2][4]; row_rs8(stats, row0, fq, rs8);
#pragma unroll
        for (int ai = 0; ai < 2; ++ai)
#pragma unroll
            for (int m = 0; m < 4; ++m) {
                const int row = row0 + ai * 128 + m * 16; const float rs = rs8[ai][m];
#pragma unroll
                for (int bj = 0; bj < 2; ++bj) {
                    const int c0 = u.pn * 256 + bj * 128 + wc * 32 + 8 * fq;
                    const f32x4 v0 = acc[ai][bj][m][0] * rs, v1 = acc[ai][bj][m][1] * rs;
                    if (u.pn < 4) {
                        const float s = 0.125f;
                        u32x4 w; w.x = pk2(v0.x * s, v0.y * s); w.y = pk2(v0.z * s, v0.w * s); w.z = pk2(v1.x * s, v1.y * s); w.w = pk2(v1.z * s, v1.w * s);
                        *(u32x4*)(qb + (size_t)row * 1024 + c0) = w;
                    } else if (c0 < 1024 + 48) {
                        float* o = gates + (size_t)row * 48 + (c0 - 1024);
                        f32x4 g0, g1;
                        g0.x = sigmoidf_(v0.x); g0.y = sigmoidf_(v0.y); g0.z = sigmoidf_(v0.z); g0.w = sigmoidf_(v0.w);
                        g1.x = sigmoidf_(v1.x); g1.y = sigmoidf_(v1.y); g1.z = sigmoidf_(v1.z); g1.w = sigmoidf_(v1.w);
                        *(f32x4*)o = g0; *(f32x4*)(o + 4) = g1;
                    }
                }
            }
    }
};
struct Args { const void* in[25]; float* out; unsigned char* ws; int ph_lo, ph_hi; unsigned dup_mask; unsigned pad; };
typedef const __attribute__((address_space(4))) Args CArgs;
#define IN_F(i) ((const float*)A.in[i])
enum { I_XP = 0, I_XS, I_SDNS, I_SDNC, I_CACHE, I_SWIN, I_PT, I_NMIX, I_NFFN, I_NKV, I_NFIN, I_FFNWIN, I_FFNWOUT, I_DNWIN, I_DNCONVW, I_DNALOG, I_DNDTB, I_DNONORM, I_DNWOUT, I_NSAWKV, I_CMPPOSW, I_WCMP, I_NSAWIN, I_NSAWOUT, I_RELB };

struct TrDesc { const float* W; const float* scale; bf16_t* WT; int Nsrc, K, Nreal, kind, k0, n0; };
DI void p0_tr_load(const TrDesc& d, f32x4 (&v)[16], f32x4& sc0, f32x4& sc1, bool& ok, int lane) {
    const int c4 = d.n0 + 4 * (lane & 15);
    int src; ok = true;
    if (d.kind == 1) { const int pn = c4 >> 8, lc = c4 & 255; src = lc < 128 ? 128 * pn + lc : DFF + 128 * pn + (lc - 128); }
    else { ok = c4 < d.Nreal; src = ok ? c4 : 0; }
    const unsigned voff = (unsigned)((lane >> 4) * d.Nsrc + src);
#pragma unroll
    for (int i = 0; i < 16; ++i) { const float* rowp = d.W + (size_t)(d.k0 + 4 * i) * d.Nsrc; v[i] = *(const f32x4*)(rowp + voff); }
    sc0 = (f32x4){1.f, 1.f, 1.f, 1.f}; sc1 = sc0;
    if (d.scale) { const f32x4* sp = (const f32x4*)(d.scale + d.k0 + 8 * (lane & 7)); sc0 = sp[0]; sc1 = sp[1]; }
}
DI void p0_tr_lds(const f32x4 (&v)[16], bool ok, LAS float* scr, int lane) {
    LAS float* w = scr + (lane >> 4) * 65 + 4 * (lane & 15);
#pragma unroll
    for (int i = 0; i < 16; ++i) {
        w[(4 * i) * 65 + 0] = ok ? v[i].x : 0.f; w[(4 * i) * 65 + 1] = ok ? v[i].y : 0.f; w[(4 * i) * 65 + 2] = ok ? v[i].z : 0.f; w[(4 * i) * 65 + 3] = ok ? v[i].w : 0.f;
    }
}
DI void p0_tr_store(bf16_t* WT, int K, int k0, int n0, const f32x4& sc0, const f32x4& sc1, const LAS float* scr, int lane) {
    const int c = lane & 7;
    const LAS float* s = scr + (8 * c) * 65 + (lane >> 3);
    bf16_t* o = WT + (size_t)(n0 + (lane >> 3)) * K + k0 + 8 * c;
#pragma unroll
    for (int j = 0; j < 8; ++j) {
        u32x4 w; w.x = pk2(s[8 * j + 0 * 65] * sc0.x, s[8 * j + 1 * 65] * sc0.y); w.y = pk2(s[8 * j + 2 * 65] * sc0.z, s[8 * j + 3 * 65] * sc0.w);
        w.z = pk2(s[8 * j + 4 * 65] * sc1.x, s[8 * j + 5 * 65] * sc1.y); w.w = pk2(s[8 * j + 6 * 65] * sc1.z, s[8 * j + 7 * 65] * sc1.w);
        *(u32x4*)(o + (size_t)(8 * j) * K) = w;
    }
}
DI void p0_row2(const float* xrow0, const float* xrow1, bf16_t* xb0, bf16_t* xb1, float* st0, float* st1, int lane) {
    const f32x4* xr0 = (const f32x4*)xrow0 + lane; const f32x4* xr1 = (const f32x4*)xrow1 + lane; f32x4 v[4], u[4]; float s = 0.f, t = 0.f;
#pragma unroll
    for (int j = 0; j < 4; ++j) { v[j] = xr0[64 * j]; u[j] = xr1[64 * j]; }
#pragma unroll
    for (int j = 0; j < 4; ++j) { s += (v[j].x * v[j].x + v[j].y * v[j].y) + (v[j].z * v[j].z + v[j].w * v[j].w); t += (u[j].x * u[j].x + u[j].y * u[j].y) + (u[j].z * u[j].z + u[j].w * u[j].w); }
    s = wave_sum(s); t = wave_sum(t);
    u32x2* o0 = (u32x2*)xb0 + lane; u32x2* o1 = (u32x2*)xb1 + lane;
#pragma unroll
    for (int j = 0; j < 4; ++j) { u32x2 w; w.x = pk2(v[j].x, v[j].y); w.y = pk2(v[j].z, v[j].w); o0[64 * j] = w; u32x2 y; y.x = pk2(u[j].x, u[j].y); y.y = pk2(u[j].z, u[j].w); o1[64 * j] = y; }
    if (lane < 16) st0[lane] = lane == 0 ? s : 0.f;
    else if (lane < 32) st1[lane - 16] = lane == 16 ? t : 0.f;
}
DI int rel_bucket_dev(int dist) {
    const int n = dist > 0 ? dist : 0;
    if (n < 16) return n;
    if (n >= 1024) return 31;
    const double v = (log2((double)n) - 4.0) * (8.0 / 3.0);
    int k = (int)(v + 1e-9); k = 16 + k;
    return k < 31 ? k : 31;
}
#define GAS __attribute__((address_space(1)))
DI const GAS float* uni_ptr(const float* p) {
    const unsigned long long v = (unsigned long long)p;
    const unsigned lo = __builtin_amdgcn_readfirstlane((unsigned)v), hi = __builtin_amdgcn_readfirstlane((unsigned)(v >> 32));
    return (const GAS float*)(((unsigned long long)hi << 32) | lo);
}
DI void conv_rows128(const float* src, int pitch, int koff, int voff, bf16_t* kdst, bf16_t* vdst, int NB, LAS float* tile, int tid, float* cpy, int row0) {
    const int c8 = tid & 31, rr0 = tid >> 5, kvh = c8 >> 3, d0 = (c8 & 7) * 8;
    f32x4 ka[8], kb[8], va[8], vb[8];
    {
        const GAS float* su = uni_ptr(src);
        const unsigned ok_ = (unsigned)(rr0 * pitch + koff + c8 * 8), ov_ = (unsigned)(rr0 * pitch + voff + c8 * 8);
#pragma unroll
        for (int i = 0; i < 8; ++i) { const GAS float* rb = su + (size_t)(16 * i) * pitch; const GAS f32x4* p = (const GAS f32x4*)(rb + ok_); ka[i] = p[0]; kb[i] = p[1]; }
#pragma unroll
        for (int i = 0; i < 8; ++i) { const GAS float* rb = su + (size_t)(16 * i) * pitch; const GAS f32x4* p = (const GAS f32x4*)(rb + ov_); va[i] = p[0]; vb[i] = p[1]; }
    }
#pragma unroll
    for (int i = 0; i < 8; ++i) {
        const int rr = rr0 + 16 * i;
        u32x4 o; o.x = pk2(ka[i].x, ka[i].y); o.y = pk2(ka[i].z, ka[i].w); o.z = pk2(kb[i].x, kb[i].y); o.w = pk2(kb[i].z, kb[i].w);
        *(u32x4*)(kdst + ((size_t)(kvh * NB + (rr >> 6)) * 64 + (rr & 63)) * 64 + d0) = o;
        if (cpy) { if (row0 + rr >= 4) { float* q = cpy + (size_t)(row0 + rr - 4) * 512 + koff + c8 * 8; *(f32x4*)q = ka[i]; *(f32x4*)(q + 4) = kb[i]; } }
    }
#pragma unroll
    for (int hb = 0; hb < 2; ++hb) {
#pragma unroll
        for (int i = 0; i < 4; ++i) {
            const int rr = rr0 + 16 * i; const f32x4 a = va[4 * hb + i], b = vb[4 * hb + i];
            LAS float* t = tile + (kvh * 64 + rr) * 65 + d0;
            t[0] = a.x; t[1] = a.y; t[2] = a.z; t[3] = a.w; t[4] = b.x; t[5] = b.y; t[6] = b.z; t[7] = b.w;
            if (cpy) { if (row0 + 64 * hb + rr >= 4) { float* q = cpy + (size_t)(row0 + 64 * hb + rr - 4) * 512 + voff + c8 * 8; *(f32x4*)q = a; *(f32x4*)(q + 4) = b; } }
        }
        __syncthreads();
#pragma unroll
        for (int i = 0; i < 4; ++i) {
            const int d = (tid >> 3) & 63, ch = tid & 7, k0 = 32 * (ch >> 2) + 4 * (ch & 3);
            const LAS float* t = tile + (i * 64) * 65 + d;
            u32x4 o; o.x = pk2(t[(k0 + 0) * 65], t[(k0 + 1) * 65]); o.y = pk2(t[(k0 + 2) * 65], t[(k0 + 3) * 65]);
            o.z = pk2(t[(k0 + 16) * 65], t[(k0 + 17) * 65]); o.w = pk2(t[(k0 + 18) * 65], t[(k0 + 19) * 65]);
            *(u32x4*)(vdst + ((size_t)(i * NB + hb) * 64 + d) * 64 + 8 * ch) = o;
        }
        __syncthreads();
    }
}
DI void cmp_item(const float* srcA, const float* srcB, int pitch, int nsub, const float* posw, const float* wcmp, bf16_t* ck, bf16_t* cvt, int NK, int j0, LAS float* blkS, int tid) {
    const int col = tid, c = col >> 8, kvh = (col >> 6) & 3, d = col & 63;
    float pw[32];
    const float* pwu = posw; const float* wu = wcmp;
    unsigned pwo = (unsigned)(((c * 32) * 4 + kvh) * 64 + d), wo = (unsigned)(((c * 4 + kvh) * 64) * 64 + d);
    asm volatile("" : "+v"(pwo), "+v"(wo));
#pragma unroll
    for (int r = 0; r < 32; ++r) { const float* rb = pwu + r * 256; pw[r] = rb[pwo]; }
    float lo_prev = 0.f;
    const GAS float* sA = uni_ptr(srcA); const GAS float* sB = uni_ptr(srcB); const unsigned ucol = (unsigned)col;
#pragma unroll 1
    for (int g = 0; g < 3; ++g) {
        float x[48];
#pragma unroll
        for (int mm = 0; mm < 3; ++mm) {
            const int m = 3 * g + mm;
            const GAS float* rp = m < 8 ? sA + (size_t)(16 * m) * pitch : sB;
#pragma unroll
            for (int r = 0; r < 16; ++r) { const GAS float* rb = rp + (size_t)r * pitch; x[16 * mm + r] = rb[ucol]; }
        }
#pragma unroll
        for (int mm = 0; mm < 3; ++mm) {
            const int m = 3 * g + mm;
            float lo = 0.f, hi = 0.f;
#pragma unroll
            for (int r = 0; r < 16; ++r) { lo += pw[r] * x[16 * mm + r]; hi += pw[16 + r] * x[16 * mm + r]; }
            if (m >= 1) blkS[(m - 1) * 512 + col] = lo_prev + hi;
            lo_prev = lo;
        }
    }
    if (nsub < 9) blkS[7 * 512 + col] = 0.f;
    float wc[16];
#pragma unroll
    for (int u = 0; u < 16; ++u) { const float* rb = wu + u * 64; wc[u] = rb[wo]; }
    __syncthreads();
    float out[8];
#pragma unroll
    for (int j = 0; j < 8; ++j) out[j] = 0.f;
    const LAS float* bs = blkS + (col & ~63);
#pragma unroll 1
    for (int g = 0; g < 4; ++g) {
        float wn[16];
        if (g < 3) {
#pragma unroll
            for (int u = 0; u < 16; ++u) { const float* rb = wu + (16 * (g + 1) + u) * 64; wn[u] = rb[wo]; }
        } else {
#pragma unroll
            for (int u = 0; u < 16; ++u) wn[u] = 0.f;
        }
#pragma unroll
        for (int u = 0; u < 16; ++u) {
            const float wv = wc[u]; const int dd = 16 * g + u;
#pragma unroll
            for (int j = 0; j < 8; ++j) out[j] += bs[j * 512 + dd] * wv;
        }
#pragma unroll
        for (int u = 0; u < 16; ++u) wc[u] = wn[u];
    }
    const int nj = nsub - 1;
#pragma unroll
    for (int j = 0; j < 8; ++j) {
        const float val = j < nj ? out[j] : 0.f; const int key = j0 + j;
        if (c == 0) ck[((size_t)(kvh * NK + key)) * 64 + d] = f2bf(val);
        else cvt[((size_t)(kvh * 64 + d)) * NK + permkey(key)] = f2bf(val);
    }
    __syncthreads();
}
DI void phase_p0(CArgs& A, LAS unsigned char* lds, int tid, int wave, int lane) {
    unsigned char* ws = A.ws;
    const int gw = blockIdx.x * NWAVES + wave, NGW = gridDim.x * NWAVES;
    LAS float* scr = (LAS float*)(lds + wave * 17408);
    constexpr int I_DNIN = 16 * (N_DNIN / 64), I_SQ = 16 * 16, I_FIN = 16 * (2 * DFF / 64), I_FOUT = (DFF / 64) * 16, I_KV = 16 * (N_KV / 64), I_NIN = 16 * (N_NSAIN / 64);
    constexpr int NITEMS = 2 * I_DNIN + 2 * I_SQ + 4 * I_FIN + 4 * I_FOUT + I_KV + 2 * I_NIN + 2 * I_SQ;
#define P0_DESC(d, it_) do { int r = (it_); int nblk; \
        if (r < 2 * I_DNIN) { const int l = r / I_DNIN; r -= l * I_DNIN; d.W = IN_F(I_DNWIN) + (size_t)l * D * N_DNIN_REAL; d.Nsrc = N_DNIN_REAL; d.K = D; nblk = N_DNIN / 64; d.Nreal = N_DNIN_REAL; d.kind = 0; d.scale = IN_F(I_NMIX) + l * D; d.WT = (bf16_t*)(ws + WS_WDNIN + l * SZ_WDNIN); } \
        else if ((r -= 2 * I_DNIN) < 2 * I_SQ) { const int l = r / I_SQ; r -= l * I_SQ; d.W = IN_F(I_DNWOUT) + (size_t)l * D * D; d.Nsrc = D; d.K = D; nblk = 16; d.Nreal = D; d.kind = 0; d.scale = nullptr; d.WT = (bf16_t*)(ws + WS_WDNOUT + l * SZ_WSQ); } \
        else if ((r -= 2 * I_SQ) < 4 * I_FIN) { const int l = r / I_FIN; r -= l * I_FIN; d.W = IN_F(I_FFNWIN) + (size_t)l * D * 2 * DFF; d.Nsrc = 2 * DFF; d.K = D; nblk = 2 * DFF / 64; d.Nreal = 2 * DFF; d.kind = 1; d.scale = IN_F(I_NFFN) + l * D; d.WT = (bf16_t*)(ws + WS_WFFNIN + l * SZ_WFFNIN); } \
        else if ((r -= 4 * I_FIN) < 4 * I_FOUT) { const int l = r / I_FOUT; r -= l * I_FOUT; d.W = IN_F(I_FFNWOUT) + (size_t)l * DFF * D; d.Nsrc = D; d.K = DFF; nblk = 16; d.Nreal = D; d.kind = 0; d.scale = nullptr; d.WT = (bf16_t*)(ws + WS_WFFNOUT + l * SZ_WFFNOUT); } \
        else if ((r -= 4 * I_FOUT) < I_KV) { d.W = IN_F(I_NSAWKV); d.Nsrc = N_KV; d.K = D; nblk = N_KV / 64; d.Nreal = N_KV; d.kind = 0; d.scale = IN_F(I_NKV); d.WT = (bf16_t*)(ws + WS_WKV); } \
        else if ((r -= I_KV) < 2 * I_NIN) { const int l = r / I_NIN; r -= l * I_NIN; d.W = IN_F(I_NSAWIN) + (size_t)l * D * N_NSAIN_REAL; d.Nsrc = N_NSAIN_REAL; d.K = D; nblk = N_NSAIN / 64; d.Nreal = N_NSAIN_REAL; d.kind = 0; d.scale = IN_F(I_NMIX) + (2 + l) * D; d.WT = (bf16_t*)(ws + WS_WNSAIN + l * SZ_WNSAIN); } \
        else { r -= 2 * I_NIN; const int l = r / I_SQ; r -= l * I_SQ; d.W = IN_F(I_NSAWOUT) + (size_t)l * D * D; d.Nsrc = D; d.K = D; nblk = 16; d.Nreal = D; d.kind = 0; d.scale = nullptr; d.WT = (bf16_t*)(ws + WS_WNSAOUT + l * SZ_WSQ); } \
        const int kb = r / nblk; d.k0 = kb * 64; d.n0 = (r - kb * nblk) * 64; } while (0)
    {
        f32x4 v[16], sc0, sc1; bool ok = true; TrDesc d;
        int it = gw;
        if (it < NITEMS) { P0_DESC(d, it); p0_tr_load(d, v, sc0, sc1, ok, lane); }
        while (it < NITEMS) {
            p0_tr_lds(v, ok, scr, lane);
            bf16_t* cWT = d.WT; const int cK = d.K, ck0 = d.k0, cn0 = d.n0; const f32x4 c0 = sc0, c1 = sc1;
            it += NGW;
            if (it < NITEMS) { P0_DESC(d, it); p0_tr_load(d, v, sc0, sc1, ok, lane); }
            LDS_WAIT();
            p0_tr_store(cWT, cK, ck0, cn0, c0, c1, scr, lane);
            LDS_WAIT();
        }
    }
    for (int m = gw; m < TT / 2; m += NGW) {
        const int m0 = m, m1 = m + TT / 2;
        const float* xr0 = IN_F(I_XP) + (size_t)m0 * D;
        const float* xr1 = m1 < TP ? IN_F(I_XP) + (size_t)m1 * D : IN_F(I_XS) + (size_t)(m1 - TP) * D;
        p0_row2(xr0, xr1, (bf16_t*)(ws + WS_XB) + (size_t)m0 * D, (bf16_t*)(ws + WS_XB) + (size_t)m1 * D, (float*)(ws + WS_STATS) + (size_t)m0 * 16, (float*)(ws + WS_STATS) + (size_t)m1 * 16, lane);
    }
    for (int i = blockIdx.x * NTHR + tid; i < 16 * BT_STRIDE; i += gridDim.x * NTHR) {
        const int h = i / BT_STRIDE, o = i - h * BT_STRIDE;
        ((float*)(ws + WS_BT))[i] = IN_F(I_RELB)[rel_bucket_dev(o - BT_OFF) * 16 + h];
    }
    for (int i = blockIdx.x * NTHR + tid; i < 512 * 512 * 4; i += gridDim.x * NTHR) {
        const int arr = i >> 18, rem = i & 262143, bk = rem >> 9, ch = rem & 511;
        bf16_t* base = arr == 0 ? (bf16_t*)(ws + WS_KSELS) + ((size_t)(bk * 33 + 32)) * 4096 : arr == 1 ? (bf16_t*)(ws + WS_VSELS) + ((size_t)(bk * 33 + 32)) * 4096
                     : arr == 2 ? (bf16_t*)(ws + WS_KWINS) + ((size_t)(bk * 9 + 8)) * 4096 : (bf16_t*)(ws + WS_VWINS) + ((size_t)(bk * 9 + 8)) * 4096;
        *(u32x4*)(base + ch * 8) = (u32x4){0u, 0u, 0u, 0u};
    }
}
DI void sample_conv_item(CArgs& A, int it, LAS unsigned char* lds, int tid) {
    unsigned char* ws = A.ws;
    LAS float* tile = (LAS float*)lds;
    LAS float* blkS = (LAS float*)(lds + 66560);
    const int* pt = (const int*)A.in[I_PT];
    if (it < 2048) {
        const int b = it >> 4, p = it & 15;
        const float* pg = IN_F(I_CACHE) + (size_t)pt[b * 16 + p] * 131072;
        const float* pg2 = p < 15 ? IN_F(I_CACHE) + (size_t)pt[b * 16 + p + 1] * 131072 : pg;
        conv_rows128(pg, 1024, 512, 768, (bf16_t*)(ws + WS_KSELS) + ((size_t)(b * 4) * 33 + 2 * p) * 4096, (bf16_t*)(ws + WS_VSELS) + ((size_t)(b * 4) * 33 + 2 * p) * 4096, 33, tile, tid, nullptr, 0);
        cmp_item(pg, pg2, 1024, p < 15 ? 9 : 8, IN_F(I_CMPPOSW), IN_F(I_WCMP), (bf16_t*)(ws + WS_CKS) + (size_t)b * 4 * 128 * 64, (bf16_t*)(ws + WS_CVS) + (size_t)b * 4 * 64 * 128, 128, 8 * p, blkS, tid);
    } else {
        const int r = it - 2048, b = r >> 2, q = r & 3;
        const float* src = IN_F(I_SWIN) + ((size_t)b * 512 + 128 * q) * 512;
        conv_rows128(src, 512, 0, 256, (bf16_t*)(ws + WS_KWINS) + ((size_t)(b * 4) * 9 + 2 * q) * 4096, (bf16_t*)(ws + WS_VWINS) + ((size_t)(b * 4) * 9 + 2 * q) * 4096, 9, tile, tid,
                     A.out + O_SW + (size_t)b * 512 * 512, 128 * q);
    }
}
DI void unpack8(const u32x4& u, float (&x)[8]) { x[0] = bflo(u.x); x[1] = bfhi(u.x); x[2] = bflo(u.y); x[3] = bfhi(u.y); x[4] = bflo(u.z); x[5] = bfhi(u.z); x[6] = bflo(u.w); x[7] = bfhi(u.w); }
DI void phase_d2(CArgs& A, int l, int wave, int lane) {
    unsigned char* ws = A.ws;
    const int gw = blockIdx.x * NWAVES + wave, NGW = gridDim.x * NWAVES;
    const bf16_t* qkvb = (const bf16_t*)(ws + WS_QKVB);
    const float* convw = IN_F(I_DNCONVW) + (size_t)l * 4 * 3072;
    for (int it = gw; it < (2048 + 128) * 6; it += NGW) {
        const int run = it / 6, chunk = it - run * 6;
        const bool prm = run < 2048;
        const int tok0 = prm ? 8 * run : TP + 4 * (run - 2048), len = prm ? 8 : 4;
        const int pos0 = tok0 & 4095, b = prm ? (tok0 >> 12) : (run - 2048);
        const int part = chunk >> 1, half = chunk & 1, col = part * 1024 + half * 512 + 8 * lane;
        u32x4 xt[8];
#pragma unroll
        for (int t = 0; t < 8; ++t) xt[t] = *(const u32x4*)(qkvb + (size_t)(tok0 + (t < len ? t : len - 1)) * 3072 + col);
        float w[4][8];
#pragma unroll
        for (int t = 0; t < 4; ++t) { const f32x4* p = (const f32x4*)(convw + t * 3072 + col); const f32x4 a = p[0], c = p[1]; w[t][0] = a.x; w[t][1] = a.y; w[t][2] = a.z; w[t][3] = a.w; w[t][4] = c.x; w[t][5] = c.y; w[t][6] = c.z; w[t][7] = c.w; }
        float x0[8], x1[8], x2[8];
        if (prm) {
            if (pos0 == 0) {
#pragma unroll
                for (int e = 0; e < 8; ++e) { x0[e] = 0.f; x1[e] = 0.f; x2[e] = 0.f; }
            } else {
                const u32x4 h0 = *(const u32x4*)(qkvb + (size_t)(tok0 - 3) * 3072 + col), h1 = *(const u32x4*)(qkvb + (size_t)(tok0 - 2) * 3072 + col), h2 = *(const u32x4*)(qkvb + (size_t)(tok0 - 1) * 3072 + col);
                unpack8(h0, x0); unpack8(h1, x1); unpack8(h2, x2);
            }
        } else {
            const float* st = IN_F(I_SDNC) + ((size_t)(l * 128 + b) * 3) * 3072 + col;
            const f32x4 a0 = *(const f32x4*)st, a1 = *(const f32x4*)(st + 4), b0 = *(const f32x4*)(st + 3072), b1 = *(const f32x4*)(st + 3072 + 4), c0 = *(const f32x4*)(st + 6144), c1 = *(const f32x4*)(st + 6144 + 4);
            x0[0] = a0.x; x0[1] = a0.y; x0[2] = a0.z; x0[3] = a0.w; x0[4] = a1.x; x0[5] = a1.y; x0[6] = a1.z; x0[7] = a1.w;
            x1[0] = b0.x; x1[1] = b0.y; x1[2] = b0.z; x1[3] = b0.w; x1[4] = b1.x; x1[5] = b1.y; x1[6] = b1.z; x1[7] = b1.w;
            x2[0] = c0.x; x2[1] = c0.y; x2[2] = c0.z; x2[3] = c0.w; x2[4] = c1.x; x2[5] = c1.y; x2[6] = c1.z; x2[7] = c1.w;
        }
        bf16_t* dst = (bf16_t*)(ws + (part == 0 ? WS_QN : part == 1 ? WS_KN : WS_VB));
#pragma unroll
        for (int t = 0; t < 8; ++t) {
            if (t < len) {
                float xc[8]; unpack8(xt[t], xc);
                if (prm) { if (pos0 + t >= 4093) { float* o = A.out + O_PC + ((size_t)(l * 4 + b) * 3 + (pos0 + t - 4093)) * 3072 + col;
                        *(f32x4*)o = (f32x4){xc[0], xc[1], xc[2], xc[3]}; *(f32x4*)(o + 4) = (f32x4){xc[4], xc[5], xc[6], xc[7]}; } }
                else if (t >= 1) { float* o = A.out + O_SC + ((size_t)(l * 128 + b) * 3 + (t - 1)) * 3072 + col;
                        *(f32x4*)o = (f32x4){xc[0], xc[1], xc[2], xc[3]}; *(f32x4*)(o + 4) = (f32x4){xc[4], xc[5], xc[6], xc[7]}; }
                float y[8]; float ss = 0.f;
#pragma unroll
                for (int e = 0; e < 8; ++e) { const float v = w[0][e] * x0[e] + w[1][e] * x1[e] + w[2][e] * x2[e] + w[3][e] * xc[e]; y[e] = siluf_(v); ss += y[e] * y[e]; }
                if (part < 2) {
                    ss = row16_sum(ss);
                    const float sc = rsqrtf(ss + EPS) * (part == 0 ? 0.08838834764831845f : 1.0f);
#pragma unroll
                    for (int e = 0; e < 8; ++e) y[e] *= sc;
                }
                u32x4 o; o.x = pk2(y[0], y[1]); o.y = pk2(y[2], y[3]); o.z = pk2(y[4], y[5]); o.w = pk2(y[6], y[7]);
                *(u32x4*)(dst + (size_t)(tok0 + t) * 1024 + half * 512 + 8 * lane) = o;
#pragma unroll
                for (int e = 0; e < 8; ++e) { x0[e] = x1[e]; x1[e] = x2[e]; x2[e] = xc[e]; }
            }
        }
        if (chunk == 0 && lane < 8) {
            const float al = __expf(IN_F(I_DNALOG)[l * 8 + lane]), dtb = IN_F(I_DNDTB)[l * 8 + lane];
            for (int t = 0; t < len; ++t) {
                const float* ab = (const float*)(ws + WS_AB) + (size_t)(tok0 + t) * 16;
                const float xa = ab[lane] + dtb, xb = ab[8 + lane];
                const float sp = fmaxf(xa, 0.f) + log1pf(__expf(-fabsf(xa)));
                ((float*)(ws + WS_GG))[(size_t)(tok0 + t) * 8 + lane] = -al * sp;
                ((float*)(ws + WS_BETA))[(size_t)(tok0 + t) * 8 + lane] = sigmoidf_(xb);
            }
        }
    }
}
DI void phase_d3(CArgs& A, LAS unsigned char* lds, int wave, int lane) {
    unsigned char* ws = A.ws;
    const int gw = blockIdx.x * NWAVES + wave, NGW = gridDim.x * NWAVES;
    const int fr = lane & 15, fq = lane >> 4;
    LAS float* As = (LAS float*)(lds + wave * 16384);
    LAS bf16_t* Tp = (LAS bf16_t*)(lds + wave * 16384);
    LAS float* sc = (LAS float*)(lds + LDS_MISC + wave * 1024);
    bf16x8 I0, I1;
#pragma unroll
    for (int jj = 0; jj < 8; ++jj) { I0[jj] = (8 * fq + jj == fr) ? (short)0x3F80 : (short)0; I1[jj] = (8 * fq + jj == 16 + fr) ? (short)0x3F80 : (short)0; }
    const f32x4 zero4 = {0.f, 0.f, 0.f, 0.f};
    for (int idx = gw; idx < 2048; idx += NGW) {
        const int b = idx >> 9, n = (idx >> 3) & 63, h = idx & 7, tok0 = b * 4096 + 64 * n;
        unsigned char* pack = ws + WS_PACK + (size_t)idx * PK_SIZE;
        float G = ((const float*)(ws + WS_GG))[(size_t)(tok0 + lane) * 8 + h];
        const float bt = ((const float*)(ws + WS_BETA))[(size_t)(tok0 + lane) * 8 + h];
#pragma unroll
        for (int o = 1; o < 64; o <<= 1) { const float t = __shfl_up(G, o); if (lane >= o) G += t; }
        const float Glast = __shfl(G, 63), eG = __expf(G), kd = __expf(Glast - G);
        sc[lane] = G; sc[64 + lane] = bt; sc[128 + lane] = eG; sc[192 + lane] = kd;
        ((float*)(ws + WS_EG))[(size_t)idx * 64 + lane] = eG;
        if (lane == 0) ((float*)(ws + WS_GL))[idx] = __expf(Glast);
        LDS_WAIT();
        bf16x8 Kf[4][4], Qf[4][4];
#pragma unroll
        for (int t = 0; t < 4; ++t)
#pragma unroll
            for (int ks = 0; ks < 4; ++ks) {
                const size_t off = (size_t)(tok0 + 16 * t + fr) * 1024 + h * 128 + 32 * ks + 8 * fq;
                Kf[t][ks] = *(const bf16x8*)((const bf16_t*)(ws + WS_KN) + off);
                Qf[t][ks] = *(const bf16x8*)((const bf16_t*)(ws + WS_QN) + off);
            }
#pragma unroll
        for (int it = 0; it < 4; ++it)
#pragma unroll
            for (int ks = 0; ks < 4; ++ks) {
                const f32x4 c0 = MFMA16(I0, Qf[it][ks], zero4), c1 = MFMA16(I1, Qf[it][ks], zero4);
                *(bf16x8*)(pack + PK_QF + ((size_t)((it * 4 + ks) * 64 + lane)) * 16) = pack8(c0, c1);
            }
#pragma unroll
        for (int it = 0; it < 4; ++it) {
            const float Gi = sc[16 * it + fr];
#pragma unroll
            for (int ks2 = 0; ks2 < 2; ++ks2) {
                f32x4 tl[2];
#pragma unroll
                for (int hh = 0; hh < 2; ++hh) {
                    const int jt = 2 * ks2 + hh;
                    f32x4 c = zero4;
                    if (jt <= it) {
#pragma unroll
                        for (int ks = 0; ks < 4; ++ks) c = MFMA16(Kf[jt][ks], Qf[it][ks], c);
#pragma unroll
                        for (int r = 0; r < 4; ++r) { const int j = 16 * jt + 4 * fq + r, i = 16 * it + fr; const float dc = __expf(Gi - sc[j]); c[r] = (i >= j) ? dc * c[r] : 0.f; }
                    }
                    tl[hh] = c;
                }
                *(bf16x8*)(pack + PK_AQK + ((size_t)((it * 2 + ks2) * 64 + lane)) * 16) = pack8(tl[0], tl[1]);
            }
        }
#pragma unroll
        for (int it = 0; it < 4; ++it)
#pragma unroll
            for (int jt = 0; jt < 4; ++jt) {
                if (jt <= it) {
                    f32x4 c = zero4;
#pragma unroll
                    for (int ks = 0; ks < 4; ++ks) c = MFMA16(Kf[it][ks], Kf[jt][ks], c);
                    const float Gj = sc[16 * jt + fr];
#pragma unroll
                    for (int r = 0; r < 4; ++r) { const int i = 16 * it + 4 * fq + r, j = 16 * jt + fr; const float v = sc[64 + i] * __expf(sc[i] - Gj) * c[r]; As[i * 64 + j] = (i > j) ? v : 0.f; }
                }
            }
        LDS_WAIT();
        asm volatile("" ::: "memory");
        float t[64];
        int lane_o = lane; asm volatile("" : "+v"(lane_o));
        float arow_nx = As[lane];
#pragma unroll
        for (int i = 0; i < 64; ++i) {
            const float arow = arow_nx;
            if (i < 63) arow_nx = As[(i + 1) * 64 + lane];
            asm volatile("" ::: "memory");
            float a0 = (lane_o == i) ? 1.f : 0.f, a1 = 0.f, a2 = 0.f, a3 = 0.f;
#pragma unroll
            for (int j = 0; j < i; ++j) {
                const float s = __builtin_bit_cast(float, __builtin_amdgcn_readlane(__builtin_bit_cast(int, arow), j));
                if ((j & 3) == 0) a0 -= s * t[j]; else if ((j & 3) == 1) a1 -= s * t[j]; else if ((j & 3) == 2) a2 -= s * t[j]; else a3 -= s * t[j];
            }
            t[i] = (a0 + a1) + (a2 + a3);
        }
        { const float bcol = sc[64 + lane];
#pragma unroll
          for (int i = 0; i < 64; ++i) Tp[i * 64 + lane] = f2bf(t[i] * bcol); }
        LDS_WAIT();
        bf16x8 Tf[4][2];
#pragma unroll
        for (int it = 0; it < 4; ++it)
#pragma unroll
            for (int ks2 = 0; ks2 < 2; ++ks2) {
                const LAS bf16_t* rp = Tp + (16 * it + fr) * 64 + 32 * ks2 + 4 * fq;
                const u32x2 lo = *(const LAS u32x2*)rp, hi = *(const LAS u32x2*)(rp + 16);
                u32x4 v; v.x = lo.x; v.y = lo.y; v.z = hi.x; v.w = hi.y; Tf[it][ks2] = __builtin_bit_cast(bf16x8, v);
            }
        asm volatile("" ::: "memory");
        bf16x8 Kg[4][4];
#pragma unroll
        for (int t2 = 0; t2 < 4; ++t2)
#pragma unroll
            for (int ks = 0; ks < 4; ++ks)
                Kg[t2][ks] = *(const bf16x8*)((const bf16_t*)(ws + WS_KN) + (size_t)(tok0 + 16 * t2 + fr) * 1024 + h * 128 + 32 * ks + 8 * fq);
#pragma unroll
        for (int ks = 0; ks < 4; ++ks) {
            bf16x8 R2f[2][2];
#pragma unroll
            for (int hh = 0; hh < 2; ++hh) {
                const int dkt = 2 * ks + hh;
#pragma unroll
                for (int ks2 = 0; ks2 < 2; ++ks2) {
                    f32x4 r2[2], r3[2];
#pragma unroll
                    for (int g = 0; g < 2; ++g) {
                        const int jt = 2 * ks2 + g;
                        const f32x4 kc = MFMA16(Kg[jt][ks], hh ? I1 : I0, zero4);
#pragma unroll
                        for (int r = 0; r < 4; ++r) { const int j = 16 * jt + 4 * fq + r; r2[g][r] = kc[r] * sc[128 + j]; r3[g][r] = kc[r] * sc[192 + j]; }
                    }
                    R2f[hh][ks2] = pack8(r2[0], r2[1]);
                    *(bf16x8*)(pack + PK_KDF + ((size_t)((dkt * 2 + ks2) * 64 + lane)) * 16) = pack8(r3[0], r3[1]);
                }
            }
#pragma unroll
            for (int it = 0; it < 4; ++it) {
                f32x4 c0 = zero4, c1 = zero4;
#pragma unroll
                for (int ks2 = 0; ks2 < 2; ++ks2) { c0 = MFMA16(R2f[0][ks2], Tf[it][ks2], c0); c1 = MFMA16(R2f[1][ks2], Tf[it][ks2], c1); }
                *(bf16x8*)(pack + PK_WKF + ((size_t)((it * 4 + ks) * 64 + lane)) * 16) = pack8(-c0, -c1);
            }
        }
        asm volatile("" ::: "memory");
        bf16x8 Vf[4][4];
#pragma unroll
        for (int t2 = 0; t2 < 4; ++t2)
#pragma unroll
            for (int ks = 0; ks < 4; ++ks)
                Vf[t2][ks] = *(const bf16x8*)((const bf16_t*)(ws + WS_VB) + (size_t)(tok0 + 16 * t2 + fr) * 1024 + h * 128 + 32 * ks + 8 * fq);
#pragma unroll
        for (int dvt = 0; dvt < 8; ++dvt) {
            bf16x8 R1f[2];
#pragma unroll
            for (int ks2 = 0; ks2 < 2; ++ks2) {
                const f32x4 v0 = MFMA16(Vf[2 * ks2][dvt >> 1], (dvt & 1) ? I1 : I0, zero4), v1 = MFMA16(Vf[2 * ks2 + 1][dvt >> 1], (dvt & 1) ? I1 : I0, zero4);
                R1f[ks2] = pack8(v0, v1);
            }
#pragma unroll
            for (int it = 0; it < 4; ++it) {
                f32x4 c = zero4;
#pragma unroll
                for (int ks2 = 0; ks2 < 2; ++ks2) c = MFMA16(Tf[it][ks2], R1f[ks2], c);
                u32x2 w; w.x = pk2(c.x, c.y); w.y = pk2(c.z, c.w);
                *(u32x2*)(pack + PK_WVC + ((size_t)((it * 8 + dvt) * 64 + lane)) * 8) = w;
            }
        }
        LDS_WAIT();
    }
}
constexpr int NSA2_EARLY = 116;
constexpr int SCAN_SPLIT = 1, SCAN_BLOCKS = 32 * SCAN_SPLIT, SCAN_STAGE = 57344;
#define SCAN_PIN(A_) asm volatile("" : "+v"(A_[0]), "+v"(A_[1]), "+v"(A_[2]), "+v"(A_[3]), "+v"(A_[4]), "+v"(A_[5]), "+v"(A_[6]), "+v"(A_[7]))
DI void scan_compute(const LAS unsigned char* cur, f32x4 (&U)[4], const float (&eg)[4], float gl, f32x4 (&S)[8], bf16_t* obp, int lane) {
    const LAS unsigned char* base = cur + lane * 16;
#define SCAN_LD(off_) (*(const LAS bf16x8*)(base + (off_)))
    bf16x8 A0[8], A1[8];
#pragma unroll
    for (int i = 0; i < 8; ++i) A0[i] = SCAN_LD(PK_WKF + i * 1024);
#pragma unroll
    for (int i = 0; i < 8; ++i) A1[i] = SCAN_LD(PK_WKF + (8 + i) * 1024);
    bf16x8 Sb[4];
#pragma unroll
    for (int ks = 0; ks < 4; ++ks) Sb[ks] = pack8(S[2 * ks], S[2 * ks + 1]);
    SCAN_PIN(A0);
#pragma unroll
    for (int ks = 0; ks < 4; ++ks) { U[0] = MFMA16(A0[ks], Sb[ks], U[0]); U[1] = MFMA16(A0[4 + ks], Sb[ks], U[1]); }
#pragma unroll
    for (int i = 0; i < 8; ++i) A0[i] = SCAN_LD(PK_QF + i * 1024);
    SCAN_PIN(A1);
#pragma unroll
    for (int ks = 0; ks < 4; ++ks) { U[2] = MFMA16(A1[ks], Sb[ks], U[2]); U[3] = MFMA16(A1[4 + ks], Sb[ks], U[3]); }
#pragma unroll
    for (int i = 0; i < 8; ++i) A1[i] = SCAN_LD(PK_QF + (8 + i) * 1024);
    bf16x8 Ub[2];
    Ub[0] = pack8(U[0], U[1]); Ub[1] = pack8(U[2], U[3]);
    f32x4 O[4];
#pragma unroll
    for (int it = 0; it < 4; ++it) O[it] = (f32x4){0.f, 0.f, 0.f, 0.f};
    SCAN_PIN(A0);
#pragma unroll
    for (int ks = 0; ks < 4; ++ks) { O[0] = MFMA16(Sb[ks], A0[ks], O[0]); O[1] = MFMA16(Sb[ks], A0[4 + ks], O[1]); }
#pragma unroll
    for (int i = 0; i < 8; ++i) A0[i] = SCAN_LD(PK_AQK + i * 1024);
    SCAN_PIN(A1);
#pragma unroll
    for (int ks = 0; ks < 4; ++ks) { O[2] = MFMA16(Sb[ks], A1[ks], O[2]); O[3] = MFMA16(Sb[ks], A1[4 + ks], O[3]); }
#pragma unroll
    for (int i = 0; i < 8; ++i) A1[i] = SCAN_LD(PK_KDF + i * 1024);
#pragma unroll
    for (int it = 0; it < 4; ++it) O[it] = O[it] * eg[it];
    SCAN_PIN(A0);
#pragma unroll
    for (int it = 0; it < 4; ++it) { O[it] = MFMA16(Ub[0], A0[2 * it], O[it]); O[it] = MFMA16(Ub[1], A0[2 * it + 1], O[it]); }
#pragma unroll
    for (int i = 0; i < 8; ++i) A0[i] = SCAN_LD(PK_KDF + (8 + i) * 1024);
#pragma unroll
    for (int it = 0; it < 4; ++it) { u32x2 o; o.x = pk2(O[it].x, O[it].y); o.y = pk2(O[it].z, O[it].w); *(u32x2*)(obp + (size_t)(16 * it) * 1024) = o; }
    SCAN_PIN(A1);
#pragma unroll
    for (int dkt = 0; dkt < 4; ++dkt) { f32x4 c = S[dkt] * gl; c = MFMA16(A1[2 * dkt], Ub[0], c); c = MFMA16(A1[2 * dkt + 1], Ub[1], c); S[dkt] = c; }
    SCAN_PIN(A0);
#pragma unroll
    for (int dkt = 0; dkt < 4; ++dkt) { f32x4 c = S[4 + dkt] * gl; c = MFMA16(A0[2 * dkt], Ub[0], c); c = MFMA16(A0[2 * dkt + 1], Ub[1], c); S[4 + dkt] = c; }
#undef SCAN_LD
}
#define SCAN_LOAD(X, nn) { const int idx_ = idx0 + (nn) * 8; const unsigned char* pk_ = ws + WS_PACK + (size_t)idx_ * PK_SIZE; \
    _Pragma("unroll") for (int i = 0; i < 7; ++i) pf##X[i] = *(const u32x4*)(pk_ + tid * 16 + i * 8192); \
    _Pragma("unroll") for (int it = 0; it < 4; ++it) wv##X[it] = *(const u32x2*)(pk_ + PK_WVC + ((size_t)((it * 8 + w) * 64 + lane)) * 8); \
    ex##X = tid < 64 ? EGp[(size_t)idx_ * 64 + tid] : GLp[idx_]; }
#define SCAN_STEP(n_, X, Y) { const int n = (n_); \
    const LAS unsigned char* cur = lds + (n & 1) * SCAN_STAGE; LAS unsigned char* nxt = lds + ((n + 1) & 1) * SCAN_STAGE; \
    f32x4 U[4]; float eg[4]; \
    const LAS float* exc = (const LAS float*)(lds + 2 * SCAN_STAGE + (n & 1) * 512); \
    _Pragma("unroll") for (int it = 0; it < 4; ++it) { U[it] = (f32x4){bflo(wv##X[it].x), bfhi(wv##X[it].x), bflo(wv##X[it].y), bfhi(wv##X[it].y)}; eg[it] = exc[16 * it + fr]; } \
    const float gl = exc[64]; \
    SCAN_LOAD(X, (n + 2 < 64 ? n + 2 : 63))             \
    if (comp) scan_compute(cur, U, eg, gl, S, ob + (size_t)(b * 4096 + 64 * n + fr) * 1024 + h * 128 + 16 * w + 4 * fq, lane); \
    { _Pragma("unroll") for (int i = 0; i < 7; ++i) *(LAS u32x4*)(nxt + tid * 16 + i * 8192) = pf##Y[i]; \
      if (tid <= 64) *(LAS float*)(lds + 2 * SCAN_STAGE + ((n + 1) & 1) * 512 + tid * 4) = ex##Y; } \
    asm volatile("s_waitcnt lgkmcnt(0)" ::: "memory"); __builtin_amdgcn_s_barrier(); asm volatile("" ::: "memory"); }
DI void d4_scan_prompt(CArgs& A, int l, int blk, LAS unsigned char* lds, int tid, int wave, int lane) {
    unsigned char* ws = A.ws;
    const int bh = blk / SCAN_SPLIT, half = blk % SCAN_SPLIT;
    const int b = bh >> 3, h = bh & 7, fr = lane & 15, fq = lane >> 4;
    const bool comp = SCAN_SPLIT == 1 ? true : wave < 8 / SCAN_SPLIT;
    const int w = half * (8 / SCAN_SPLIT) + (comp ? wave : 0);
    f32x4 S[8];
#pragma unroll
    for (int i = 0; i < 8; ++i) S[i] = (f32x4){0.f, 0.f, 0.f, 0.f};
    const float* EGp = (const float*)(ws + WS_EG);
    const float* GLp = (const float*)(ws + WS_GL);
    bf16_t* ob = (bf16_t*)(ws + WS_OB);
    const int idx0 = (b * 64) * 8 + h;
    u32x4 pfA[7], pfB[7];
    u32x2 wvA[4], wvB[4]; float exA, exB;
    SCAN_LOAD(A, 0)
    SCAN_LOAD(B, 1)
#pragma unroll
    for (int i = 0; i < 7; ++i) *(LAS u32x4*)(lds + tid * 16 + i * 8192) = pfA[i];
    if (tid <= 64) *(LAS float*)(lds + 2 * SCAN_STAGE + tid * 4) = exA;
    __syncthreads();
#pragma unroll 1
    for (int n2 = 0; n2 < 64; n2 += 2) {
        SCAN_STEP(n2, A, B)
        SCAN_STEP(n2 + 1, B, A)
    }
    if (comp) {
        float* so = A.out + O_PS + ((size_t)((l * 4 + b) * 8 + h)) * 16384;
#pragma unroll
        for (int dkt = 0; dkt < 8; ++dkt)
#pragma unroll
            for (int r = 0; r < 4; ++r) so[(size_t)(16 * dkt + 4 * fq + r) * 128 + 16 * w + fr] = S[dkt][r];
    }
}
DI void d4_sample_item(CArgs& A, int l, int item, LAS float* L, int tid, int wave, int lane) {
    unsigned char* ws = A.ws;
    const int b = item >> 3, h = item & 7, tok0 = TP + 4 * b;
    LAS float* sq = L;
    LAS float* sk = L + 512;
    LAS float* sv = L + 1024;
    LAS float* sgb = L + 1536;
    LAS float* dots = L + 1544;
    LAS float* red = L + 1600;
    const int dv = tid & 127, dkq = tid >> 7;
    for (int i2 = tid; i2 < 1536; i2 += NTHR) {
        const int part = i2 >> 9, i = (i2 >> 7) & 3, d = i2 & 127;
        const bf16_t* src = (const bf16_t*)(ws + (part == 0 ? WS_QN : part == 1 ? WS_KN : WS_VB));
        L[i2] = bf2f(src[(size_t)(tok0 + i) * 1024 + h * 128 + d]);
    }
    if (tid < 4) { sgb[tid] = ((const float*)(ws + WS_GG))[(size_t)(tok0 + tid) * 8 + h]; sgb[4 + tid] = ((const float*)(ws + WS_BETA))[(size_t)(tok0 + tid) * 8 + h]; }
    const float* S0 = IN_F(I_SDNS) + ((size_t)((l * 128 + b) * 8 + h)) * 16384;
    float s0[32];
#pragma unroll
    for (int u = 0; u < 32; ++u) s0[u] = S0[(size_t)(32 * dkq + u) * 128 + dv];
    __syncthreads();
#pragma unroll
    for (int u = 0; u < 4; ++u) {
        const int p = 4 * wave + u, i = (p >> 2) & 3, j = p & 3;
        const LAS float* a = (p < 16) ? sk + i * 128 : sq + i * 128;
        float s = a[lane] * sk[j * 128 + lane] + a[lane + 64] * sk[j * 128 + lane + 64];
        s = wave_sum(s);
        if (lane == 0) dots[p] = s;
    }
    __syncthreads();
    float G[4], bt[4], eG[4];
    { float acc = 0.f;
#pragma unroll
      for (int i = 0; i < 4; ++i) { acc += sgb[i]; G[i] = acc; bt[i] = sgb[4 + i]; eG[i] = __expf(acc); } }
    float Am[4][4], T[4][4];
#pragma unroll
    for (int i = 0; i < 4; ++i)
#pragma unroll
        for (int j = 0; j < 4; ++j) { Am[i][j] = (i > j) ? bt[i] * __expf(G[i] - G[j]) * dots[i * 4 + j] : 0.f; T[i][j] = (i == j) ? 1.f : 0.f; }
#pragma unroll
    for (int i = 1; i < 4; ++i)
#pragma unroll
        for (int c = 0; c < i; ++c) { float acc = 0.f;
#pragma unroll
            for (int j = c; j < i; ++j) acc -= Am[i][j] * T[j][c];
            T[i][c] = acc; }
    float pU[4] = {0.f, 0.f, 0.f, 0.f}, pQ[4] = {0.f, 0.f, 0.f, 0.f};
#pragma unroll 4
    for (int u = 0; u < 32; ++u) {
        const int dk = 32 * dkq + u;
        float kj[4], qj[4];
#pragma unroll
        for (int j = 0; j < 4; ++j) { kj[j] = sk[j * 128 + dk]; qj[j] = sq[j * 128 + dk]; }
#pragma unroll
        for (int i = 0; i < 4; ++i) {
            float wk = 0.f;
#pragma unroll
            for (int j = 0; j <= i; ++j) wk += T[i][j] * bt[j] * eG[j] * kj[j];
            pU[i] += wk * s0[u]; pQ[i] += qj[i] * s0[u];
        }
    }
#pragma unroll
    for (int i = 0; i < 4; ++i) { red[(i * 4 + dkq) * 128 + dv] = pU[i]; red[((4 + i) * 4 + dkq) * 128 + dv] = pQ[i]; }
    __syncthreads();
    float U[4];
#pragma unroll
    for (int i = 0; i < 4; ++i) {
        float wv = 0.f;
#pragma unroll
        for (int j = 0; j <= i; ++j) wv += T[i][j] * bt[j] * sv[j * 128 + dv];
        U[i] = wv - ((red[(i * 4 + 0) * 128 + dv] + red[(i * 4 + 1) * 128 + dv]) + (red[(i * 4 + 2) * 128 + dv] + red[(i * 4 + 3) * 128 + dv]));
    }
    if (dkq == 0) {
#pragma unroll
        for (int i = 0; i < 4; ++i) {
            float o = eG[i] * ((red[((4 + i) * 4 + 0) * 128 + dv] + red[((4 + i) * 4 + 1) * 128 + dv]) + (red[((4 + i) * 4 + 2) * 128 + dv] + red[((4 + i) * 4 + 3) * 128 + dv]));
#pragma unroll
            for (int j = 0; j <= i; ++j) o += __expf(G[i] - G[j]) * dots[16 + i * 4 + j] * U[j];
            ((bf16_t*)(ws + WS_OB))[(size_t)(tok0 + i) * 1024 + h * 128 + dv] = f2bf(o);
        }
    }
    const float gl = eG[3];
    float* So = A.out + O_SS + ((size_t)((l * 128 + b) * 8 + h)) * 16384;
#pragma unroll 4
    for (int u = 0; u < 32; ++u) {
        const int dk = 32 * dkq + u;
        float acc = gl * s0[u];
#pragma unroll
        for (int i = 0; i < 4; ++i) acc += __expf(G[3] - G[i]) * sk[i * 128 + dk] * U[i];
        So[(size_t)dk * 128 + dv] = acc;
    }
    __syncthreads();
}
DI void phase_d4(CArgs& A, int l, LAS unsigned char* lds, int tid, int wave, int lane) {
    if (blockIdx.x < SCAN_BLOCKS) { if (!(A.dup_mask >> 31)) d4_scan_prompt(A, l, blockIdx.x, lds, tid, wave, lane); }
    else if (!((A.dup_mask >> 30) & 1u)) {
        for (int it = blockIdx.x - SCAN_BLOCKS; it < 1024; it += gridDim.x - SCAN_BLOCKS) d4_sample_item(A, l, it, (LAS float*)lds, tid, wave, lane);
        for (int it = l * 1280 + (blockIdx.x - SCAN_BLOCKS); it < (l + 1) * 1280; it += gridDim.x - SCAN_BLOCKS) sample_conv_item(A, it, lds, tid);
    }
}
DI void phase_d5(CArgs& A, int l, int wave, int lane) {
    unsigned char* ws = A.ws;
    const int gw = blockIdx.x * NWAVES + wave, NGW = gridDim.x * NWAVES;
    const float* onw = IN_F(I_DNONORM) + l * 128;
    float wn[8];
#pragma unroll
    for (int e = 0; e < 8; ++e) wn[e] = onw[(8 * lane + e) & 127];
    for (int tok0 = gw; tok0 < TT / 2; tok0 += NGW) {
        u32x4 ro[4], rz[4];
#pragma unroll
        for (int q = 0; q < 4; ++q) {
            const size_t off = (size_t)(tok0 + (q >> 1) * (TT / 2)) * 1024 + (q & 1) * 512 + 8 * lane;
            ro[q] = *(const u32x4*)((const bf16_t*)(ws + WS_OB) + off); rz[q] = *(const u32x4*)((const bf16_t*)(ws + WS_ZB) + off);
        }
#pragma unroll
        for (int q = 0; q < 4; ++q) {
            const size_t off = (size_t)(tok0 + (q >> 1) * (TT / 2)) * 1024 + (q & 1) * 512 + 8 * lane;
            float o[8], z[8];
            unpack8(ro[q], o); unpack8(rz[q], z);
            float ss = 0.f;
#pragma unroll
            for (int e = 0; e < 8; ++e) ss += o[e] * o[e];
            ss = row16_sum(ss);
            const float r = rsqrtf(ss * (1.0f / 128.0f) + EPS);
            float y[8];
#pragma unroll
            for (int e = 0; e < 8; ++e) y[e] = o[e] * r * wn[e] * siluf_(z[e]);
            u32x4 w; w.x = pk2(y[0], y[1]); w.y = pk2(y[2], y[3]); w.z = pk2(y[4], y[5]); w.w = pk2(y[6], y[7]);
            *(u32x4*)((bf16_t*)(ws + WS_OB) + off) = w;
        }
    }
}
DI void phase_n1(CArgs& A, LAS unsigned char* lds, int tid, int rank, int nranks) {
    unsigned char* ws = A.ws;
    LAS float* blkS = (LAS float*)lds;
    if (nranks < 1) { rank = blockIdx.x; nranks = gridDim.x; }
    if (rank < 0) return;
    for (int it = rank; it < 128; it += nranks) {
        const int b = it >> 5, g = it & 31;
        const float* src = A.out + O_PKV + ((size_t)b * 4096 + 128 * g) * 1024;
        cmp_item(src, src + 128 * 1024, 1024, g < 31 ? 9 : 8, IN_F(I_CMPPOSW), IN_F(I_WCMP), (bf16_t*)(ws + WS_CKP) + (size_t)b * 4 * 256 * 64, (bf16_t*)(ws + WS_CVP) + (size_t)b * 4 * 64 * 256, 256, 8 * g, blkS, tid);
    }
}
struct AttnState { float m, l; f32x4 o[4]; };
template <int MODE>
DI void attend_block(const bf16_t* Kb, const bf16_t* Vb, const bf16x8 (&Qf)[2], int dist0, bool colsel, bool far, float biasfar, const LAS float* bp, AttnState& st, int fr, int fq) {
    f32x4 s[4];
    bf16x8 Kf[4][2], Vf[4][2];
#pragma unroll
    for (int kt = 0; kt < 4; ++kt) { const bf16_t* kp = Kb + (16 * kt + fr) * 64 + 8 * fq; Kf[kt][0] = *(const bf16x8*)kp; Kf[kt][1] = *(const bf16x8*)(kp + 32); }
#pragma unroll
    for (int dt = 0; dt < 4; ++dt) { const bf16_t* vp = Vb + (16 * dt + fr) * 64 + 8 * fq; Vf[dt][0] = *(const bf16x8*)vp; Vf[dt][1] = *(const bf16x8*)(vp + 32); }
    asm volatile("" : "+v"(Vf[0][0]), "+v"(Vf[0][1]), "+v"(Vf[1][0]), "+v"(Vf[1][1]), "+v"(Vf[2][0]), "+v"(Vf[2][1]), "+v"(Vf[3][0]), "+v"(Vf[3][1]));
#pragma unroll
    for (int kt = 0; kt < 4; ++kt) {
        f32x4 z = {0.f, 0.f, 0.f, 0.f};
        z = MFMA16(Kf[kt][0], Qf[0], z); z = MFMA16(Kf[kt][1], Qf[1], z);
        s[kt] = z;
    }
    float bm = -1e30f;
    float bv[4][4];
    {
        const LAS float* bq = far ? bp - (dist0 - 1024) : bp;
#pragma unroll
        for (int kt = 0; kt < 4; ++kt)
#pragma unroll
            for (int r = 0; r < 4; ++r) bv[kt][r] = bq[-(16 * kt + r)];
        asm volatile("" : "+v"(bv[0][0]), "+v"(bv[0][1]), "+v"(bv[0][2]), "+v"(bv[0][3]), "+v"(bv[1][0]), "+v"(bv[1][1]), "+v"(bv[1][2]), "+v"(bv[1][3]),
                          "+v"(bv[2][0]), "+v"(bv[2][1]), "+v"(bv[2][2]), "+v"(bv[2][3]), "+v"(bv[3][0]), "+v"(bv[3][1]), "+v"(bv[3][2]), "+v"(bv[3][3]));
    }
#pragma unroll
    for (int kt = 0; kt < 4; ++kt)
#pragma unroll
        for (int r = 0; r < 4; ++r) {
            const int dist = dist0 - 16 * kt - r;
            const bool valid = (MODE == 0) ? (colsel && dist >= 0) : (dist >= 0 && dist < 512);
            const float bias = far ? biasfar : bv[kt][r];
            const float v = valid ? s[kt][r] + bias : -1e30f;
            s[kt][r] = v; bm = fmaxf(bm, v);
        }
    bm = rows_max(bm);
    const float mn = fmaxf(st.m, bm), alpha = __expf(st.m - mn);
    st.m = mn;
    float ps = 0.f;
#pragma unroll
    for (int kt = 0; kt < 4; ++kt)
#pragma unroll
        for (int r = 0; r < 4; ++r) { const float p = (s[kt][r] > -1e29f) ? __expf(s[kt][r] - mn) : 0.f; s[kt][r] = p; ps += p; }
    st.l = st.l * alpha + ps;
    bf16x8 Pf[2]; Pf[0] = pack8(s[0], s[1]); Pf[1] = pack8(s[2], s[3]);
#pragma unroll
    for (int dt = 0; dt < 4; ++dt) {
        f32x4 c = st.o[dt] * alpha;
        c = MFMA16(Vf[dt][0], Pf[0], c); c = MFMA16(Vf[dt][1], Pf[1], c);
        st.o[dt] = c;
    }
}
template <bool LSRC>
DI void cmp_branch(const bf16_t* CK, const bf16_t* CV, const LAS unsigned char* CKL, const LAS unsigned char* CVL, int cvpitch, int NK, int nblk, const bf16x8 (&Qf)[2], int qpos, int qpos0, float g_cmp, const LAS float* bth, LAS float* scoreL, int lane,
                   f32x4 (&OUT)[4], unsigned long long (&msel)[4]) {
    const int fr = lane & 15, fq = lane >> 4, qa = fr >> 2, hh = fr & 3, qmax = qpos0 + 3;
    const int ncv = qmax >= 31 ? ((qmax - 31) >> 4) + 1 : 0;
    const int ntile = (ncv + 15) >> 4;
    f32x4 lg[16];
#pragma unroll
    for (int kt = 0; kt < 16; ++kt) {
        if (kt < ntile) {
            f32x4 z = {0.f, 0.f, 0.f, 0.f};
            if (LSRC) { const int row = 16 * kt + fr; const LAS unsigned char* kp = CKL + row * 128;
                z = MFMA16(*(const LAS bf16x8*)(kp + ((fq ^ (row & 7)) << 4)), Qf[0], z); z = MFMA16(*(const LAS bf16x8*)(kp + (((fq + 4) ^ (row & 7)) << 4)), Qf[1], z); }
            else { const bf16_t* kp = CK + (size_t)(16 * kt + fr) * 64 + 8 * fq;
                z = MFMA16(*(const bf16x8*)kp, Qf[0], z); z = MFMA16(*(const bf16x8*)(kp + 32), Qf[1], z); }
            {
                const int dist0 = qpos - (16 * (16 * kt + 4 * fq) + 31);
                float bv[4];
#pragma unroll
                for (int r = 0; r < 4; ++r) { int di = dist0 - 16 * r; di = di < -BT_OFF ? -BT_OFF : di; di = di > 1100 ? 1100 : di; bv[r] = bth[di]; }
                asm volatile("" : "+v"(bv[0]), "+v"(bv[1]), "+v"(bv[2]), "+v"(bv[3]));
#pragma unroll
                for (int r = 0; r < 4; ++r) z[r] = (dist0 - 16 * r >= 0) ? z[r] + bv[r] : -1e30f;
            }
            lg[kt] = z;
        } else lg[kt] = (f32x4){-1e30f, -1e30f, -1e30f, -1e30f};
    }
    float mx = -1e30f;
#pragma unroll
    for (int kt = 0; kt < 16; ++kt) mx = fmaxf(fmaxf(fmaxf(mx, lg[kt][0]), fmaxf(lg[kt][1], lg[kt][2])), lg[kt][3]);
    mx = rows_max(mx);
    float sm = 0.f;
#pragma unroll
    for (int kt = 0; kt < 16; ++kt)
#pragma unroll
        for (int r = 0; r < 4; ++r) { const float p = lg[kt][r] > -1e29f ? __expf(lg[kt][r] - mx) : 0.f; lg[kt][r] = p; sm += p; }
    sm = rows_sum(sm);
    const float inv = __builtin_amdgcn_rcpf(fmaxf(sm, 1e-30f));
#pragma unroll
    for (int kt = 0; kt < 16; ++kt) lg[kt] = lg[kt] * inv;
#pragma unroll
    for (int dt = 0; dt < 4; ++dt) OUT[dt] = (f32x4){0.f, 0.f, 0.f, 0.f};
#pragma unroll
    for (int s2 = 0; s2 < 8; ++s2) {
        if (2 * s2 < ntile) {
            const bf16x8 Pf = pack8(lg[2 * s2], lg[2 * s2 + 1]);
#pragma unroll
            for (int dt = 0; dt < 4; ++dt) {
                if (LSRC) { const int row = 16 * dt + fr; OUT[dt] = MFMA16(*(const LAS bf16x8*)(CVL + row * cvpitch + (((4 * s2 + fq) ^ (row & 7)) << 4)), Pf, OUT[dt]); }
                else OUT[dt] = MFMA16(*(const bf16x8*)(CV + (size_t)(16 * dt + fr) * NK + 32 * s2 + 8 * fq), Pf, OUT[dt]);
            }
        }
    }
#pragma unroll
    for (int dt = 0; dt < 4; ++dt) OUT[dt] = OUT[dt] * g_cmp;
    const int cur = qpos >> 6;
    const int ctu = __builtin_amdgcn_readfirstlane(cur >> 2);
    {
        float prevx3 = 0.f;
#pragma unroll
        for (int kt = 0; kt < 16; ++kt) {
            if (kt > ctu) {
                const int blk = 4 * kt + fq; const float sc = blk >= nblk ? -3e38f : -1.0f;
                unsigned uk = ~__float_as_uint(sc);
                if (hh == 0) scoreL[qa * 64 + blk] = __uint_as_float((uk & ~63u) | (unsigned)(63 - blk));
                continue;
            }
            f32x4 x = lg[kt];
#pragma unroll
            for (int r = 0; r < 4; ++r) x[r] = quad_sum(x[r]);
            const u32x2s cd = __builtin_amdgcn_permlane16_swap(__float_as_uint(x[3]), __float_as_uint(x[3]), false, false);
            const u32x2s ef = __builtin_amdgcn_permlane32_swap(cd.y, cd.y, false, false);
            const float up = fq == 2 ? __uint_as_float(ef.x) : __uint_as_float(cd.x);
            const float pv = fq > 0 ? up : prevx3;
            prevx3 = __uint_as_float(ef.y);
            const float pslc = 2.0f * (x[0] + x[1] + x[2]) + x[3] + pv;
            const int blk = 4 * kt + fq;
            const bool forced = (blk == 0) | (blk == cur) | (blk == cur - 1);
            float sc = forced ? 1e4f : (blk <= cur ? pslc : -1.0f);
            if (blk >= nblk) sc = -3e38f;
            unsigned uk = __float_as_uint(sc); uk = (uk & 0x80000000u) ? ~uk : (uk | 0x80000000u);
            if (hh == 0) scoreL[qa * 64 + blk] = __uint_as_float((uk & ~63u) | (unsigned)(63 - blk));
        }
    }
    LDS_WAIT();
#pragma unroll
    for (int q = 0; q < 4; ++q) {
        const unsigned s = __float_as_uint(scoreL[q * 64 + lane]);
        int rank = 0;
#pragma unroll
        for (int p4 = 0; p4 < 16; ++p4) {
            if (p4 <= ctu) {
                const f32x4 v = *(const LAS f32x4*)(scoreL + q * 64 + 4 * p4);
#pragma unroll
                for (int e = 0; e < 4; ++e) rank += (__float_as_uint(v[e]) > s) ? 1 : 0;
            }
        }
        const int curq = (qpos0 + q) >> 6;
        const unsigned long long vm = curq >= 63 ? ~0ull : ((1ull << (curq + 1)) - 1ull);
        msel[q] = __ballot(rank < 16) & vm;
    }
    LDS_WAIT();
}
constexpr int AT_SCORE = 16 * BT_STRIDE * 4;
constexpr int AP_SCORE = 4 * BT_STRIDE * 4;
constexpr int AT_MASK = AP_SCORE + 8 * 1024;
constexpr int AT_LIST = AT_MASK + 512;
constexpr int AT_RING = 29696;
constexpr int AT_CMPK = AT_RING + 49152;
constexpr int AT_CMPV = AT_CMPK + 32768;
static_assert(AT_CMPV + 32768 <= LDS_BARW, "attention LDS map");
constexpr int AS_CMPK = 29696, AS_CMPV = AS_CMPK + 16384;
constexpr int AS_PART = AS_CMPK; static_assert(AS_PART + 8 * 2 * 18 * 64 * 4 <= LDS_BARW, "partials fit below the barrier words");
DI void attn_sample_item(CArgs& A, int item, LAS unsigned char* lds, int wave) {
    unsigned char* ws = A.ws;
    const int lane = lane_id(), tid = wave * 64 + lane, fr = lane & 15, fq = lane >> 4, qa = fr >> 2, hh = fr & 3;
    const int b = item >> 2, kvh = item & 3, tok0 = TP + 4 * b, qpos0 = 2048;
    LAS float* BT4 = (LAS float*)lds;
    LAS float* scoreL = (LAS float*)(lds + AP_SCORE);
    LAS unsigned long long* maskL = (LAS unsigned long long*)(lds + AT_MASK);
    LAS float* part = (LAS float*)(lds + AS_PART);
    const bf16_t* CK = (const bf16_t*)(ws + WS_CKS) + (size_t)(b * 4 + kvh) * 128 * 64;
    const bf16_t* CV = (const bf16_t*)(ws + WS_CVS) + (size_t)(b * 4 + kvh) * 64 * 128;
    const bf16_t* KS = (const bf16_t*)(ws + WS_KSELS) + (size_t)(b * 4 + kvh) * 33 * 4096;
    const bf16_t* VS = (const bf16_t*)(ws + WS_VSELS) + (size_t)(b * 4 + kvh) * 33 * 4096;
    const bf16_t* KW = (const bf16_t*)(ws + WS_KWINS) + ((ptrdiff_t)(b * 4 + kvh) * 9 - 24) * 4096;
    const bf16_t* VW = (const bf16_t*)(ws + WS_VWINS) + ((ptrdiff_t)(b * 4 + kvh) * 9 - 24) * 4096;
    {
        const float* btg = (const float*)(ws + WS_BT) + (size_t)(4 * kvh) * BT_STRIDE;
        for (int i = tid; i < 4 * BT_STRIDE; i += NTHR) BT4[i] = btg[i];
#pragma unroll
        for (int i = 0; i < 2; ++i) {
            const int c = tid + 512 * i, r = c >> 3, c8 = c & 7, d = c >> 4, cc = c & 15;
            *(LAS u32x4*)(lds + AS_CMPK + r * 128 + ((c8 ^ (r & 7)) << 4)) = *(const u32x4*)(CK + (size_t)r * 64 + c8 * 8);
            *(LAS u32x4*)(lds + AS_CMPV + d * 256 + ((cc ^ (d & 7)) << 4)) = *(const u32x4*)(CV + (size_t)d * 128 + cc * 8);
        }
    }
    __syncthreads();
    const int qpos = qpos0 + qa, qmax = qpos0 + 3, qmin = qpos0, hg = 4 * kvh + hh, tok = tok0 + qa;
    const LAS float* bth = BT4 + hh * BT_STRIDE + BT_OFF;
    const float biasfar = bth[1024];
    const bf16_t* QB = (const bf16_t*)(ws + WS_QB);
    bf16x8 Qf[2];
    Qf[0] = *(const bf16x8*)(QB + (size_t)tok * 1024 + hg * 64 + 8 * fq);
    Qf[1] = *(const bf16x8*)(QB + (size_t)tok * 1024 + hg * 64 + 32 + 8 * fq);
    AttnState stS, stW;
    stS.m = -1e30f; stS.l = 0.f; stW.m = -1e30f; stW.l = 0.f;
#pragma unroll
    for (int dt = 0; dt < 4; ++dt) { stS.o[dt] = (f32x4){0.f, 0.f, 0.f, 0.f}; stW.o[dt] = (f32x4){0.f, 0.f, 0.f, 0.f}; }
    f32x4 OUT[4];
#pragma unroll
    for (int dt = 0; dt < 4; ++dt) OUT[dt] = (f32x4){0.f, 0.f, 0.f, 0.f};
    const int wlo = (qmin - 511) >> 6, whi = qmax >> 6;
    if (wave == 0) {
        const float g_cmp = ((const float*)(ws + WS_GATES))[(size_t)tok * 48 + hg * 3];
        unsigned long long msel[4];
        cmp_branch<true>(CK, CV, lds + AS_CMPK, lds + AS_CMPV, 256, 128, 33, Qf, qpos, qpos0, g_cmp, bth, scoreL, lane, OUT, msel);
        if (lane < 4) maskL[lane] = lane == 0 ? msel[0] : lane == 1 ? msel[1] : lane == 2 ? msel[2] : msel[3];
    } else {
        for (int blk = wlo + wave - 1; blk <= whi; blk += 7) {
            const int dist0 = qpos - 64 * blk - 4 * fq;
            attend_block<1>(KW + (size_t)blk * 4096, VW + (size_t)blk * 4096, Qf, dist0, true, false, biasfar, bth + dist0, stW, fr, fq);
        }
    }
    __syncthreads();
    {
        const unsigned long long m0 = maskL[0], m1 = maskL[1], m2 = maskL[2], m3 = maskL[3];
        const unsigned long long mymask = qa == 0 ? m0 : qa == 1 ? m1 : qa == 2 ? m2 : m3;
        unsigned long long um = m0 | m1 | m2 | m3;
        int idx = 0;
        while (um) {
            const int blk = __builtin_ctzll(um); um &= um - 1ull;
            if ((idx & 7) == wave) {
                const int bpos = 64 * blk, dist0 = qpos - bpos - 4 * fq;
                const bool far = (qmin - bpos - 63) >= 1024;
                attend_block<0>(KS + (size_t)blk * 4096, VS + (size_t)blk * 4096, Qf, dist0, ((mymask >> blk) & 1ull) != 0ull, far, biasfar, bth + dist0, stS, fr, fq);
            }
            ++idx;
        }
    }
    {
        LAS float* ps = part + (size_t)((wave * 2 + 0) * 18) * 64 + lane; LAS float* pw = part + (size_t)((wave * 2 + 1) * 18) * 64 + lane;
        ps[0] = stS.m; ps[64] = stS.l; pw[0] = stW.m; pw[64] = stW.l;
#pragma unroll
        for (int dt = 0; dt < 4; ++dt)
#pragma unroll
            for (int r = 0; r < 4; ++r) { ps[(2 + dt * 4 + r) * 64] = stS.o[dt][r]; pw[(2 + dt * 4 + r) * 64] = stW.o[dt][r]; }
    }
    __syncthreads();
    if (wave == 0) {
        const float* gp = (const float*)(ws + WS_GATES) + (size_t)tok * 48 + hg * 3;
#pragma unroll
        for (int br = 0; br < 2; ++br) {
            float M = -1e30f;
#pragma unroll
            for (int w2 = 0; w2 < 8; ++w2) M = fmaxf(M, part[(size_t)((w2 * 2 + br) * 18) * 64 + lane]);
            float L = 0.f; f32x4 O[4];
#pragma unroll
            for (int dt = 0; dt < 4; ++dt) O[dt] = (f32x4){0.f, 0.f, 0.f, 0.f};
#pragma unroll
            for (int w2 = 0; w2 < 8; ++w2) {
                const LAS float* pp = part + (size_t)((w2 * 2 + br) * 18) * 64 + lane;
                const float sc = __expf(pp[0] - M);
                L += pp[64] * sc;
#pragma unroll
                for (int dt = 0; dt < 4; ++dt)
#pragma unroll
                    for (int r = 0; r < 4; ++r) O[dt][r] += pp[(2 + dt * 4 + r) * 64] * sc;
            }
            L = rows_sum(L);
            const float g = gp[1 + br] / fmaxf(L, 1e-30f);
#pragma unroll
            for (int dt = 0; dt < 4; ++dt) OUT[dt] += O[dt] * g;
        }
        bf16_t* op = (bf16_t*)(ws + WS_OB) + (size_t)tok * 1024 + hg * 64 + 4 * fq;
#pragma unroll
        for (int dt = 0; dt < 4; ++dt) { u32x2 w; w.x = pk2(OUT[dt].x, OUT[dt].y); w.y = pk2(OUT[dt].z, OUT[dt].w); *(u32x2*)(op + 16 * dt) = w; }
    }
    __syncthreads();
}
constexpr float LOG2E = 1.4426950408889634f;
template <int KIND, bool FAR>
DI void ring_pair_qk(const bf16x8 (&Kf)[4][2], const bf16x8 (&Qf)[2][2], const int (&dist0)[2], const bool (&colsel)[2], float biasfar, const LAS float* bth, AttnState (&st)[2], f32x4 (&lacc)[2], bf16x8 (&Pf)[2][2]) {
    f32x4 s[2][4];
#pragma unroll
    for (int kt = 0; kt < 4; ++kt)
#pragma unroll
        for (int g = 0; g < 2; ++g) { f32x4 z = {0.f, 0.f, 0.f, 0.f}; z = MFMA16(Kf[kt][0], Qf[g][0], z); z = MFMA16(Kf[kt][1], Qf[g][1], z); s[g][kt] = z; }
    float bm[2];
#pragma unroll
    for (int g = 0; g < 2; ++g) {
        if (!FAR) {
            const LAS float* bp = bth + dist0[g];
#pragma unroll
            for (int kt = 0; kt < 4; ++kt)
#pragma unroll
                for (int r = 0; r < 4; ++r) s[g][kt][r] += bp[-(16 * kt + r)];
        } else {
#pragma unroll
            for (int kt = 0; kt < 4; ++kt) s[g][kt] = s[g][kt] + biasfar;
        }
        if (KIND == 1 || KIND == 4) {
#pragma unroll
            for (int kt = 0; kt < 4; ++kt)
#pragma unroll
                for (int r = 0; r < 4; ++r) s[g][kt][r] = (dist0[g] - 16 * kt - r >= 0) ? s[g][kt][r] : -1e30f;
        } else if (KIND == 3) {
#pragma unroll
            for (int kt = 0; kt < 4; ++kt)
#pragma unroll
                for (int r = 0; r < 4; ++r) s[g][kt][r] = (dist0[g] - 16 * kt - r < 512) ? s[g][kt][r] : -1e30f;
        }
        const float t0 = max3f(s[g][0][0], s[g][0][1], s[g][0][2]), t1 = max3f(s[g][0][3], s[g][1][0], s[g][1][1]), t2 = max3f(s[g][1][2], s[g][1][3], s[g][2][0]);
        const float t3 = max3f(s[g][2][1], s[g][2][2], s[g][2][3]), t4 = max3f(s[g][3][0], s[g][3][1], s[g][3][2]);
        float b = max3f(max3f(t0, t1, t2), max3f(t3, t4, s[g][3][3]), -1e30f);
        if (KIND < 2) b = colsel[g] ? b : -1e30f;
        bm[g] = b;
    }
#pragma unroll
    for (int g = 0; g < 2; ++g) bm[g] = rows_max(bm[g]);
#pragma unroll
    for (int g = 0; g < 2; ++g) {
        const float mn = max3f(st[g].m, bm[g], -1e20f);
        const float alpha = __builtin_amdgcn_exp2f((st[g].m - mn) * LOG2E);
        st[g].m = mn;
        float nm = -mn * LOG2E;
        if (KIND < 2) nm = colsel[g] ? nm : -1e30f;
#pragma unroll
        for (int kt = 0; kt < 4; ++kt) {
            const f32x4 e = s[g][kt] * LOG2E + nm;
#pragma unroll
            for (int r = 0; r < 4; ++r) s[g][kt][r] = __builtin_amdgcn_exp2f(e[r]);
        }
        Pf[g][0] = pack8(s[g][0], s[g][1]); Pf[g][1] = pack8(s[g][2], s[g][3]);
        lacc[g] = lacc[g] * alpha;
#pragma unroll
        for (int dt = 0; dt < 4; ++dt) st[g].o[dt] = st[g].o[dt] * alpha;
    }
}
DI void attn_prompt_item(CArgs& A, int b, int kvh, int qt, LAS unsigned char* lds, int tid_in, int wave, int lane_in) {
    unsigned char* ws = A.ws;
    const int lane = lane_id(), tid = wave * 64 + lane; (void)lane_in; (void)tid_in;
    const int fr = lane & 15, fq = lane >> 4, qa = fr >> 2, hh = fr & 3, hg = 4 * kvh + hh;
    LAS float* BT4 = (LAS float*)lds;
    LAS float* scoreL = (LAS float*)(lds + AP_SCORE + wave * 1024);
    LAS unsigned long long* maskL = (LAS unsigned long long*)(lds + AT_MASK);
    LAS int* listL = (LAS int*)(lds + AT_LIST);
    const bf16_t* CK = (const bf16_t*)(ws + WS_CKP) + (size_t)(b * 4 + kvh) * 256 * 64;
    const bf16_t* CV = (const bf16_t*)(ws + WS_CVP) + (size_t)(b * 4 + kvh) * 64 * 256;
    const bf16_t* KS = (const bf16_t*)(ws + WS_KSELP) + (size_t)(b * 4 + kvh) * 64 * 4096;
    const bf16_t* VS = (const bf16_t*)(ws + WS_VSELP) + (size_t)(b * 4 + kvh) * 64 * 4096;
    const bf16_t* KW = (const bf16_t*)(ws + WS_KWINP) + (size_t)(b * 4 + kvh) * 64 * 4096;
    const bf16_t* VW = (const bf16_t*)(ws + WS_VWINP) + (size_t)(b * 4 + kvh) * 64 * 4096;
    const bf16_t* QB = (const bf16_t*)(ws + WS_QB);
    bf16x8 Qf[2][2]; float g_cmpv[2], g_sel[2], g_win[2]; int qposg[2];
#pragma unroll
    for (int g = 0; g < 2; ++g) {
        const int qpos = 64 * qt + 8 * wave + 4 * g + qa, tok = b * 4096 + qpos;
        qposg[g] = qpos;
        Qf[g][0] = *(const bf16x8*)(QB + (size_t)tok * 1024 + hg * 64 + 8 * fq);
        Qf[g][1] = *(const bf16x8*)(QB + (size_t)tok * 1024 + hg * 64 + 32 + 8 * fq);
        const float* gp = (const float*)(ws + WS_GATES) + (size_t)tok * 48 + hg * 3;
        g_cmpv[g] = gp[0]; g_sel[g] = gp[1]; g_win[g] = gp[2];
    }
    {
        const float* btg = (const float*)(ws + WS_BT) + (size_t)(4 * kvh) * BT_STRIDE;
        for (int i = tid; i < 4 * BT_STRIDE; i += NTHR) BT4[i] = btg[i];
        const int ncv_t = 4 * qt + 3, ntl = (((ncv_t + 15) >> 4) + 1) & ~1;
        for (int c = tid; c < ntl * 128; c += NTHR) {
            const int r = c >> 3, c8 = c & 7;
            *(LAS u32x4*)(lds + AT_CMPK + r * 128 + ((c8 ^ (r & 7)) << 4)) = *(const u32x4*)(CK + (size_t)r * 64 + c8 * 8);
            const int d = c / (2 * ntl), cc = c - d * (2 * ntl);
            *(LAS u32x4*)(lds + AT_CMPV + d * 512 + ((cc ^ (d & 7)) << 4)) = *(const u32x4*)(CV + (size_t)d * 256 + cc * 8);
        }
    }
    __syncthreads();
    const LAS float* bth = BT4 + hh * BT_STRIDE + BT_OFF;
    const float biasfar = bth[1024];
    f32x4 OUT[2][4]; unsigned long long mymask[2], gmask[2];
    const int srow = tid >> 3, schunk = tid & 7;
    const int gch = (srow << 3) + (schunk ^ (srow & 7));
    { LAS unsigned char* bb0 = lds + AT_RING + wave * 1024;
      __builtin_amdgcn_global_load_lds((const unsigned*)(KS + gch * 8), (LAS unsigned*)bb0, 16, 0, 0);
      __builtin_amdgcn_global_load_lds((const unsigned*)(VS + gch * 8), (LAS unsigned*)(bb0 + 8192), 16, 0, 0); }
#pragma unroll
    for (int g = 0; g < 2; ++g) {
        const int qpos0 = 64 * qt + 8 * wave + 4 * g, qpos = qposg[g];
        const float g_cmp = g_cmpv[g];
        unsigned long long msel[4];
        cmp_branch<true>(CK, CV, lds + AT_CMPK, lds + AT_CMPV, 512, 256, 64, Qf[g], qpos, qpos0, g_cmp, bth, scoreL, lane, OUT[g], msel);
        mymask[g] = qa == 0 ? msel[0] : qa == 1 ? msel[1] : qa == 2 ? msel[2] : msel[3];
        gmask[g] = msel[0] | msel[1] | msel[2] | msel[3];
    }
    if (lane == 0) maskL[wave] = gmask[0] | gmask[1];
    __syncthreads();
    unsigned long long U = 0ull;
#pragma unroll
    for (int w2 = 0; w2 < 8; ++w2) U |= maskL[w2];
    const int nsel = __builtin_popcountll(U);
    const int wlo = qt >= 8 ? qt - 8 : 0, nwin = qt - wlo + 1, nst = ((A.dup_mask >> 29) & 1u) ? 2 : nsel + nwin;
    {
        if ((U >> lane) & 1ull) listL[__builtin_popcountll(U & ((1ull << lane) - 1ull))] = lane;
        if (lane < nwin) listL[nsel + lane] = 64 + wlo + lane;
    }
    LDS_WAIT();
#define LIST_E(si_) __builtin_amdgcn_readfirstlane(listL[si_])
#define RING_DMA(si_, slot_) do { const int e_ = LIST_E(si_); const bf16_t* kb_ = ((e_ >= 64) ? KW : KS) + (size_t)(e_ & 63) * 4096; const bf16_t* vb_ = ((e_ >= 64) ? VW : VS) + (size_t)(e_ & 63) * 4096; \
        LAS unsigned char* bb_ = lds + AT_RING + (slot_) * 16384 + wave * 1024; \
        __builtin_amdgcn_global_load_lds((const unsigned*)(kb_ + gch * 8), (LAS unsigned*)bb_, 16, 0, 0); \
        __builtin_amdgcn_global_load_lds((const unsigned*)(vb_ + gch * 8), (LAS unsigned*)(bb_ + 8192), 16, 0, 0); } while (0)
    asm volatile("s_waitcnt vmcnt(0)" ::: "memory");
    RING_DMA(1, 1);
    AttnState st[2]; f32x4 lacc[2];
    bf16x8 ONESf;
#pragma unroll
    for (int jj = 0; jj < 8; ++jj) ONESf[jj] = (fr == 0) ? (short)0x3F80 : (short)0;
#pragma unroll
    for (int g = 0; g < 2; ++g) { st[g].m = -1e30f; st[g].l = 0.f; lacc[g] = (f32x4){0.f, 0.f, 0.f, 0.f};
#pragma unroll
        for (int dt = 0; dt < 4; ++dt) st[g].o[dt] = (f32x4){0.f, 0.f, 0.f, 0.f}; }
    int slot = 0;
#pragma unroll 1
    for (int si = 0; si < nst; ++si) {
        if (si + 1 < nst) asm volatile("s_waitcnt vmcnt(2)" ::: "memory"); else asm volatile("s_waitcnt vmcnt(0)" ::: "memory");
        asm volatile("s_waitcnt lgkmcnt(0)" ::: "memory"); __builtin_amdgcn_s_barrier(); asm volatile("" ::: "memory");
        if (si + 2 < nst) { const int ns = slot == 0 ? 2 : slot - 1; RING_DMA(si + 2, ns); }
        if (si == nsel) {
#pragma unroll
            for (int g = 0; g < 2; ++g) {
                const float l = __shfl(lacc[g][0], fr);
                const float sc = g_sel[g] / fmaxf(l, 1e-30f);
#pragma unroll
                for (int dt = 0; dt < 4; ++dt) { OUT[g][dt] += st[g].o[dt] * sc; st[g].o[dt] = (f32x4){0.f, 0.f, 0.f, 0.f}; }
                st[g].m = -1e30f; lacc[g] = (f32x4){0.f, 0.f, 0.f, 0.f};
            }
        }
        const int e = listL[si]; const int blk = e & 63; const bool win = e >= 64;
        const bool a0 = win || ((gmask[0] >> blk) & 1ull), a1 = win || ((gmask[1] >> blk) & 1ull);
        if (a0 || a1) {
            const LAS unsigned char* kb = lds + AT_RING + slot * 16384; const LAS unsigned char* vb = kb + 8192;
            bf16x8 Kf[4][2];
#pragma unroll
            for (int t = 0; t < 4; ++t)
#pragma unroll
                for (int k2 = 0; k2 < 2; ++k2) { const int row = 16 * t + fr; Kf[t][k2] = *(const LAS bf16x8*)(kb + row * 128 + (((fq + 4 * k2) ^ (row & 7)) << 4)); }
            const int kind = win ? (blk == qt ? 4 : (blk == qt - 8 ? 3 : 2)) : (blk == qt ? 1 : 0);
            const bool far = !win && (qt - blk >= 17);
            bf16x8 Pf[2][2];
            const int dist0[2] = {qposg[0] - 64 * blk - 4 * fq, qposg[1] - 64 * blk - 4 * fq};
            const bool colsel[2] = {((mymask[0] >> blk) & 1ull) != 0ull, ((mymask[1] >> blk) & 1ull) != 0ull};
            if (win) {
                if (kind == 4) ring_pair_qk<4, false>(Kf, Qf, dist0, colsel, biasfar, bth, st, lacc, Pf);
                else if (kind == 3) ring_pair_qk<3, false>(Kf, Qf, dist0, colsel, biasfar, bth, st, lacc, Pf);
                else ring_pair_qk<2, false>(Kf, Qf, dist0, colsel, biasfar, bth, st, lacc, Pf);
            } else {
                if (kind == 1) ring_pair_qk<1, false>(Kf, Qf, dist0, colsel, biasfar, bth, st, lacc, Pf);
                else if (far) ring_pair_qk<0, true>(Kf, Qf, dist0, colsel, biasfar, bth, st, lacc, Pf);
                else ring_pair_qk<0, false>(Kf, Qf, dist0, colsel, biasfar, bth, st, lacc, Pf);
            }
#pragma unroll
            for (int dt = 0; dt < 4; ++dt) {
                const int row = 16 * dt + fr;
                const bf16x8 v0 = *(const LAS bf16x8*)(vb + row * 128 + ((fq ^ (row & 7)) << 4)), v1 = *(const LAS bf16x8*)(vb + row * 128 + (((fq + 4) ^ (row & 7)) << 4));
                { f32x4 c = st[0].o[dt]; c = MFMA16(v0, Pf[0][0], c); c = MFMA16(v1, Pf[0][1], c); st[0].o[dt] = c; }
                { f32x4 c = st[1].o[dt]; c = MFMA16(v0, Pf[1][0], c); c = MFMA16(v1, Pf[1][1], c); st[1].o[dt] = c; }
            }
#pragma unroll
            for (int g = 0; g < 2; ++g) { f32x4 c = lacc[g]; c = MFMA16(ONESf, Pf[g][0], c); c = MFMA16(ONESf, Pf[g][1], c); lacc[g] = c; }
        }
        slot = slot == 2 ? 0 : slot + 1;
    }
#pragma unroll
    for (int g = 0; g < 2; ++g) {
        const float l = __shfl(lacc[g][0], fr);
        const float sc = g_win[g] / fmaxf(l, 1e-30f);
        bf16_t* op = (bf16_t*)(ws + WS_OB) + (size_t)(b * 4096 + qposg[g]) * 1024 + hg * 64 + 4 * fq;
#pragma unroll
        for (int dt = 0; dt < 4; ++dt) { const f32x4 o = OUT[g][dt] + st[g].o[dt] * sc; u32x2 w; w.x = pk2(o.x, o.y); w.y = pk2(o.z, o.w); *(u32x2*)(op + 16 * dt) = w; }
    }
    __syncthreads();
#undef LIST_E
#undef RING_DMA
}
DI void phase_attn(CArgs& A, LAS unsigned char* lds, int tid, int wave, int lane) {
    unsigned char* ws = A.ws;
    if (!(A.dup_mask >> 31))
    for (int t = blockIdx.x; t < 1024; t += gridDim.x) {
        const int i = t & 255, r = t >> 8, bk = i & 15, j = i >> 4;
        const int qt = r == 0 ? 63 - j : r == 1 ? 47 - j : r == 2 ? 16 + j : j;
        attn_prompt_item(A, bk >> 2, bk & 3, qt, lds, tid, wave, lane);
    }
    if (!((A.dup_mask >> 30) & 1u))
    for (int it = blockIdx.x; it < 512; it += gridDim.x) attn_sample_item(A, it, lds, wave);
}
DI void phase_final(CArgs& A, int wave, int lane) {
    unsigned char* ws = A.ws;
    const int gw = blockIdx.x * NWAVES + wave, NGW = gridDim.x * NWAVES;
    const float* nw = IN_F(I_NFIN);
    f32x4 w4[4];
#pragma unroll
    for (int j = 0; j < 4; ++j) w4[j] = *((const f32x4*)nw + lane + 64 * j);
    for (int m = gw; m < TT; m += NGW) {
        const u32x2* xr = (const u32x2*)((const bf16_t*)(ws + WS_XB) + (size_t)m * D) + lane; f32x4 v[4]; float s = 0.f;
#pragma unroll
        for (int j = 0; j < 4; ++j) { const u32x2 b2 = xr[64 * j]; v[j] = (f32x4){bflo(b2.x), bfhi(b2.x), bflo(b2.y), bfhi(b2.y)}; s += (v[j].x * v[j].x + v[j].y * v[j].y) + (v[j].z * v[j].z + v[j].w * v[j].w); }
        s = wave_sum(s);
        const float rs = rsqrtf(s * (1.0f / 1024.0f) + EPS);
        f32x4* o = (f32x4*)(A.out + O_Y + (size_t)m * D) + lane;
#pragma unroll
        for (int j = 0; j < 4; ++j) o[64 * j] = v[j] * rs * w4[j];
    }
}
DI void sample_gemm_res(const bf16_t* Aop, const bf16_t* Bt, int K, const float* xs, const bf16_t* XBr, float* Xw_unused, bf16_t* XB, float* stats, int first, LAS unsigned char* lds, int wave) {
    const int lane = lane_id(), fr = lane & 15, fq = lane >> 4;
    LAS f32x4* part = (LAS f32x4*)lds;
    LAS float* red = (LAS float*)(lds + 65536);
    const int kw = K >> 3, nks = kw >> 5;
    for (int t = blockIdx.x; t < 256; t += gridDim.x) {
        const int rt = t >> 4, ct = t & 15;
        const bf16_t* ap = Aop + (size_t)(TP + 32 * rt + fr) * K + wave * kw + 8 * fq;
        const bf16_t* bp = Bt + (size_t)(64 * ct + fr) * K + wave * kw + 8 * fq;
        f32x4 acc[2][4];
#pragma unroll
        for (int m = 0; m < 2; ++m)
#pragma unroll
            for (int n = 0; n < 4; ++n) acc[m][n] = (f32x4){0.f, 0.f, 0.f, 0.f};
        const int mr_ = wave >> 2, nc_ = wave & 3, rowb = TP + 32 * rt + 16 * mr_ + fr, colb = 64 * ct + 16 * nc_ + 4 * fq;
        f32x4 base;
        if (first) base = *(const f32x4*)(xs + (size_t)(rowb - TP) * D + colb);
        else { const u32x2 b2 = *(const u32x2*)(XBr + (size_t)rowb * D + colb); base = (f32x4){bflo(b2.x), bfhi(b2.x), bflo(b2.y), bfhi(b2.y)}; }
#pragma unroll 1
        for (int k0 = 0; k0 < nks; k0 += 4) {
            bf16x8 a[4][2], b[4][4];
#pragma unroll
            for (int j = 0; j < 4; ++j) {
                const int kk = (k0 + j < nks ? k0 + j : nks - 1) * 32;
#pragma unroll
                for (int m = 0; m < 2; ++m) a[j][m] = *(const bf16x8*)(ap + (size_t)(16 * m) * K + kk);
#pragma unroll
                for (int n = 0; n < 4; ++n) b[j][n] = *(const bf16x8*)(bp + (size_t)(16 * n) * K + kk);
            }
#pragma unroll
            for (int j = 0; j < 4; ++j) {
                if (k0 + j < nks) {
#pragma unroll
                    for (int m = 0; m < 2; ++m)
#pragma unroll
                        for (int n = 0; n < 4; ++n) acc[m][n] = MFMA16(b[j][n], a[j][m], acc[m][n]);
                }
            }
        }
#pragma unroll
        for (int m = 0; m < 2; ++m)
#pragma unroll
            for (int n = 0; n < 4; ++n) part[(wave * 8 + m * 4 + n) * 64 + lane] = acc[m][n];
        __syncthreads();
        const int mr = wave >> 2, nc = wave & 3;
        f32x4 sum = part[(0 * 8 + wave) * 64 + lane];
#pragma unroll
        for (int w2 = 1; w2 < 8; ++w2) sum += part[(w2 * 8 + wave) * 64 + lane];
        const int row = TP + 32 * rt + 16 * mr + fr, col = 64 * ct + 16 * nc + 4 * fq;
        const f32x4 o = base + sum;
        u32x2 w; w.x = pk2(o.x, o.y); w.y = pk2(o.z, o.w);
        *(u32x2*)(XB + (size_t)row * D + col) = w;
        float ss = (o.x * o.x + o.y * o.y) + (o.z * o.z + o.w * o.w);
        ss = rows_sum(ss);
        if (fq == 0) red[wave * 16 + fr] = ss;
        __syncthreads();
        if (nc == 0 && fq == 0) stats[(size_t)row * 16 + ct] = (red[(4 * mr + 0) * 16 + fr] + red[(4 * mr + 1) * 16 + fr]) + (red[(4 * mr + 2) * 16 + fr] + red[(4 * mr + 3) * 16 + fr]);
        __syncthreads();
    }
}
constexpr int NPH = 30;
__global__ void __launch_bounds__(NTHR, 2) mk_fwd(Args A_) {
    CArgs& A = *(CArgs*)__builtin_amdgcn_kernarg_segment_ptr();
    extern __shared__ __attribute__((aligned(16))) unsigned char lds_raw[];
    LAS unsigned char* lds = (LAS unsigned char*)lds_raw;
    const int wave0 = __builtin_amdgcn_readfirstlane((int)threadIdx.x >> 6);
    const int lane = lane_id(), wave = wave0, tid = wave0 * 64 + lane;
    unsigned char* ws = A.ws;
    volatile LAS unsigned* bw = (volatile LAS unsigned*)(lds + LDS_BARW);
    if (tid == 0) { bw[0] = 0u; bw[1] = 0u; bw[2] = 0u; bw[3] = 0u; }
    __syncthreads();
#if MK_PER_PHASE
    XcdBarrier bar; bar.w0 = 0; bar.bar = (unsigned*)(ws + WS_CTL); bar.x = 0; bar.st = bw;
#else
    XcdBarrier bar = xcd_barrier_post((unsigned*)(ws + WS_CTL), bw, (unsigned)wave0);
#endif
    const int lo = A.ph_lo, hi = A.ph_hi;
#define RUN(k) (lo <= (k) && (k) < hi)
#define REP(k) _Pragma("unroll 1") for (int rep_ = 0, nrep_ = 1 + (int)((A.dup_mask >> (k)) & 1u); rep_ < nrep_; ++rep_, __syncthreads()) { int tidr_ = wave0 * 64 + lane_id(); asm volatile("" : "+v"(tidr_)); const int tid = tidr_, lane = tid & 63, wave = wave0; (void)tid; (void)lane; (void)wave;
#define REPE }
#define FRESH { int tidr_ = wave0 * 64 + lane_id(); asm volatile("" : "+v"(tidr_)); const int tid = tidr_, lane = tid & 63, wave = wave0; (void)tid; (void)lane; (void)wave;
#define FRESHE }
#if MK_PER_PHASE
#define SEAM(k) do { } while (0)
#else
#define SEAM(k) do { if ((k) + 1 < hi) xcd_barrier(bar); } while (0)
#endif

    if (RUN(0)) { REP(0) phase_p0(A, lds, tid, wave, lane); REPE SEAM(0); }
#pragma unroll 1
    for (int l = 0; l < 4; ++l) {
        unsigned char* ws = A.ws; asm volatile("" : "+s"(ws));
        float* stats = (float*)(ws + WS_STATS); bf16_t* XB = (bf16_t*)(ws + WS_XB); bf16_t* OB = (bf16_t*)(ws + WS_OB); float* X = (float*)(ws + WS_X);
        int bx = blockIdx.x; asm volatile("" : "+s"(bx));
        const int pb = l < 2 ? 1 + 8 * l : 19 + 5 * (l - 2);
        if (l < 2) {
            if (RUN(pb)) {
                pg8::Gemm g{XB, (const bf16_t*)(ws + WS_WDNIN + l * SZ_WDNIN), TT, N_DNIN, D};
                pg8::StaticOrder S; S.init(TT, N_DNIN, gridDim.x, bx);
                EpiDnIn E{stats, (bf16_t*)(ws + WS_QKVB), (bf16_t*)(ws + WS_ZB), (float*)(ws + WS_AB)};
                REP(pb) pg8::gemm_phase<EpiDnIn, pg8::StaticOrder>(lds, g, S, E, nullptr, wave); REPE
                SEAM(pb);
            }
            if (RUN(pb + 1)) { REP(pb + 1) phase_d2(A, l, wave, lane); REPE SEAM(pb + 1); }
            if (RUN(pb + 2)) { REP(pb + 2) phase_d3(A, lds, wave, lane); REPE SEAM(pb + 2); }
            if (RUN(pb + 3)) { REP(pb + 3) phase_d4(A, l, lds, tid, wave, lane); REPE SEAM(pb + 3); }
            if (RUN(pb + 4)) { FRESH phase_d5(A, l, wave, lane); FRESHE SEAM(pb + 4); }
        } else {
            if (RUN(pb)) {
                pg8::Gemm g{XB, (const bf16_t*)(ws + WS_WNSAIN + (l - 2) * SZ_WNSAIN), TT, N_NSAIN, D};
                pg8::StaticOrder S; S.init(TT, N_NSAIN, gridDim.x, bx);
                const int early = gridDim.x == 256 ? NSA2_EARLY : 0;
                if (l == 2) S.slice(early, S.nwg);
                EpiNsaIn E{stats, (bf16_t*)(ws + WS_QB), (float*)(ws + WS_GATES)};
                REP(pb) pg8::gemm_phase<EpiNsaIn, pg8::StaticOrder>(lds, g, S, E, nullptr, wave); REPE
                if (l == 2) { __syncthreads(); const int nb1 = (330 - early) < (int)gridDim.x ? 330 - early : 330 % (int)gridDim.x; phase_n1(A, lds, wave0 * 64 + lane_id(), bx >= nb1 ? bx - nb1 : -1, (int)gridDim.x - nb1); }
                SEAM(pb);
            }
            if (RUN(pb + 1)) { REP(pb + 1) phase_attn(A, lds, tid, wave, lane); REPE SEAM(pb + 1); }
        }
        const int pm = l < 2 ? pb + 5 : pb + 2;
        if (RUN(pm)) {
            const bf16_t* wt = (const bf16_t*)(ws + (l < 2 ? WS_WDNOUT + l * SZ_WSQ : WS_WNSAOUT + (l - 2) * SZ_WSQ));
            pg8::Gemm g{OB, wt, TP, D, D};
            pg8::StaticOrder S; S.init(TP, D, gridDim.x, bx);
#if MK_PROBE & 1
            { EpiRes Ed{IN_F(I_XP), IN_F(I_XS), X, XB, stats, l == 0 ? 1 : 0, (float*)(ws + WS_QKVB), (bf16_t*)(ws + WS_QN), (float*)(ws + WS_GATES)};
              pg8::gemm_phase<EpiRes, pg8::StaticOrder>(lds, g, S, Ed, nullptr, wave0);
              sample_gemm_res(OB, wt, D, IN_F(I_XS), XB, (float*)(ws + WS_QKVB), (bf16_t*)(ws + WS_QN), (float*)(ws + WS_GATES), l == 0 ? 1 : 0, lds, wave0); __syncthreads(); }
#endif
            EpiRes E{IN_F(I_XP), IN_F(I_XS), X, XB, stats, l == 0 ? 1 : 0, X, XB, stats};
            pg8::gemm_phase<EpiRes, pg8::StaticOrder>(lds, g, S, E, nullptr, wave0);
            sample_gemm_res(OB, wt, D, IN_F(I_XS), XB, X, XB, stats, l == 0 ? 1 : 0, lds, wave0);
            SEAM(pm);
        }
        if (RUN(pm + 1)) {
            pg8::Gemm g{XB, (const bf16_t*)(ws + WS_WFFNIN + l * SZ_WFFNIN), TT, 2 * DFF, D};
            pg8::StaticOrder S; S.init(TT, 2 * DFF, gridDim.x, bx);
            EpiFfnIn E{stats, (bf16_t*)(ws + WS_ACT)};
            REP(pm + 1) pg8::gemm_phase<EpiFfnIn, pg8::StaticOrder>(lds, g, S, E, nullptr, wave); REPE
            SEAM(pm + 1);
        }
        if (RUN(pm + 2)) {
            const bf16_t* wt = (const bf16_t*)(ws + WS_WFFNOUT + l * SZ_WFFNOUT);
            pg8::Gemm g{(const bf16_t*)(ws + WS_ACT), wt, TP, D, DFF};
            pg8::StaticOrder S; S.init(TP, D, gridDim.x, bx);
#if MK_PROBE & 1
            { EpiRes Ed{IN_F(I_XP), IN_F(I_XS), X, XB, stats, 0, (float*)(ws + WS_QKVB), (bf16_t*)(ws + WS_QN), (float*)(ws + WS_GATES)};
              pg8::gemm_phase<EpiRes, pg8::StaticOrder>(lds, g, S, Ed, nullptr, wave0);
              sample_gemm_res((const bf16_t*)(ws + WS_ACT), wt, DFF, IN_F(I_XS), XB, (float*)(ws + WS_QKVB), (bf16_t*)(ws + WS_QN), (float*)(ws + WS_GATES), 0, lds, wave0); __syncthreads(); }
#endif
            EpiRes E{IN_F(I_XP), IN_F(I_XS), X, XB, stats, 0, X, XB, stats};
            pg8::gemm_phase<EpiRes, pg8::StaticOrder>(lds, g, S, E, nullptr, wave0);
            sample_gemm_res((const bf16_t*)(ws + WS_ACT), wt, DFF, IN_F(I_XS), XB, X, XB, stats, 0, lds, wave0);
            SEAM(pm + 2);
        }
        if (l == 1) {
            if (RUN(17)) {
                pg8::Gemm g{XB, (const bf16_t*)(ws + WS_WKV), TT, N_KV, D};
                pg8::StaticOrder S; S.init(TT, N_KV, gridDim.x, bx);
                EpiKV E{stats, A.out, ws};
                REP(17) pg8::gemm_phase<EpiKV, pg8::StaticOrder>(lds, g, S, E, nullptr, wave);
                    if (gridDim.x == 256 && bx >= 256 - NSA2_EARLY) {
                        pg8::Gemm g2{XB, (const bf16_t*)(ws + WS_WNSAIN), TT, N_NSAIN, D};
                        pg8::StaticOrder S2; S2.init(TT, N_NSAIN, NSA2_EARLY, bx - (256 - NSA2_EARLY)); S2.slice(0, NSA2_EARLY);
                        EpiNsaIn E2{stats, (bf16_t*)(ws + WS_QB), (float*)(ws + WS_GATES)};
                        __syncthreads();
                        pg8::gemm_phase<EpiNsaIn, pg8::StaticOrder>(lds, g2, S2, E2, nullptr, wave);
                    }
                REPE
                SEAM(17);
            }
        }
    }
    if (RUN(29)) {
        int tid_f = wave0 * 64 + lane_id(); asm volatile("" : "+v"(tid_f));
        phase_final(A, __builtin_amdgcn_readfirstlane(tid_f >> 6), tid_f & 63);
#if MK_PROBE & 4
        asm volatile("" ::: "memory"); phase_final(A, __builtin_amdgcn_readfirstlane(tid_f >> 6), tid_f & 63);
#endif
    }
#undef RUN
#undef REP
#undef REPE
#undef FRESH
#undef FRESHE
#undef SEAM
}

extern "C" void kernel_launch(void* const* d_in, const int* in_sizes, int n_in, void* d_out, int out_size, void* d_ws, size_t ws_size, hipStream_t stream) {
    static int grid = 0;
    if (grid == 0) {
        if (n_in != 25 || ws_size < WS_END) { fprintf(stderr, "kernel_launch: expected 25 inputs and >= %zu bytes of workspace (got %d, %zu)\n", (size_t)WS_END, n_in, ws_size); grid = -1; return; }
        int dev = 0, cus = 0, per_cu = 0;
        if (hipGetDevice(&dev) != hipSuccess || hipDeviceGetAttribute(&cus, hipDeviceAttributeMultiprocessorCount, dev) != hipSuccess) { grid = -1; return; }
        if (hipFuncSetAttribute((const void*)mk_fwd, hipFuncAttributeMaxDynamicSharedMemorySize, LDS_BYTES) != hipSuccess) { fprintf(stderr, "kernel_launch: hipFuncSetAttribute failed\n"); grid = -1; return; }
        if (hipOccupancyMaxActiveBlocksPerMultiprocessor(&per_cu, (const void*)mk_fwd, NTHR, LDS_BYTES) != hipSuccess || per_cu < 1)
            fprintf(stderr, "kernel_launch: occupancy query reports %d workgroups per CU\n", per_cu);
        (void)hipGetLastError();
        grid = cus > 0 ? cus : 256;
    }
    if (grid < 0) return;
    if (hipMemsetAsync((char*)d_ws + WS_CTL, 0, 65536, stream) != hipSuccess) { fprintf(stderr, "kernel_launch: memset failed\n"); return; }
    Args a{};
    for (int i = 0; i < 25; ++i) a.in[i] = d_in[i];
    a.out = (float*)d_out; a.ws = (unsigned char*)d_ws; a.dup_mask = MK_DUP_MASK; a.pad = 0u;
#if MK_PER_PHASE
    for (int k = 0; k < NPH; ++k) { a.ph_lo = k; a.ph_hi = k + 1; hipLaunchKernelGGL(mk_fwd, dim3(grid), dim3(NTHR), LDS_BYTES, stream, a); }
#else
    a.ph_lo = 0; a.ph_hi = NPH;
    hipLaunchKernelGGL(mk_fwd, dim3(grid), dim3(NTHR), LDS_BYTES, stream, a);
#if MK_XTRA_PH >= 0
    a.ph_lo = MK_XTRA_PH; a.ph_hi = MK_XTRA_PH + 1; a.dup_mask = MK_XTRA_MASK;
    hipLaunchKernelGGL(mk_fwd, dim3(grid), dim3(NTHR), LDS_BYTES, stream, a);
#endif
#endif
    const hipError_t le = hipPeekAtLastError();
    if (le != hipSuccess) fprintf(stderr, "kernel_launch: launch failed: %s\n", hipGetErrorName(le));
}
```

```cpp
#include <hip/hip_runtime.h>
#include <cstdio>
#include <cstdint>

#ifndef MK_DUP_MASK
#define MK_DUP_MASK 0u
#endif
#ifndef MK_PROBE
#define MK_PROBE 0
#endif
#ifndef MK_XTRA_PH
#define MK_XTRA_PH (-1)
#define MK_XTRA_MASK 0u
#endif
#ifndef MK_PER_PHASE
#define MK_PER_PHASE 0
#endif

#define DI __device__ __forceinline__
#define LAS __attribute__((address_space(3)))
typedef unsigned short bf16_t;
typedef short bf16x8 __attribute__((ext_vector_type(8)));
typedef float f32x4 __attribute__((ext_vector_type(4)));
typedef float f32x2 __attribute__((ext_vector_type(2)));
typedef unsigned u32x4 __attribute__((ext_vector_type(4)));
typedef unsigned u32x2 __attribute__((ext_vector_type(2)));
typedef __bf16 bf16v2 __attribute__((ext_vector_type(2)));

constexpr int D = 1024, TP = 16384, TS = 512, TT = TP + TS, SEQ = 4096, DFF = 2816;
constexpr int N_DNIN = 4352, N_DNIN_REAL = 4112, N_NSAIN = 1280, N_NSAIN_REAL = 1072, N_KV = 1536;
constexpr int NWAVES = 8, NTHR = 512;
constexpr float EPS = 1e-6f;
constexpr size_t O_Y = 0, O_PS = 17301504, O_PC = 18350080, O_PKV = 18423808, O_PW = 35201024, O_SS = 36249600, O_SC = 69804032, O_SKV = 72163328, O_SW = 72687616;
constexpr size_t al256(size_t x) { return (x + 255) & ~(size_t)255; }
constexpr size_t WS_CTL = 0, CTL_BYTES = 1u << 20;
constexpr size_t SZ_WDNIN = (size_t)N_DNIN * D * 2, SZ_WSQ = (size_t)D * D * 2, SZ_WFFNIN = (size_t)2 * DFF * D * 2, SZ_WFFNOUT = (size_t)D * DFF * 2, SZ_WKV = (size_t)N_KV * D * 2, SZ_WNSAIN = (size_t)N_NSAIN * D * 2;
constexpr size_t WS_WDNIN = CTL_BYTES;
constexpr size_t WS_WDNOUT = WS_WDNIN + 2 * SZ_WDNIN;
constexpr size_t WS_WFFNIN = WS_WDNOUT + 2 * SZ_WSQ;
constexpr size_t WS_WFFNOUT = WS_WFFNIN + 4 * SZ_WFFNIN;
constexpr size_t WS_WKV = WS_WFFNOUT + 4 * SZ_WFFNOUT;
constexpr size_t WS_WNSAIN = WS_WKV + SZ_WKV;
constexpr size_t WS_WNSAOUT = WS_WNSAIN + 2 * SZ_WNSAIN;
constexpr size_t WS_X = al256(WS_WNSAOUT + 2 * SZ_WSQ);
constexpr size_t WS_XB = WS_X + (size_t)TT * D * 4;
constexpr size_t WS_STATS = WS_XB + (size_t)TT * D * 2;
constexpr size_t WS_QKVB = WS_STATS + (size_t)TT * 16 * 4;
constexpr size_t WS_ZB = WS_QKVB + (size_t)TT * 3072 * 2;
constexpr size_t WS_AB = WS_ZB + (size_t)TT * D * 2;
constexpr size_t WS_QN = WS_AB + (size_t)TT * 16 * 4;
constexpr size_t WS_KN = WS_QN + (size_t)TT * D * 2;
constexpr size_t WS_VB = WS_KN + (size_t)TT * D * 2;
constexpr size_t WS_GG = WS_VB + (size_t)TT * D * 2;
constexpr size_t WS_BETA = WS_GG + (size_t)TT * 8 * 4;
constexpr size_t PK_WKF = 0, PK_QF = 16384, PK_AQK = 32768, PK_KDF = 40960, PK_WVC = 57344, PK_SIZE = 73728;
constexpr size_t WS_PACK = WS_BETA + (size_t)TT * 8 * 4;
constexpr size_t WS_EG = WS_PACK + (size_t)2048 * PK_SIZE;
constexpr size_t WS_GL = WS_EG + (size_t)2048 * 64 * 4;
constexpr size_t WS_OB = al256(WS_GL + 2048 * 4);
constexpr size_t WS_ACT = WS_OB + (size_t)TT * D * 2;
constexpr size_t SZ_KVP = (size_t)4 * 4 * 64 * 4096 * 2;
constexpr size_t WS_KSELP = WS_ACT + (size_t)TT * DFF * 2;
constexpr size_t WS_VSELP = WS_KSELP + SZ_KVP;
constexpr size_t WS_KWINP = WS_VSELP + SZ_KVP;
constexpr size_t WS_VWINP = WS_KWINP + SZ_KVP;
constexpr size_t SZ_KSELS = (size_t)128 * 4 * 33 * 4096 * 2, SZ_KWINS = (size_t)128 * 4 * 9 * 4096 * 2;
constexpr size_t WS_KSELS = WS_VWINP + SZ_KVP;
constexpr size_t WS_VSELS = WS_KSELS + SZ_KSELS;
constexpr size_t WS_KWINS = WS_VSELS + SZ_KSELS;
constexpr size_t WS_VWINS = WS_KWINS + SZ_KWINS;
constexpr size_t WS_CKP = WS_VWINS + SZ_KWINS;
constexpr size_t WS_CVP = WS_CKP + (size_t)16 * 256 * 64 * 2;
constexpr size_t WS_CKS = WS_CVP + (size_t)16 * 256 * 64 * 2;
constexpr size_t WS_CVS = WS_CKS + (size_t)512 * 128 * 64 * 2;
constexpr size_t WS_QB = WS_CVS + (size_t)512 * 128 * 64 * 2;
constexpr size_t WS_GATES = WS_QB + (size_t)TT * D * 2;
constexpr int BT_STRIDE = 1224, BT_OFF = 80;
constexpr size_t WS_BT = WS_GATES + (size_t)TT * 48 * 4;
constexpr size_t WS_END = al256(WS_BT + 16 * BT_STRIDE * 4);
constexpr int LDS_MAIN = 131072, LDS_MISC = 131072, LDS_BYTES = 147456;
constexpr int LDS_BARW = LDS_BYTES - 16;

DI int lane_id() { int l; asm volatile("v_mbcnt_lo_u32_b32 %0, -1, 0\n\tv_mbcnt_hi_u32_b32 %0, -1, %0" : "=&v"(l)); return l; }
DI unsigned pk2(float a, float b) { f32x2 v = {a, b}; bf16v2 r = __builtin_convertvector(v, bf16v2); return __builtin_bit_cast(unsigned, r); }
DI float bflo(unsigned u) { return __uint_as_float(u << 16); }
DI float bfhi(unsigned u) { return __uint_as_float(u & 0xffff0000u); }
DI float bf2f(bf16_t b) { return __uint_as_float(((unsigned)b) << 16); }
DI bf16_t f2bf(float f) { return (bf16_t)(pk2(f, 0.f) & 0xffffu); }
template <int CTRL> DI float dpp_f(float x) { return __builtin_bit_cast(float, __builtin_amdgcn_update_dpp(0, __builtin_bit_cast(int, x), CTRL, 0xF, 0xF, true)); }
DI float quad_sum(float x) { x += dpp_f<0xB1>(x); x += dpp_f<0x4E>(x); return x; }
DI float row16_sum(float x) { x = quad_sum(x); x += dpp_f<0x141>(x); x += dpp_f<0x140>(x); return x; }
DI float max3f(float a, float b, float c) { return fmaxf(fmaxf(a, b), c); }
DI float max2f(float a, float b) { return fmaxf(a, b); }
typedef unsigned u32x2s __attribute__((ext_vector_type(2)));
DI float rows_max(float x) {
    u32x2s r = __builtin_amdgcn_permlane16_swap(__float_as_uint(x), __float_as_uint(x), false, false);
    const float y = fmaxf(__uint_as_float(r.x), __uint_as_float(r.y));
    r = __builtin_amdgcn_permlane32_swap(__float_as_uint(y), __float_as_uint(y), false, false);
    return fmaxf(__uint_as_float(r.x), __uint_as_float(r.y));
}
DI float rows_sum(float x) {
    u32x2s r = __builtin_amdgcn_permlane16_swap(__float_as_uint(x), __float_as_uint(x), false, false);
    const float y = __uint_as_float(r.x) + __uint_as_float(r.y);
    r = __builtin_amdgcn_permlane32_swap(__float_as_uint(y), __float_as_uint(y), false, false);
    return __uint_as_float(r.x) + __uint_as_float(r.y);
}
DI float wave_sum(float v) { return rows_sum(row16_sum(v)); }
DI float sigmoidf_(float x) { return __builtin_amdgcn_rcpf(1.0f + __expf(-x)); }
DI float siluf_(float x) { return x * __builtin_amdgcn_rcpf(1.0f + __expf(-x)); }
#define LDS_WAIT() asm volatile("s_waitcnt lgkmcnt(0)" ::: "memory")
#define MFMA16(a, b, c) __builtin_amdgcn_mfma_f32_16x16x32_bf16((a), (b), (c), 0, 0, 0)
DI bf16x8 pack8(const f32x4& a, const f32x4& b) { u32x4 p; p.x = pk2(a.x, a.y); p.y = pk2(a.z, a.w); p.z = pk2(b.x, b.y); p.w = pk2(b.z, b.w); return __builtin_bit_cast(bf16x8, p); }
namespace pg8 {
#define PG8_LAS __attribute__((address_space(3)))
typedef unsigned short bf16_t;
typedef short bf16x8 __attribute__((ext_vector_type(8)));
typedef float f32x4 __attribute__((ext_vector_type(4)));
typedef unsigned u32x4 __attribute__((ext_vector_type(4)));
constexpr int BM = 256, BK = 64, HALF = 128, HTB = HALF * BK * 2  , STAGE_BYTES = 8 * HTB, NXCD = 8, WGM = 8;

__host__ __device__ __forceinline__ int lds_byte(int r, int c) { const int st = (r >> 4) * 2 + (c >> 5), rr = r & 15, cc = c & 31, ob = rr * 64 + cc * 2; return st * 1024 + (ob ^ (((ob >> 9) & 1) << 5)); }
__host__ __device__ __forceinline__ void stage_rc(int b, int& R, int& C) { const int st = b / 1024, sb = b % 1024, swz = sb ^ (((sb >> 9) & 1) << 5); R = (st >> 1) * 16 + swz / 64; C = (st & 1) * 32 + (swz % 64) / 2; }
__host__ __device__ __forceinline__ int perm32(int rho) { const int n = rho >> 4, i = rho & 15; return 8 * (i >> 2) + 4 * n + (i & 3); }

struct Unit { int pm, pn; };
struct Gemm { const bf16_t* A; const bf16_t* Bt; int M, N, K; };

struct StaticOrder {
    int nM, nN, nwg, G, c, lo, hi;
    __host__ __device__ void init(int M, int N, int G_, int c_) { nM = M / BM; nN = N / BM; nwg = nM * nN; G = G_; c = c_; lo = 0; hi = nwg; }
    __host__ __device__ void slice(int lo_, int hi_) { lo = lo_; hi = hi_; }
    __host__ __device__ bool next(int i, Unit& u) const {
        const long L = (long)lo + (long)i * G + c; if (L >= hi) return false;
        int wgid = (int)L; { const int q = nwg / NXCD, r = nwg % NXCD, xcd = wgid % NXCD, off = wgid / NXCD; wgid = (xcd < r ? xcd * (q + 1) : r * (q + 1) + (xcd - r) * q) + off; }
        const int nig = WGM * nN, gid = wgid / nig, fm = gid * WGM, gsz = (nM - fm) < WGM ? (nM - fm) : WGM;
        u.pm = fm + ((wgid % nig) % gsz); u.pn = (wgid % nig) / gsz; return true;
    }
    __device__ __forceinline__ void a_ready(const Unit&) const {}
    __device__ __forceinline__ void done(const Unit&) const {}
};
struct CountedOrder : StaticOrder {
    const unsigned* ready; unsigned need; unsigned* tmo;
    __device__ __forceinline__ void a_ready(const Unit& u) const {
        if (threadIdx.x < 64) {
            const unsigned long long t0 = __builtin_amdgcn_s_memrealtime(); unsigned polls = 0;
            while ((unsigned)__builtin_amdgcn_readfirstlane(__hip_atomic_load(ready + 64 * u.pm, __ATOMIC_RELAXED, __HIP_MEMORY_SCOPE_AGENT)) < need) {
                if ((++polls & 255u) == 0u && __builtin_amdgcn_readfirstlane(__hip_atomic_load(tmo, __ATOMIC_RELAXED, __HIP_MEMORY_SCOPE_AGENT)) != 0u) break;
                if (__builtin_amdgcn_s_memrealtime() - t0 > 2000000ull) {
                    if (threadIdx.x == 0) { unsigned expect = 0u; __hip_atomic_compare_exchange_strong(tmo + 1, &expect, 0x600u | (unsigned)(u.pm & 0xff), __ATOMIC_RELAXED, __ATOMIC_RELAXED, __HIP_MEMORY_SCOPE_AGENT); __hip_atomic_store(tmo, 1u, __ATOMIC_RELAXED, __HIP_MEMORY_SCOPE_AGENT); }
                    break; }
                __builtin_amdgcn_s_sleep(2); }
            __builtin_amdgcn_fence(__ATOMIC_ACQUIRE, "agent");
            asm volatile("s_waitcnt vmcnt(0)" ::: "memory");
        }
#if !defined(BROKEN_HOOK_NO_BARRIER)
        asm volatile("" ::: "memory"); __builtin_amdgcn_s_barrier(); asm volatile("" ::: "memory");
#endif
    }
};

__device__ __forceinline__ unsigned cvt_pk_bf16(float lo, float hi) { unsigned r; asm volatile("v_cvt_pk_bf16_f32 %0, %1, %2" : "=v"(r) : "v"(lo), "v"(hi)); return r; }
typedef float f32x2 __attribute__((ext_vector_type(2)));
__device__ __forceinline__ f32x2 gelu_pk(f32x2 v) {
    const f32x2 av = __builtin_elementwise_abs(v), d = av * 0.2316418882f + 1.0f;
    f32x2 t; t.x = __builtin_amdgcn_rcpf(d.x); t.y = __builtin_amdgcn_rcpf(d.y);
    f32x2 q = t * 0.5307027145f + (-0.7265760135f); q = q * t + 0.7107068705f; q = q * t + (-0.142248368f); q = q * t + 0.127414796f; q = q * t;
    const f32x2 s = (v * v) * (-0.72134752044f);
    f32x2 e; e.x = __builtin_amdgcn_exp2f(s.x); e.y = __builtin_amdgcn_exp2f(s.y);
    const f32x2 m = v * (q * e), r = v - m;
    f32x2 o; o.x = v.x < 0.f ? m.x : r.x; o.y = v.y < 0.f ? m.y : r.y; return o;
}

struct EpiF32 {
    static constexpr bool PERM = false, AFTER_DRAIN = false;
    float* C; int ldc; const float* bias;
    __device__ __forceinline__ void operator()(const f32x4 (&acc)[2][2][4][2], const Unit& u, int wr, int wc, int fr, int fq) const {
        const int row0 = u.pm * BM + wr * 64 + fr, col0 = u.pn * BM + wc * 32 + 4 * fq;
        f32x4 bv[2][2];
#pragma unroll
        for (int bj = 0; bj < 2; ++bj)
#pragma unroll
            for (int n = 0; n < 2; ++n) bv[bj][n] = bias ? *(const f32x4*)(bias + col0 + bj * HALF + n * 16) : (f32x4){0.f, 0.f, 0.f, 0.f};
#pragma unroll
        for (int ai = 0; ai < 2; ++ai)
#pragma unroll
            for (int m = 0; m < 4; ++m) { float* rowp = C + (size_t)(row0 + ai * HALF + m * 16) * ldc + col0;
#pragma unroll
                for (int bj = 0; bj < 2; ++bj)
#pragma unroll
                    for (int n = 0; n < 2; ++n) *(f32x4*)(rowp + bj * HALF + n * 16) = acc[ai][bj][m][n] + bv[bj][n]; }
    }
};
template <int ACT  > struct EpiBf16 {
    static constexpr bool PERM = true, AFTER_DRAIN = false;
    bf16_t* O; int ldc; const float* bias; int split_cols; size_t split_stride;
    __device__ __forceinline__ void operator()(const f32x4 (&acc)[2][2][4][2], const Unit& u, int wr, int wc, int fr, int fq) const {
        const int row0 = u.pm * BM + wr * 64 + fr; int colt = u.pn * BM; bf16_t* base = O;
        if (split_cols) { const int t = colt / split_cols; base += (size_t)t * split_stride; colt -= t * split_cols; }
        const int col0 = colt + wc * 32 + 8 * fq, bcol0 = u.pn * BM + wc * 32 + 8 * fq;
        f32x4 bv[2][2];
#pragma unroll
        for (int bj = 0; bj < 2; ++bj)
#pragma unroll
            for (int n = 0; n < 2; ++n) bv[bj][n] = bias ? *(const f32x4*)(bias + bcol0 + bj * HALF + 4 * n) : (f32x4){0.f, 0.f, 0.f, 0.f};
#pragma unroll
        for (int ai = 0; ai < 2; ++ai)
#pragma unroll
            for (int m = 0; m < 4; ++m) { bf16_t* rowp = base + (size_t)(row0 + ai * HALF + m * 16) * ldc + col0;
#pragma unroll
                for (int bj = 0; bj < 2; ++bj) { f32x4 v0 = acc[ai][bj][m][0] + bv[bj][0], v1 = acc[ai][bj][m][1] + bv[bj][1];
                    if (ACT == 1) { f32x2 a = gelu_pk((f32x2){v0[0], v0[1]}), b = gelu_pk((f32x2){v0[2], v0[3]}), c = gelu_pk((f32x2){v1[0], v1[1]}), d = gelu_pk((f32x2){v1[2], v1[3]});
                        v0 = (f32x4){a.x, a.y, b.x, b.y}; v1 = (f32x4){c.x, c.y, d.x, d.y}; }
                    if (ACT == 2) {
#pragma unroll
                        for (int j = 0; j < 4; ++j) { v0[j] = 0.5f * v0[j] * (1.0f + erff(v0[j] * 0.70710678f)); v1[j] = 0.5f * v1[j] * (1.0f + erff(v1[j] * 0.70710678f)); } }
                    u32x4 w; w.x = cvt_pk_bf16(v0[0], v0[1]); w.y = cvt_pk_bf16(v0[2], v0[3]); w.z = cvt_pk_bf16(v1[0], v1[1]); w.w = cvt_pk_bf16(v1[2], v1[3]);
                    *(u32x4*)(rowp + bj * HALF) = w; } }
    }
};

template <class Epi, class Sched, bool STAMP = false>
__device__ __forceinline__ void gemm_phase(PG8_LAS unsigned char* lds, const Gemm g, const Sched& S, const Epi& E, unsigned long long* stamps, int wid_in) {
    int tid_o; asm volatile("v_mbcnt_lo_u32_b32 %0, -1, 0\n\tv_mbcnt_hi_u32_b32 %0, -1, %0" : "=&v"(tid_o)); tid_o += wid_in * 64;
    const int tid = tid_o, wid = __builtin_amdgcn_readfirstlane(tid >> 6), lane = tid & 63, wr = wid >> 2, wc = wid & 3, fr = lane & 15, fq = lane >> 4;
    const int K = g.K, nt = K / BK;
    int ts_lo = 0, ts_hi = 0, nts = 0; const unsigned long long rt_entry = STAMP ? (unsigned long long)wall_clock64() : 0ull;
#define PG8_STAMP() do { if (STAMP && wid == 0 && nts < 64) { const unsigned long long _c = (unsigned long long)clock64(); \
        ts_lo = (lane == nts) ? (int)(unsigned)_c : ts_lo; ts_hi = (lane == nts) ? (int)(unsigned)(_c >> 32) : ts_hi; ++nts; } } while (0)
    PG8_STAMP();
    unsigned voffA[2], voffB[2];
#pragma unroll
    for (int i = 0; i < 2; ++i) { int R, C; stage_rc(tid * 16 + i * 8192, R, C); const int Rb = Epi::PERM ? ((R & ~31) + perm32(R & 31)) : R;
        voffA[i] = (unsigned)(R * K + C) * 2u; voffB[i] = (unsigned)(Rb * K + C) * 2u; }
    const size_t kstep = (size_t)(BK * 2);
    const size_t hstep = (size_t)HALF * K * 2;
    const size_t tstep = 2 * hstep;
    const unsigned ldsw = (unsigned)wid * 1024u;
    const int aoff = lds_byte(wr * 64 + fr, fq * 8), boff = lds_byte(wc * 32 + fr, fq * 8);
#define PG8_SA(b, h) (((b) * 2 + (h)) * HTB)
#define PG8_SB(b, h) ((4 + (b) * 2 + (h)) * HTB)
#define PG8_STAGE(bufoff, gbase, voff) do { _Pragma("unroll") for (int _i = 0; _i < 2; ++_i) \
        __builtin_amdgcn_global_load_lds((const unsigned*)((const char*)(gbase) + (voff)[_i]), (PG8_LAS unsigned*)(lds + (bufoff) + ldsw + _i * 8192), 16, 0, 0); } while (0)
#define PG8_LDA(dst, b, h) do { _Pragma("unroll") for (int m = 0; m < 4; ++m) _Pragma("unroll") for (int k = 0; k < 2; ++k) dst[m][k] = *(const PG8_LAS bf16x8*)(lds + PG8_SA(b, h) + aoff + m * 2048 + k * 1024); } while (0)
#define PG8_LDB(dst, b, h) do { _Pragma("unroll") for (int n = 0; n < 2; ++n) _Pragma("unroll") for (int k = 0; k < 2; ++k) dst[n][k] = *(const PG8_LAS bf16x8*)(lds + PG8_SB(b, h) + boff + n * 2048 + k * 1024); } while (0)
#define PG8_MMA(ai, bj, At, Bt) do { __builtin_amdgcn_s_setprio(1); _Pragma("unroll") for (int m = 0; m < 4; ++m) _Pragma("unroll") for (int n = 0; n < 2; ++n) _Pragma("unroll") for (int k = 0; k < 2; ++k) \
        acc[ai][bj][m][n] = __builtin_amdgcn_mfma_f32_16x16x32_bf16(Bt[n][k], At[m][k], acc[ai][bj][m][n], 0, 0, 0); __builtin_amdgcn_s_setprio(0); } while (0)
#define PG8_WAIT_V(n) asm volatile("s_waitcnt vmcnt(" #n ")" ::: "memory")
#define PG8_WAIT_L(n) asm volatile("s_waitcnt lgkmcnt(" #n ")" ::: "memory")
#define PG8_BAR __builtin_amdgcn_s_barrier()
#define PG8_SCHED __builtin_amdgcn_sched_barrier(0)
    Unit cur, nxt; int ui = 0;
    if (!S.next(0, cur)) return;
    f32x4 acc[2][2][4][2];
#pragma unroll
    for (int a = 0; a < 2; ++a)
#pragma unroll
        for (int b = 0; b < 2; ++b)
#pragma unroll
            for (int m = 0; m < 4; ++m)
#pragma unroll
                for (int n = 0; n < 2; ++n) acc[a][b][m][n] = (f32x4){0.f, 0.f, 0.f, 0.f};
    bf16x8 At[4][2], B0[2][2], B1[2][2];
    const char* cA = (const char*)g.A + (size_t)cur.pm * tstep; const char* cB = (const char*)g.Bt + (size_t)cur.pn * tstep;
    S.a_ready(cur);
    PG8_STAGE(PG8_SB(0, 0), cB, voffB); PG8_STAGE(PG8_SA(0, 0), cA, voffA); PG8_STAGE(PG8_SB(0, 1), cB + hstep, voffB); PG8_STAGE(PG8_SA(0, 1), cA + hstep, voffA);
    if (wr == 1) PG8_BAR;
    PG8_WAIT_V(4); PG8_BAR;
    PG8_STAGE(PG8_SB(1, 0), cB + kstep, voffB); PG8_STAGE(PG8_SA(1, 0), cA + kstep, voffA); PG8_STAGE(PG8_SB(1, 1), cB + hstep + kstep, voffB);
    PG8_WAIT_V(6); PG8_BAR;
    PG8_STAMP();
    for (;;) {
        const bool has_next = S.next(ui + 1, nxt);
        const char* nA = has_next ? (const char*)g.A + (size_t)nxt.pm * tstep : cA; const char* nB = has_next ? (const char*)g.Bt + (size_t)nxt.pn * tstep : cB;
        for (int t = 0; t < nt; t += 2) {
            const bool last = (t == nt - 2);
            const char* a1 = cA + (size_t)(t + 1) * kstep;
            const char* a2 = last ? nA : cA + (size_t)(t + 2) * kstep; const char* b2 = last ? nB : cB + (size_t)(t + 2) * kstep;
            const char* a3 = a2 + kstep; const char* b3 = b2 + kstep;
            if (last && has_next) S.a_ready(nxt);
            PG8_LDB(B0, 0, 0); PG8_SCHED; PG8_LDA(At, 0, 0); PG8_STAGE(PG8_SA(1, 1), a1 + hstep, voffA);
            PG8_WAIT_L(8); PG8_BAR; PG8_WAIT_L(0); PG8_MMA(0, 0, At, B0); PG8_BAR; PG8_SCHED;
            PG8_LDB(B1, 0, 1); PG8_STAGE(PG8_SB(0, 0), b2, voffB);
            PG8_BAR; PG8_WAIT_L(0); PG8_MMA(0, 1, At, B1); PG8_BAR;
            PG8_LDA(At, 0, 1); PG8_STAGE(PG8_SA(0, 0), a2, voffA);
            PG8_BAR; PG8_WAIT_L(0); PG8_MMA(1, 0, At, B0); PG8_BAR; PG8_SCHED;
            PG8_STAGE(PG8_SB(0, 1), b2 + hstep, voffB);
            PG8_WAIT_V(6); PG8_BAR; PG8_MMA(1, 1, At, B1); PG8_BAR;
            PG8_LDB(B0, 1, 0); PG8_SCHED; PG8_LDA(At, 1, 0); PG8_STAGE(PG8_SA(0, 1), a2 + hstep, voffA);
            PG8_WAIT_L(8); PG8_BAR; PG8_WAIT_L(0); PG8_MMA(0, 0, At, B0); PG8_BAR; PG8_SCHED;
            PG8_LDB(B1, 1, 1); PG8_STAGE(PG8_SB(1, 0), b3, voffB);
            PG8_BAR; PG8_WAIT_L(0); PG8_MMA(0, 1, At, B1); PG8_BAR;
            PG8_LDA(At, 1, 1); PG8_STAGE(PG8_SA(1, 0), a3, voffA);
            PG8_BAR; PG8_WAIT_L(0); PG8_MMA(1, 0, At, B0); PG8_BAR; PG8_SCHED;
            PG8_STAGE(PG8_SB(1, 1), b3 + hstep, voffB);
            PG8_WAIT_V(6); PG8_BAR; PG8_MMA(1, 1, At, B1); PG8_BAR;
        }
        PG8_STAMP();
        if constexpr (!Epi::AFTER_DRAIN) { E(acc, cur, wr, wc, fr, fq); S.done(cur); }
        PG8_STAMP();
        if (!has_next) break;
#pragma unroll
        for (int a = 0; a < 2; ++a)
#pragma unroll
            for (int b = 0; b < 2; ++b)
#pragma unroll
                for (int m = 0; m < 4; ++m)
#pragma unroll
                    for (int n = 0; n < 2; ++n) acc[a][b][m][n] = (f32x4){0.f, 0.f, 0.f, 0.f};
        cur = nxt; cA = nA; cB = nB; ++ui;
    }
    PG8_WAIT_V(0);
    if (wr == 0) PG8_BAR;
    PG8_BAR;
    if constexpr (Epi::AFTER_DRAIN) { E.fused(acc, cur, wr, wc, fr, fq, lds, wid, lane); S.done(cur); }
    PG8_STAMP();
    if (STAMP && wid == 0) { stamps[lane] = lane < nts ? (((unsigned long long)(unsigned)ts_hi << 32) | (unsigned)ts_lo) : 0ull;
        if (lane == 62) stamps[62] = rt_entry; if (lane == 63) stamps[63] = (unsigned long long)wall_clock64(); }
#undef PG8_STAMP
#undef PG8_SA
#undef PG8_SB
#undef PG8_STAGE
#undef PG8_LDA
#undef PG8_LDB
#undef PG8_MMA
#undef PG8_WAIT_V
#undef PG8_WAIT_L
#undef PG8_BAR
#undef PG8_SCHED
}
}
#define XB_TMO      128
#define XB_XCNT(j)  (256  + 64 * (j))
#define XB_XSUB(j)  (1280 + 64 * (j))
#define XB_XGEN(j)  (2304 + 64 * (j))
#define XB_TOP      3328
#define XB_TOPGEN   3392
#define XCD_BAR_WORDS 3456
#define XB_SPIN_CAP (1u << 18)

__device__ __forceinline__ unsigned xb_ld(unsigned* p)              { return __hip_atomic_load(p, __ATOMIC_RELAXED, __HIP_MEMORY_SCOPE_AGENT); }
__device__ __forceinline__ unsigned xb_add(unsigned* p, unsigned v) { return __hip_atomic_fetch_add(p, v, __ATOMIC_RELAXED, __HIP_MEMORY_SCOPE_AGENT); }
__device__ __forceinline__ unsigned xb_xcc_id() { return (unsigned)__builtin_amdgcn_s_getreg((3 << 11) | 20) & 0xFu; }
#define XB_SPIN(cond, bar) do { unsigned _sp = 0; while (cond) { __builtin_amdgcn_s_sleep(1); \
    if ((++_sp & 255u) == 0u) { if (xb_ld(&(bar)[XB_TMO])) break; if (_sp > XB_SPIN_CAP) { atomicAdd(&(bar)[XB_TMO], 1u); break; } } } } while (0)

struct XcdBarrier {
    unsigned w0;
    unsigned* bar; unsigned x;
    volatile LAS unsigned* st;
};

__device__ __forceinline__ XcdBarrier xcd_barrier_post(unsigned* bar, volatile LAS unsigned* st, unsigned w0) {
    XcdBarrier b; b.w0 = w0; b.bar = bar; b.x = xb_xcc_id(); b.st = st;
    if (threadIdx.x == 0) (void)xb_add(&bar[XB_XCNT(b.x)], 1u);
    return b;
}
__device__ __forceinline__ void xcd_barrier_complete(unsigned* bar, unsigned x, unsigned& nloc, unsigned& nx) {
    const unsigned G = gridDim.x * gridDim.y * gridDim.z;
    unsigned sum, cnt, mine, sp = 0u;
    for (;;) {
        sum = 0u; cnt = 0u; mine = 0u;
#pragma unroll
        for (unsigned j = 0; j < 16; ++j) { const unsigned c = xb_ld(&bar[XB_XCNT(j)]); sum += c; cnt += (c > 0u) ? 1u : 0u; mine = (j == x) ? c : mine; }
        if (sum == G) break;
        __builtin_amdgcn_s_sleep(1);
        if ((++sp & 255u) == 0u) { if (xb_ld(&bar[XB_TMO])) break; if (sp > XB_SPIN_CAP) { atomicAdd(&bar[XB_TMO], 1u); break; } }
    }
    nloc = mine > 0u ? mine : 1u; nx = cnt > 0u ? cnt : 1u;
}

__device__ __forceinline__ void xcd_barrier(const XcdBarrier& b) {
    asm volatile("s_waitcnt vmcnt(0)" ::: "memory");
    __syncthreads();
    int xb_lane; asm volatile("v_mbcnt_lo_u32_b32 %0, -1, 0\n\tv_mbcnt_hi_u32_b32 %0, -1, %0" : "=&v"(xb_lane));
    if (b.w0 == 0u && xb_lane == 0) {
        unsigned* bar = b.bar;
        __builtin_amdgcn_s_waitcnt(0);
        unsigned nloc = b.st[0], nx = b.st[1];
        if (nloc == 0u) { xcd_barrier_complete(bar, b.x, nloc, nx); b.st[0] = nloc; b.st[1] = nx; }
        const unsigned old = xb_add(&bar[XB_XSUB(b.x)], 1u);
        const unsigned gen = old / nloc;
        if (old + 1u == (gen + 1u) * nloc) {
            __builtin_amdgcn_fence(__ATOMIC_RELEASE, "agent");
            asm volatile("s_waitcnt vmcnt(0)" ::: "memory");
            const unsigned og = xb_add(&bar[XB_TOP], 1u);
            const unsigned tg = og / nx;
            if (og + 1u == (tg + 1u) * nx) xb_add(&bar[XB_TOPGEN], 1u);
            else XB_SPIN(xb_ld(&bar[XB_TOPGEN]) == tg, bar);
            __builtin_amdgcn_fence(__ATOMIC_ACQUIRE, "agent");
            xb_add(&bar[XB_XGEN(b.x)], 1u);
            asm volatile("s_waitcnt vmcnt(0)" ::: "memory");
        } else {
            XB_SPIN(xb_ld(&bar[XB_XGEN(b.x)]) == gen, bar);
            __builtin_amdgcn_fence(__ATOMIC_ACQUIRE, "agent");
            asm volatile("s_waitcnt vmcnt(0)" ::: "memory");
        }
    }
    __syncthreads();
}

using pg8::Unit;
DI float row_rs(const float* stats, int row) {
    const f32x4* p = (const f32x4*)(stats + (size_t)row * 16);
    const f32x4 a = p[0], b = p[1], c = p[2], d = p[3];
    const float s = ((a.x + a.y) + (a.z + a.w)) + ((b.x + b.y) + (b.z + b.w)) + ((c.x + c.y) + (c.z + c.w)) + ((d.x + d.y) + (d.z + d.w));
    return rsqrtf(s * (1.0f / 1024.0f) + EPS);
}
DI void row_rs8(const float* stats, int row0, int fq, float (&rs)[2][4]) {
    f32x4 p[2][4];
#pragma unroll
    for (int ai = 0; ai < 2; ++ai)
#pragma unroll
        for (int m = 0; m < 4; ++m) p[ai][m] = *(const f32x4*)(stats + (size_t)(row0 + ai * 128 + m * 16) * 16 + 4 * fq);
#pragma unroll
    for (int ai = 0; ai < 2; ++ai)
#pragma unroll
        for (int m = 0; m < 4; ++m) rs[ai][m] = rsqrtf(rows_sum((p[ai][m].x + p[ai][m].y) + (p[ai][m].z + p[ai][m].w)) * (1.0f / 1024.0f) + EPS);
}
struct EpiDnIn {
    static constexpr bool PERM = true, AFTER_DRAIN = false;
    const float* stats; bf16_t* qkvb; bf16_t* zb; float* ab;
    DI void operator()(const f32x4 (&acc)[2][2][4][2], const Unit& u, int wr, int wc, int fr, int fq) const {
        const int row0 = u.pm * 256 + wr * 64 + fr;
        asm volatile("" ::: "memory");
        float rs8[2][4]; row_rs8(stats, row0, fq, rs8);
#pragma unroll
        for (int ai = 0; ai < 2; ++ai)
#pragma unroll
            for (int m = 0; m < 4; ++m) {
                const int row = row0 + ai * 128 + m * 16; const float rs = rs8[ai][m];
#pragma unroll
                for (int bj = 0; bj < 2; ++bj) {
                    const int c0 = u.pn * 256 + bj * 128 + wc * 32 + 8 * fq;
                    const f32x4 v0 = acc[ai][bj][m][0] * rs, v1 = acc[ai][bj][m][1] * rs;
                    if (u.pn < 16) {
                        u32x4 w; w.x = pk2(v0.x, v0.y); w.y = pk2(v0.z, v0.w); w.z = pk2(v1.x, v1.y); w.w = pk2(v1.z, v1.w);
                        if (u.pn < 12) *(u32x4*)(qkvb + (size_t)row * 3072 + c0) = w;
                        else *(u32x4*)(zb + (size_t)row * 1024 + (c0 - 3072)) = w;
                    } else if (c0 < 4096 + 16) {
                        float* o = ab + (size_t)row * 16 + (c0 - 4096);
                        *(f32x4*)o = v0; *(f32x4*)(o + 4) = v1;
                    }
                }
            }
    }
};
struct EpiRes {
    static constexpr bool PERM = true, AFTER_DRAIN = false;
    const float* xp; const float* xs; float* X; bf16_t* XB; float* stats; int first; float* Xw; bf16_t* XBw; float* statsw;
    DI void operator()(const f32x4 (&acc)[2][2][4][2], const Unit& u, int wr, int wc, int fr, int fq) const {
        const int row0 = u.pm * 256 + wr * 64 + fr, col0 = u.pn * 256 + wc * 32 + 8 * fq;
        asm volatile("" ::: "memory");
#pragma unroll
        for (int ai = 0; ai < 2; ++ai) {
            u32x4 bb[4][2];
            if (!first) {
#pragma unroll
                for (int m = 0; m < 4; ++m)
#pragma unroll
                    for (int bj = 0; bj < 2; ++bj) bb[m][bj] = *(const u32x4*)(XB + (size_t)(row0 + ai * 128 + m * 16) * D + col0 + bj * 128);
            }
#pragma unroll
            for (int m = 0; m < 4; ++m) {
                const int row = row0 + ai * 128 + m * 16;
                float ss = 0.f;
#pragma unroll
                for (int bj = 0; bj < 2; ++bj) {
                    const int c = col0 + bj * 128;
                    f32x4 b0, b1;
                    if (first) { const float* xr = (row < TP ? xp + (size_t)row * D : xs + (size_t)(row - TP) * D) + c; b0 = *(const f32x4*)xr; b1 = *(const f32x4*)(xr + 4); }
                    else { const u32x4 q = bb[m][bj]; b0 = (f32x4){bflo(q.x), bfhi(q.x), bflo(q.y), bfhi(q.y)}; b1 = (f32x4){bflo(q.z), bfhi(q.z), bflo(q.w), bfhi(q.w)}; }
                    const f32x4 o0 = b0 + acc[ai][bj][m][0], o1 = b1 + acc[ai][bj][m][1];
                    u32x4 w; w.x = pk2(o0.x, o0.y); w.y = pk2(o0.z, o0.w); w.z = pk2(o1.x, o1.y); w.w = pk2(o1.z, o1.w);
                    *(u32x4*)(XBw + (size_t)row * D + c) = w;
                    ss += ((o0.x * o0.x + o0.y * o0.y) + (o0.z * o0.z + o0.w * o0.w)) + ((o1.x * o1.x + o1.y * o1.y) + (o1.z * o1.z + o1.w * o1.w));
                }
                ss = rows_sum(ss);
                if (fq == 0) statsw[(size_t)row * 16 + u.pn * 4 + wc] = ss;
            }
        }
    }
};
struct EpiFfnIn {
    static constexpr bool PERM = true, AFTER_DRAIN = false;
    const float* stats; bf16_t* act;
    DI void operator()(const f32x4 (&acc)[2][2][4][2], const Unit& u, int wr, int wc, int fr, int fq) const {
        const int row0 = u.pm * 256 + wr * 64 + fr, c0 = u.pn * 128 + wc * 32 + 8 * fq;
        asm volatile("" ::: "memory");
        float rs8[2][4]; row_rs8(stats, row0, fq, rs8);
#pragma unroll
        for (int ai = 0; ai < 2; ++ai)
#pragma unroll
            for (int m = 0; m < 4; ++m) {
                const int row = row0 + ai * 128 + m * 16; const float rs = rs8[ai][m];
                float o[8];
#pragma unroll
                for (int n = 0; n < 2; ++n)
#pragma unroll
                    for (int j = 0; j < 4; ++j) { const float g = acc[ai][0][m][n][j] * rs, up = acc[ai][1][m][n][j] * rs; o[4 * n + j] = siluf_(g) * up; }
                u32x4 w; w.x = pk2(o[0], o[1]); w.y = pk2(o[2], o[3]); w.z = pk2(o[4], o[5]); w.w = pk2(o[6], o[7]);
                *(u32x4*)(act + (size_t)row * DFF + c0) = w;
            }
    }
};
DI int permkey(int key) { return (key & ~31) + 8 * ((key >> 2) & 3) + 4 * ((key >> 4) & 1) + (key & 3); }
struct EpiKV {
    static constexpr bool PERM = true, AFTER_DRAIN = false;
    const float* stats; float* out; unsigned char* ws;
    DI void operator()(const f32x4 (&acc)[2][2][4][2], const Unit& u, int wr, int wc, int fr, int fq) const {
        const int row0 = u.pm * 256 + wr * 64 + fr, part = u.pn;
        asm volatile("" ::: "memory");
        float rs8[2][4]; row_rs8(stats, row0, fq, rs8);
#pragma unroll
        for (int ai = 0; ai < 2; ++ai)
#pragma unroll
            for (int m = 0; m < 4; ++m) {
                const int row = row0 + ai * 128 + m * 16; const float rs = rs8[ai][m];
                const bool prm = row < TP;
                const int b = prm ? (row >> 12) : ((row - TP) >> 2), pos = prm ? (row & 4095) : (2048 + ((row - TP) & 3));
                const int blk = pos >> 6, key = pos & 63;
#pragma unroll
                for (int bj = 0; bj < 2; ++bj) {
                    const int lc = bj * 128 + wc * 32 + 8 * fq, kvh = lc >> 6, d = lc & 63;
                    const f32x4 v0 = acc[ai][bj][m][0] * rs, v1 = acc[ai][bj][m][1] * rs;
                    if (part < 4) {
                        float* o = (prm ? out + O_PKV + (size_t)row * 1024 : out + O_SKV + (size_t)(row - TP) * 1024) + part * 256 + lc;
                        *(f32x4*)o = v0; *(f32x4*)(o + 4) = v1;
                    } else {
                        if (prm) { if (pos >= 3584) { float* o = out + O_PW + ((size_t)(b * 512 + (pos - 3584)) * 2 + (part - 4)) * 256 + lc; *(f32x4*)o = v0; *(f32x4*)(o + 4) = v1; } }
                        else { float* o = out + O_SW + ((size_t)(b * 512 + 508 + (pos - 2048)) * 2 + (part - 4)) * 256 + lc; *(f32x4*)o = v0; *(f32x4*)(o + 4) = v1; }
                    }
                    if (part == 2 || part == 4) {
                        bf16_t* kb = prm ? (bf16_t*)(ws + (part == 2 ? WS_KSELP : WS_KWINP)) + ((size_t)((b * 4 + kvh) * 64 + blk)) * 4096
                                         : (part == 2 ? (bf16_t*)(ws + WS_KSELS) + ((size_t)((b * 4 + kvh) * 33 + 32)) * 4096 : (bf16_t*)(ws + WS_KWINS) + ((size_t)((b * 4 + kvh) * 9 + 8)) * 4096);
                        u32x4 w; w.x = pk2(v0.x, v0.y); w.y = pk2(v0.z, v0.w); w.z = pk2(v1.x, v1.y); w.w = pk2(v1.z, v1.w);
                        *(u32x4*)(kb + key * 64 + d) = w;
                    } else if (part == 3 || part == 5) {
                        bf16_t* vb = prm ? (bf16_t*)(ws + (part == 3 ? WS_VSELP : WS_VWINP)) + ((size_t)((b * 4 + kvh) * 64 + blk)) * 4096
                                         : (part == 3 ? (bf16_t*)(ws + WS_VSELS) + ((size_t)((b * 4 + kvh) * 33 + 32)) * 4096 : (bf16_t*)(ws + WS_VWINS) + ((size_t)((b * 4 + kvh) * 9 + 8)) * 4096);
                        const int pk = permkey(key);
                        vb[(d + 0) * 64 + pk] = f2bf(v0.x); vb[(d + 1) * 64 + pk] = f2bf(v0.y); vb[(d + 2) * 64 + pk] = f2bf(v0.z); vb[(d + 3) * 64 + pk] = f2bf(v0.w);
                        vb[(d + 4) * 64 + pk] = f2bf(v1.x); vb[(d + 5) * 64 + pk] = f2bf(v1.y); vb[(d + 6) * 64 + pk] = f2bf(v1.z); vb[(d + 7) * 64 + pk] = f2bf(v1.w);
                    }
                }
            }
    }
};
struct EpiNsaIn {
    static constexpr bool PERM = true, AFTER_DRAIN = false;
    const float* stats; bf16_t* qb; float* gates;
    DI void operator()(const f32x4 (&acc)[2][2][4][2], const Unit& u, int wr, int wc, int fr, int fq) const {
        const int row0 = u.pm * 256 + wr * 64 + fr;
        asm volatile("" ::: "memory");
        float rs8[2][4]; row_rs8(stats, row0, fq, rs8);
#pragma unroll
        for (int ai = 0; ai < 2; ++ai)
#pragma unroll
            for (int m = 0; m < 4; ++m) {
                const int row = row0 + ai * 128 + m * 16; const float rs = rs8[ai][m];
#pragma unroll
                for (int bj = 0; bj < 2; ++bj) {
                    const int c0 = u.pn * 256 + bj * 128 + wc * 32 + 8 * fq;
                    const f32x4 v0 = acc[ai][bj][m][0] * rs, v1 = acc[ai][bj][m][1] * rs;
                    if (u.pn < 4) {
                        const float s = 0.125f;
                        u32x4 w; w.x = pk2(v0.x * s, v0.y * s); w.y = pk2(v0.z * s, v0.w * s); w.z = pk2(v1.x * s, v1.y * s); w.w = pk2(v1.z * s, v1.w * s);
                        *(u32x4*)(qb + (size_t)row * 1024 + c0) = w;
                    } else if (c0 < 1024 + 48) {
                        float* o = gates + (size_t)row * 48 + (c0 - 1024);
                        f32x4 g0, g1;
                        g0.x = sigmoidf_(v0.x); g0.y = sigmoidf_(v0.y); g0.z = sigmoidf_(v0.z); g0.w = sigmoidf_(v0.w);
                        g1.x = sigmoidf_(v1.x); g1.y = sigmoidf_(v1.y); g1.z = sigmoidf_(v1.z); g1.w = sigmoidf_(v1.w);
                        *(f32x4*)o = g0; *(f32x4*)(o + 4) = g1;
                    }
                }
            }
    }
};
struct Args { const void* in[25]; float* out; unsigned char* ws; int ph_lo, ph_hi; unsigned dup_mask; unsigned pad; };
typedef const __attribute__((address_space(4))) Args CArgs;
#define IN_F(i) ((const float*)A.in[i])
enum { I_XP = 0, I_XS, I_SDNS, I_SDNC, I_CACHE, I_SWIN, I_PT, I_NMIX, I_NFFN, I_NKV, I_NFIN, I_FFNWIN, I_FFNWOUT, I_DNWIN, I_DNCONVW, I_DNALOG, I_DNDTB, I_DNONORM, I_DNWOUT, I_NSAWKV, I_CMPPOSW, I_WCMP, I_NSAWIN, I_NSAWOUT, I_RELB };

struct TrDesc { const float* W; const float* scale; bf16_t* WT; int Nsrc, K, Nreal, kind, k0, n0; };
DI void p0_tr_load(const TrDesc& d, f32x4 (&v)[16], f32x4& sc0, f32x4& sc1, bool& ok, int lane) {
    const int c4 = d.n0 + 4 * (lane & 15);
    int src; ok = true;
    if (d.kind == 1) { const int pn = c4 >> 8, lc = c4 & 255; src = lc < 128 ? 128 * pn + lc : DFF + 128 * pn + (lc - 128); }
    else { ok = c4 < d.Nreal; src = ok ? c4 : 0; }
    const unsigned voff = (unsigned)((lane >> 4) * d.Nsrc + src);
#pragma unroll
    for (int i = 0; i < 16; ++i) { const float* rowp = d.W + (size_t)(d.k0 + 4 * i) * d.Nsrc; v[i] = *(const f32x4*)(rowp + voff); }
    sc0 = (f32x4){1.f, 1.f, 1.f, 1.f}; sc1 = sc0;
    if (d.scale) { const f32x4* sp = (const f32x4*)(d.scale + d.k0 + 8 * (lane & 7)); sc0 = sp[0]; sc1 = sp[1]; }
}
DI void p0_tr_lds(const f32x4 (&v)[16], bool ok, LAS float* scr, int lane) {
    LAS float* w = scr + (lane >> 4) * 65 + 4 * (lane & 15);
#pragma unroll
    for (int i = 0; i < 16; ++i) {
        w[(4 * i) * 65 + 0] = ok ? v[i].x : 0.f; w[(4 * i) * 65 + 1] = ok ? v[i].y : 0.f; w[(4 * i) * 65 + 2] = ok ? v[i].z : 0.f; w[(4 * i) * 65 + 3] = ok ? v[i].w : 0.f;
    }
}
DI void p0_tr_store(bf16_t* WT, int K, int k0, int n0, const f32x4& sc0, const f32x4& sc1, const LAS float* scr, int lane) {
    const int c = lane & 7;
    const LAS float* s = scr + (8 * c) * 65 + (lane >> 3);
    bf16_t* o = WT + (size_t)(n0 + (lane >> 3)) * K + k0 + 8 * c;
#pragma unroll
    for (int j = 0; j < 8; ++j) {
        u32x4 w; w.x = pk2(s[8 * j + 0 * 65] * sc0.x, s[8 * j + 1 * 65] * sc0.y); w.y = pk2(s[8 * j + 2 * 65] * sc0.z, s[8 * j + 3 * 65] * sc0.w);
        w.z = pk2(s[8 * j + 4 * 65] * sc1.x, s[8 * j + 5 * 65] * sc1.y); w.w = pk2(s[8 * j + 6 * 65] * sc1.z, s[8 * j + 7 * 65] * sc1.w);
        *(u32x4*)(o + (size_t)(8 * j) * K) = w;
    }
}
DI void p0_row2(const float* xrow0, const float* xrow1, bf16_t* xb0, bf16_t* xb1, float* st0, float* st1, int lane) {
    const f32x4* xr0 = (const f32x4*)xrow0 + lane; const f32x4* xr1 = (const f32x4*)xrow1 + lane; f32x4 v[4], u[4]; float s = 0.f, t = 0.f;
#pragma unroll
    for (int j = 0; j < 4; ++j) { v[j] = xr0[64 * j]; u[j] = xr1[64 * j]; }
#pragma unroll
    for (int j = 0; j < 4; ++j) { s += (v[j].x * v[j].x + v[j].y * v[j].y) + (v[j].z * v[j].z + v[j].w * v[j].w); t += (u[j].x * u[j].x + u[j].y * u[j].y) + (u[j].z * u[j].z + u[j].w * u[j].w); }
    s = wave_sum(s); t = wave_sum(t);
    u32x2* o0 = (u32x2*)xb0 + lane; u32x2* o1 = (u32x2*)xb1 + lane;
#pragma unroll
    for (int j = 0; j < 4; ++j) { u32x2 w; w.x = pk2(v[j].x, v[j].y); w.y = pk2(v[j].z, v[j].w); o0[64 * j] = w; u32x2 y; y.x = pk2(u[j].x, u[j].y); y.y = pk2(u[j].z, u[j].w); o1[64 * j] = y; }
    if (lane < 16) st0[lane] = lane == 0 ? s : 0.f;
    else if (lane < 32) st1[lane - 16] = lane == 16 ? t : 0.f;
}
DI int rel_bucket_dev(int dist) {
    const int n = dist > 0 ? dist : 0;
    if (n < 16) return n;
    if (n >= 1024) return 31;
    const double v = (log2((double)n) - 4.0) * (8.0 / 3.0);
    int k = (int)(v + 1e-9); k = 16 + k;
    return k < 31 ? k : 31;
}
#define GAS __attribute__((address_space(1)))
DI const GAS float* uni_ptr(const float* p) {
    const unsigned long long v = (unsigned long long)p;
    const unsigned lo = __builtin_amdgcn_readfirstlane((unsigned)v), hi = __builtin_amdgcn_readfirstlane((unsigned)(v >> 32));
    return (const GAS float*)(((unsigned long long)hi << 32) | lo);
}
DI void conv_rows128(const float* src, int pitch, int koff, int voff, bf16_t* kdst, bf16_t* vdst, int NB, LAS float* tile, int tid, float* cpy, int row0) {
    const int c8 = tid & 31, rr0 = tid >> 5, kvh = c8 >> 3, d0 = (c8 & 7) * 8;
    f32x4 ka[8], kb[8], va[8], vb[8];
    {
        const GAS float* su = uni_ptr(src);
        const unsigned ok_ = (unsigned)(rr0 * pitch + koff + c8 * 8), ov_ = (unsigned)(rr0 * pitch + voff + c8 * 8);
#pragma unroll
        for (int i = 0; i < 8; ++i) { const GAS float* rb = su + (size_t)(16 * i) * pitch; const GAS f32x4* p = (const GAS f32x4*)(rb + ok_); ka[i] = p[0]; kb[i] = p[1]; }
#pragma unroll
        for (int i = 0; i < 8; ++i) { const GAS float* rb = su + (size_t)(16 * i) * pitch; const GAS f32x4* p = (const GAS f32x4*)(rb + ov_); va[i] = p[0]; vb[i] = p[1]; }
    }
#pragma unroll
    for (int i = 0; i < 8; ++i) {
        const int rr = rr0 + 16 * i;
        u32x4 o; o.x = pk2(ka[i].x, ka[i].y); o.y = pk2(ka[i].z, ka[i].w); o.z = pk2(kb[i].x, kb[i].y); o.w = pk2(kb[i].z, kb[i].w);
        *(u32x4*)(kdst + ((size_t)(kvh * NB + (rr >> 6)) * 64 + (rr & 63)) * 64 + d0) = o;
        if (cpy) { if (row0 + rr >= 4) { float* q = cpy + (size_t)(row0 + rr - 4) * 512 + koff + c8 * 8; *(f32x4*)q = ka[i]; *(f32x4*)(q + 4) = kb[i]; } }
    }
#pragma unroll
    for (int hb = 0; hb < 2; ++hb) {
#pragma unroll
        for (int i = 0; i < 4; ++i) {
            const int rr = rr0 + 16 * i; const f32x4 a = va[4 * hb + i], b = vb[4 * hb + i];
            LAS float* t = tile + (kvh * 64 + rr) * 65 + d0;
            t[0] = a.x; t[1] = a.y; t[2] = a.z; t[3] = a.w; t[4] = b.x; t[5] = b.y; t[6] = b.z; t[7] = b.w;
            if (cpy) { if (row0 + 64 * hb + rr >= 4) { float* q = cpy + (size_t)(row0 + 64 * hb + rr - 4) * 512 + voff + c8 * 8; *(f32x4*)q = a; *(f32x4*)(q + 4) = b; } }
        }
        __syncthreads();
#pragma unroll
        for (int i = 0; i < 4; ++i) {
            const int d = (tid >> 3) & 63, ch = tid & 7, k0 = 32 * (ch >> 2) + 4 * (ch & 3);
            const LAS float* t = tile + (i * 64) * 65 + d;
            u32x4 o; o.x = pk2(t[(k0 + 0) * 65], t[(k0 + 1) * 65]); o.y = pk2(t[(k0 + 2) * 65], t[(k0 + 3) * 65]);
            o.z = pk2(t[(k0 + 16) * 65], t[(k0 + 17) * 65]); o.w = pk2(t[(k0 + 18) * 65], t[(k0 + 19) * 65]);
            *(u32x4*)(vdst + ((size_t)(i * NB + hb) * 64 + d) * 64 + 8 * ch) = o;
        }
        __syncthreads();
    }
}
DI void cmp_item(const float* srcA, const float* srcB, int pitch, int nsub, const float* posw, const float* wcmp, bf16_t* ck, bf16_t* cvt, int NK, int j0, LAS float* blkS, int tid) {
    const int col = tid, c = col >> 8, kvh = (col >> 6) & 3, d = col & 63;
    float pw[32];
    const float* pwu = posw; const float* wu = wcmp;
    unsigned pwo = (unsigned)(((c * 32) * 4 + kvh) * 64 + d), wo = (unsigned)(((c * 4 + kvh) * 64) * 64 + d);
    asm volatile("" : "+v"(pwo), "+v"(wo));
#pragma unroll
    for (int r = 0; r < 32; ++r) { const float* rb = pwu + r * 256; pw[r] = rb[pwo]; }
    float lo_prev = 0.f;
    const GAS float* sA = uni_ptr(srcA); const GAS float* sB = uni_ptr(srcB); const unsigned ucol = (unsigned)col;
#pragma unroll 1
    for (int g = 0; g < 3; ++g) {
        float x[48];
#pragma unroll
        for (int mm = 0; mm < 3; ++mm) {
            const int m = 3 * g + mm;
            const GAS float* rp = m < 8 ? sA + (size_t)(16 * m) * pitch : sB;
#pragma unroll
            for (int r = 0; r < 16; ++r) { const GAS float* rb = rp + (size_t)r * pitch; x[16 * mm + r] = rb[ucol]; }
        }
#pragma unroll
        for (int mm = 0; mm < 3; ++mm) {
            const int m = 3 * g + mm;
            float lo = 0.f, hi = 0.f;
#pragma unroll
            for (int r = 0; r < 16; ++r) { lo += pw[r] * x[16 * mm + r]; hi += pw[16 + r] * x[16 * mm + r]; }
            if (m >= 1) blkS[(m - 1) * 512 + col] = lo_prev + hi;
            lo_prev = lo;
        }
    }
    if (nsub < 9) blkS[7 * 512 + col] = 0.f;
    float wc[16];
#pragma unroll
    for (int u = 0; u < 16; ++u) { const float* rb = wu + u * 64; wc[u] = rb[wo]; }
    __syncthreads();
    float out[8];
#pragma unroll
    for (int j = 0; j < 8; ++j) out[j] = 0.f;
    const LAS float* bs = blkS + (col & ~63);
#pragma unroll 1
    for (int g = 0; g < 4; ++g) {
        float wn[16];
        if (g < 3) {
#pragma unroll
            for (int u = 0; u < 16; ++u) { const float* rb = wu + (16 * (g + 1) + u) * 64; wn[u] = rb[wo]; }
        } else {
#pragma unroll
            for (int u = 0; u < 16; ++u) wn[u] = 0.f;
        }
#pragma unroll
        for (int u = 0; u < 16; ++u) {
            const float wv = wc[u]; const int dd = 16 * g + u;
#pragma unroll
            for (int j = 0; j < 8; ++j) out[j] += bs[j * 512 + dd] * wv;
        }
#pragma unroll
        for (int u = 0; u < 16; ++u) wc[u] = wn[u];
    }
    const int nj = nsub - 1;
#pragma unroll
    for (int j = 0; j < 8; ++j) {
        const float val = j < nj ? out[j] : 0.f; const int key = j0 + j;
        if (c == 0) ck[((size_t)(kvh * NK + key)) * 64 + d] = f2bf(val);
        else cvt[((size_t)(kvh * 64 + d)) * NK + permkey(key)] = f2bf(val);
    }
    __syncthreads();
}
DI void phase_p0(CArgs& A, LAS unsigned char* lds, int tid, int wave, int lane) {
    unsigned char* ws = A.ws;
    const int gw = blockIdx.x * NWAVES + wave, NGW = gridDim.x * NWAVES;
    LAS float* scr = (LAS float*)(lds + wave * 17408);
    constexpr int I_DNIN = 16 * (N_DNIN / 64), I_SQ = 16 * 16, I_FIN = 16 * (2 * DFF / 64), I_FOUT = (DFF / 64) * 16, I_KV = 16 * (N_KV / 64), I_NIN = 16 * (N_NSAIN / 64);
    constexpr int NITEMS = 2 * I_DNIN + 2 * I_SQ + 4 * I_FIN + 4 * I_FOUT + I_KV + 2 * I_NIN + 2 * I_SQ;
#define P0_DESC(d, it_) do { int r = (it_); int nblk; \
        if (r < 2 * I_DNIN) { const int l = r / I_DNIN; r -= l * I_DNIN; d.W = IN_F(I_DNWIN) + (size_t)l * D * N_DNIN_REAL; d.Nsrc = N_DNIN_REAL; d.K = D; nblk = N_DNIN / 64; d.Nreal = N_DNIN_REAL; d.kind = 0; d.scale = IN_F(I_NMIX) + l * D; d.WT = (bf16_t*)(ws + WS_WDNIN + l * SZ_WDNIN); } \
        else if ((r -= 2 * I_DNIN) < 2 * I_SQ) { const int l = r / I_SQ; r -= l * I_SQ; d.W = IN_F(I_DNWOUT) + (size_t)l * D * D; d.Nsrc = D; d.K = D; nblk = 16; d.Nreal = D; d.kind = 0; d.scale = nullptr; d.WT = (bf16_t*)(ws + WS_WDNOUT + l * SZ_WSQ); } \
        else if ((r -= 2 * I_SQ) < 4 * I_FIN) { const int l = r / I_FIN; r -= l * I_FIN; d.W = IN_F(I_FFNWIN) + (size_t)l * D * 2 * DFF; d.Nsrc = 2 * DFF; d.K = D; nblk = 2 * DFF / 64; d.Nreal = 2 * DFF; d.kind = 1; d.scale = IN_F(I_NFFN) + l * D; d.WT = (bf16_t*)(ws + WS_WFFNIN + l * SZ_WFFNIN); } \
        else if ((r -= 4 * I_FIN) < 4 * I_FOUT) { const int l = r / I_FOUT; r -= l * I_FOUT; d.W = IN_F(I_FFNWOUT) + (size_t)l * DFF * D; d.Nsrc = D; d.K = DFF; nblk = 16; d.Nreal = D; d.kind = 0; d.scale = nullptr; d.WT = (bf16_t*)(ws + WS_WFFNOUT + l * SZ_WFFNOUT); } \
        else if ((r -= 4 * I_FOUT) < I_KV) { d.W = IN_F(I_NSAWKV); d.Nsrc = N_KV; d.K = D; nblk = N_KV / 64; d.Nreal = N_KV; d.kind = 0; d.scale = IN_F(I_NKV); d.WT = (bf16_t*)(ws + WS_WKV); } \
        else if ((r -= I_KV) < 2 * I_NIN) { const int l = r / I_NIN; r -= l * I_NIN; d.W = IN_F(I_NSAWIN) + (size_t)l * D * N_NSAIN_REAL; d.Nsrc = N_NSAIN_REAL; d.K = D; nblk = N_NSAIN / 64; d.Nreal = N_NSAIN_REAL; d.kind = 0; d.scale = IN_F(I_NMIX) + (2 + l) * D; d.WT = (bf16_t*)(ws + WS_WNSAIN + l * SZ_WNSAIN); } \
        else { r -= 2 * I_NIN; const int l = r / I_SQ; r -= l * I_SQ; d.W = IN_F(I_NSAWOUT) + (size_t)l * D * D; d.Nsrc = D; d.K = D; nblk = 16; d.Nreal = D; d.kind = 0; d.scale = nullptr; d.WT = (bf16_t*)(ws + WS_WNSAOUT + l * SZ_WSQ); } \
        const int kb = r / nblk; d.k0 = kb * 64; d.n0 = (r - kb * nblk) * 64; } while (0)
    {
        f32x4 v[16], sc0, sc1; bool ok = true; TrDesc d;
        int it = gw;
        if (it < NITEMS) { P0_DESC(d, it); p0_tr_load(d, v, sc0, sc1, ok, lane); }
        while (it < NITEMS) {
            p0_tr_lds(v, ok, scr, lane);
            bf16_t* cWT = d.WT; const int cK = d.K, ck0 = d.k0, cn0 = d.n0; const f32x4 c0 = sc0, c1 = sc1;
            it += NGW;
            if (it < NITEMS) { P0_DESC(d, it); p0_tr_load(d, v, sc0, sc1, ok, lane); }
            LDS_WAIT();
            p0_tr_store(cWT, cK, ck0, cn0, c0, c1, scr, lane);
            LDS_WAIT();
        }
    }
    for (int m = gw; m < TT / 2; m += NGW) {
        const int m0 = m, m1 = m + TT / 2;
        const float* xr0 = IN_F(I_XP) + (size_t)m0 * D;
        const float* xr1 = m1 < TP ? IN_F(I_XP) + (size_t)m1 * D : IN_F(I_XS) + (size_t)(m1 - TP) * D;
        p0_row2(xr0, xr1, (bf16_t*)(ws + WS_XB) + (size_t)m0 * D, (bf16_t*)(ws + WS_XB) + (size_t)m1 * D, (float*)(ws + WS_STATS) + (size_t)m0 * 16, (float*)(ws + WS_STATS) + (size_t)m1 * 16, lane);
    }
    for (int i = blockIdx.x * NTHR + tid; i < 16 * BT_STRIDE; i += gridDim.x * NTHR) {
        const int h = i / BT_STRIDE, o = i - h * BT_STRIDE;
        ((float*)(ws + WS_BT))[i] = IN_F(I_RELB)[rel_bucket_dev(o - BT_OFF) * 16 + h];
    }
    for (int i = blockIdx.x * NTHR + tid; i < 512 * 512 * 4; i += gridDim.x * NTHR) {
        const int arr = i >> 18, rem = i & 262143, bk = rem >> 9, ch = rem & 511;
        bf16_t* base = arr == 0 ? (bf16_t*)(ws + WS_KSELS) + ((size_t)(bk * 33 + 32)) * 4096 : arr == 1 ? (bf16_t*)(ws + WS_VSELS) + ((size_t)(bk * 33 + 32)) * 4096
                     : arr == 2 ? (bf16_t*)(ws + WS_KWINS) + ((size_t)(bk * 9 + 8)) * 4096 : (bf16_t*)(ws + WS_VWINS) + ((size_t)(bk * 9 + 8)) * 4096;
        *(u32x4*)(base + ch * 8) = (u32x4){0u, 0u, 0u, 0u};
    }
}
DI void sample_conv_item(CArgs& A, int it, LAS unsigned char* lds, int tid) {
    unsigned char* ws = A.ws;
    LAS float* tile = (LAS float*)lds;
    LAS float* blkS = (LAS float*)(lds + 66560);
    const int* pt = (const int*)A.in[I_PT];
    if (it < 2048) {
        const int b = it >> 4, p = it & 15;
        const float* pg = IN_F(I_CACHE) + (size_t)pt[b * 16 + p] * 131072;
        const float* pg2 = p < 15 ? IN_F(I_CACHE) + (size_t)pt[b * 16 + p + 1] * 131072 : pg;
        conv_rows128(pg, 1024, 512, 768, (bf16_t*)(ws + WS_KSELS) + ((size_t)(b * 4) * 33 + 2 * p) * 4096, (bf16_t*)(ws + WS_VSELS) + ((size_t)(b * 4) * 33 + 2 * p) * 4096, 33, tile, tid, nullptr, 0);
        cmp_item(pg, pg2, 1024, p < 15 ? 9 : 8, IN_F(I_CMPPOSW), IN_F(I_WCMP), (bf16_t*)(ws + WS_CKS) + (size_t)b * 4 * 128 * 64, (bf16_t*)(ws + WS_CVS) + (size_t)b * 4 * 64 * 128, 128, 8 * p, blkS, tid);
    } else {
        const int r = it - 2048, b = r >> 2, q = r & 3;
        const float* src = IN_F(I_SWIN) + ((size_t)b * 512 + 128 * q) * 512;
        conv_rows128(src, 512, 0, 256, (bf16_t*)(ws + WS_KWINS) + ((size_t)(b * 4) * 9 + 2 * q) * 4096, (bf16_t*)(ws + WS_VWINS) + ((size_t)(b * 4) * 9 + 2 * q) * 4096, 9, tile, tid,
                     A.out + O_SW + (size_t)b * 512 * 512, 128 * q);
    }
}
DI void unpack8(const u32x4& u, float (&x)[8]) { x[0] = bflo(u.x); x[1] = bfhi(u.x); x[2] = bflo(u.y); x[3] = bfhi(u.y); x[4] = bflo(u.z); x[5] = bfhi(u.z); x[6] = bflo(u.w); x[7] = bfhi(u.w); }
DI void phase_d2(CArgs& A, int l, int wave, int lane) {
    unsigned char* ws = A.ws;
    const int gw = blockIdx.x * NWAVES + wave, NGW = gridDim.x * NWAVES;
    const bf16_t* qkvb = (const bf16_t*)(ws + WS_QKVB);
    const float* convw = IN_F(I_DNCONVW) + (size_t)l * 4 * 3072;
    for (int it = gw; it < (2048 + 128) * 6; it += NGW) {
        const int run = it / 6, chunk = it - run * 6;
        const bool prm = run < 2048;
        const int tok0 = prm ? 8 * run : TP + 4 * (run - 2048), len = prm ? 8 : 4;
        const int pos0 = tok0 & 4095, b = prm ? (tok0 >> 12) : (run - 2048);
        const int part = chunk >> 1, half = chunk & 1, col = part * 1024 + half * 512 + 8 * lane;
        u32x4 xt[8];
#pragma unroll
        for (int t = 0; t < 8; ++t) xt[t] = *(const u32x4*)(qkvb + (size_t)(tok0 + (t < len ? t : len - 1)) * 3072 + col);
        float w[4][8];
#pragma unroll
        for (int t = 0; t < 4; ++t) { const f32x4* p = (const f32x4*)(convw + t * 3072 + col); const f32x4 a = p[0], c = p[1]; w[t][0] = a.x; w[t][1] = a.y; w[t][2] = a.z; w[t][3] = a.w; w[t][4] = c.x; w[t][5] = c.y; w[t][6] = c.z; w[t][7] = c.w; }
        float x0[8], x1[8], x2[8];
        if (prm) {
            if (pos0 == 0) {
#pragma unroll
                for (int e = 0; e < 8; ++e) { x0[e] = 0.f; x1[e] = 0.f; x2[e] = 0.f; }
            } else {
                const u32x4 h0 = *(const u32x4*)(qkvb + (size_t)(tok0 - 3) * 3072 + col), h1 = *(const u32x4*)(qkvb + (size_t)(tok0 - 2) * 3072 + col), h2 = *(const u32x4*)(qkvb + (size_t)(tok0 - 1) * 3072 + col);
                unpack8(h0, x0); unpack8(h1, x1); unpack8(h2, x2);
            }
        } else {
            const float* st = IN_F(I_SDNC) + ((size_t)(l * 128 + b) * 3) * 3072 + col;
            const f32x4 a0 = *(const f32x4*)st, a1 = *(const f32x4*)(st + 4), b0 = *(const f32x4*)(st + 3072), b1 = *(const f32x4*)(st + 3072 + 4), c0 = *(const f32x4*)(st + 6144), c1 = *(const f32x4*)(st + 6144 + 4);
            x0[0] = a0.x; x0[1] = a0.y; x0[2] = a0.z; x0[3] = a0.w; x0[4] = a1.x; x0[5] = a1.y; x0[6] = a1.z; x0[7] = a1.w;
            x1[0] = b0.x; x1[1] = b0.y; x1[2] = b0.z; x1[3] = b0.w; x1[4] = b1.x; x1[5] = b1.y; x1[6] = b1.z; x1[7] = b1.w;
            x2[0] = c0.x; x2[1] = c0.y; x2[2] = c0.z; x2[3] = c0.w; x2[4] = c1.x; x2[5] = c1.y; x2[6] = c1.z; x2[7] = c1.w;
        }
        bf16_t* dst = (bf16_t*)(ws + (part == 0 ? WS_QN : part == 1 ? WS_KN : WS_VB));
#pragma unroll
        for (int t = 0; t < 8; ++t) {
            if (t < len) {
                float xc[8]; unpack8(xt[t], xc);
                if (prm) { if (pos0 + t >= 4093) { float* o = A.out + O_PC + ((size_t)(l * 4 + b) * 3 + (pos0 + t - 4093)) * 3072 + col;
                        *(f32x4*)o = (f32x4){xc[0], xc[1], xc[2], xc[3]}; *(f32x4*)(o + 4) = (f32x4){xc[4], xc[5], xc[6], xc[7]}; } }
                else if (t >= 1) { float* o = A.out + O_SC + ((size_t)(l * 128 + b) * 3 + (t - 1)) * 3072 + col;
                        *(f32x4*)o = (f32x4){xc[0], xc[1], xc[2], xc[3]}; *(f32x4*)(o + 4) = (f32x4){xc[4], xc[5], xc[6], xc[7]}; }
                float y[8]; float ss = 0.f;
#pragma unroll
                for (int e = 0; e < 8; ++e) { const float v = w[0][e] * x0[e] + w[1][e] * x1[e] + w[2][e] * x2[e] + w[3][e] * xc[e]; y[e] = siluf_(v); ss += y[e] * y[e]; }
                if (part < 2) {
                    ss = row16_sum(ss);
                    const float sc = rsqrtf(ss + EPS) * (part == 0 ? 0.08838834764831845f : 1.0f);
#pragma unroll
                    for (int e = 0; e < 8; ++e) y[e] *= sc;
                }
                u32x4 o; o.x = pk2(y[0], y[1]); o.y = pk2(y[2], y[3]); o.z = pk2(y[4], y[5]); o.w = pk2(y[6], y[7]);
                *(u32x4*)(dst + (size_t)(tok0 + t) * 1024 + half * 512 + 8 * lane) = o;
#pragma unroll
                for (int e = 0; e < 8; ++e) { x0[e] = x1[e]; x1[e] = x2[e]; x2[e] = xc[e]; }
            }
        }
        if (chunk == 0 && lane < 8) {
            const float al = __expf(IN_F(I_DNALOG)[l * 8 + lane]), dtb = IN_F(I_DNDTB)[l * 8 + lane];
            for (int t = 0; t < len; ++t) {
                const float* ab = (const float*)(ws + WS_AB) + (size_t)(tok0 + t) * 16;
                const float xa = ab[lane] + dtb, xb = ab[8 + lane];
                const float sp = fmaxf(xa, 0.f) + log1pf(__expf(-fabsf(xa)));
                ((float*)(ws + WS_GG))[(size_t)(tok0 + t) * 8 + lane] = -al * sp;
                ((float*)(ws + WS_BETA))[(size_t)(tok0 + t) * 8 + lane] = sigmoidf_(xb);
            }
        }
    }
}
DI void phase_d3(CArgs& A, LAS unsigned char* lds, int wave, int lane) {
    unsigned char* ws = A.ws;
    const int gw = blockIdx.x * NWAVES + wave, NGW = gridDim.x * NWAVES;
    const int fr = lane & 15, fq = lane >> 4;
    LAS float* As = (LAS float*)(lds + wave * 16384);
    LAS bf16_t* Tp = (LAS bf16_t*)(lds + wave * 16384);
    LAS float* sc = (LAS float*)(lds + LDS_MISC + wave * 1024);
    bf16x8 I0, I1;
#pragma unroll
    for (int jj = 0; jj < 8; ++jj) { I0[jj] = (8 * fq + jj == fr) ? (short)0x3F80 : (short)0; I1[jj] = (8 * fq + jj == 16 + fr) ? (short)0x3F80 : (short)0; }
    const f32x4 zero4 = {0.f, 0.f, 0.f, 0.f};
    for (int idx = gw; idx < 2048; idx += NGW) {
        const int b = idx >> 9, n = (idx >> 3) & 63, h = idx & 7, tok0 = b * 4096 + 64 * n;
        unsigned char* pack = ws + WS_PACK + (size_t)idx * PK_SIZE;
        float G = ((const float*)(ws + WS_GG))[(size_t)(tok0 + lane) * 8 + h];
        const float bt = ((const float*)(ws + WS_BETA))[(size_t)(tok0 + lane) * 8 + h];
#pragma unroll
        for (int o = 1; o < 64; o <<= 1) { const float t = __shfl_up(G, o); if (lane >= o) G += t; }
        const float Glast = __shfl(G, 63), eG = __expf(G), kd = __expf(Glast - G);
        sc[lane] = G; sc[64 + lane] = bt; sc[128 + lane] = eG; sc[192 + lane] = kd;
        ((float*)(ws + WS_EG))[(size_t)idx * 64 + lane] = eG;
        if (lane == 0) ((float*)(ws + WS_GL))[idx] = __expf(Glast);
        LDS_WAIT();
        bf16x8 Kf[4][4], Qf[4][4];
#pragma unroll
        for (int t = 0; t < 4; ++t)
#pragma unroll
            for (int ks = 0; ks < 4; ++ks) {
                const size_t off = (size_t)(tok0 + 16 * t + fr) * 1024 + h * 128 + 32 * ks + 8 * fq;
                Kf[t][ks] = *(const bf16x8*)((const bf16_t*)(ws + WS_KN) + off);
                Qf[t][ks] = *(const bf16x8*)((const bf16_t*)(ws + WS_QN) + off);
            }
#pragma unroll
        for (int it = 0; it < 4; ++it)
#pragma unroll
            for (int ks = 0; ks < 4; ++ks) {
                const f32x4 c0 = MFMA16(I0, Qf[it][ks], zero4), c1 = MFMA16(I1, Qf[it][ks], zero4);
                *(bf16x8*)(pack + PK_QF + ((size_t)((it * 4 + ks) * 64 + lane)) * 16) = pack8(c0, c1);
            }
#pragma unroll
        for (int it = 0; it < 4; ++it) {
            const float Gi = sc[16 * it + fr];
#pragma unroll
            for (int ks2 = 0; ks2 < 2; ++ks2) {
                f32x4 tl[2];
#pragma unroll
                for (int hh = 0; hh < 2; ++hh) {
                    const int jt = 2 * ks2 + hh;
                    f32x4 c = zero4;
                    if (jt <= it) {
#pragma unroll
                        for (int ks = 0; ks < 4; ++ks) c = MFMA16(Kf[jt][ks], Qf[it][ks], c);
#pragma unroll
                        for (int r = 0; r < 4; ++r) { const int j = 16 * jt + 4 * fq + r, i = 16 * it + fr; const float dc = __expf(Gi - sc[j]); c[r] = (i >= j) ? dc * c[r] : 0.f; }
                    }
                    tl[hh] = c;
                }
                *(bf16x8*)(pack + PK_AQK + ((size_t)((it * 2 + ks2) * 64 + lane)) * 16) = pack8(tl[0], tl[1]);
            }
        }
#pragma unroll
        for (int it = 0; it < 4; ++it)
#pragma unroll
            for (int jt = 0; jt < 4; ++jt) {
                if (jt <= it) {
                    f32x4 c = zero4;
#pragma unroll
                    for (int ks = 0; ks < 4; ++ks) c = MFMA16(Kf[it][ks], Kf[jt][ks], c);
                    const float Gj = sc[16 * jt + fr];
#pragma unroll
                    for (int r = 0; r < 4; ++r) { const int i = 16 * it + 4 * fq + r, j = 16 * jt + fr; const float v = sc[64 + i] * __expf(sc[i] - Gj) * c[r]; As[i * 64 + j] = (i > j) ? v : 0.f; }
                }
            }
        LDS_WAIT();
        asm volatile("" ::: "memory");
        float t[64];
        int lane_o = lane; asm volatile("" : "+v"(lane_o));
        float arow_nx = As[lane];
#pragma unroll
        for (int i = 0; i < 64; ++i) {
            const float arow = arow_nx;
            if (i < 63) arow_nx = As[(i + 1) * 64 + lane];
            asm volatile("" ::: "memory");
            float a0 = (lane_o == i) ? 1.f : 0.f, a1 = 0.f, a2 = 0.f, a3 = 0.f;
#pragma unroll
            for (int j = 0; j < i; ++j) {
                const float s = __builtin_bit_cast(float, __builtin_amdgcn_readlane(__builtin_bit_cast(int, arow), j));
                if ((j & 3) == 0) a0 -= s * t[j]; else if ((j & 3) == 1) a1 -= s * t[j]; else if ((j & 3) == 2) a2 -= s * t[j]; else a3 -= s * t[j];
            }
            t[i] = (a0 + a1) + (a2 + a3);
        }
        { const float bcol = sc[64 + lane];
#pragma unroll
          for (int i = 0; i < 64; ++i) Tp[i * 64 + lane] = f2bf(t[i] * bcol); }
        LDS_WAIT();
        bf16x8 Tf[4][2];
#pragma unroll
        for (int it = 0; it < 4; ++it)
#pragma unroll
            for (int ks2 = 0; ks2 < 2; ++ks2) {
                const LAS bf16_t* rp = Tp + (16 * it + fr) * 64 + 32 * ks2 + 4 * fq;
                const u32x2 lo = *(const LAS u32x2*)rp, hi = *(const LAS u32x2*)(rp + 16);
                u32x4 v; v.x = lo.x; v.y = lo.y; v.z = hi.x; v.w = hi.y; Tf[it][ks2] = __builtin_bit_cast(bf16x8, v);
            }
        asm volatile("" ::: "memory");
        bf16x8 Kg[4][4];
#pragma unroll
        for (int t2 = 0; t2 < 4; ++t2)
#pragma unroll
            for (int ks = 0; ks < 4; ++ks)
                Kg[t2][ks] = *(const bf16x8*)((const bf16_t*)(ws + WS_KN) + (size_t)(tok0 + 16 * t2 + fr) * 1024 + h * 128 + 32 * ks + 8 * fq);
#pragma unroll
        for (int ks = 0; ks < 4; ++ks) {
            bf16x8 R2f[2][2];
#pragma unroll
            for (int hh = 0; hh < 2; ++hh) {
                const int dkt = 2 * ks + hh;
#pragma unroll
                for (int ks2 = 0; ks2 < 2; ++ks2) {
                    f32x4 r2[2], r3[2];
#pragma unroll
                    for (int g = 0; g < 2; ++g) {
                        const int jt = 2 * ks2 + g;
                        const f32x4 kc = MFMA16(Kg[jt][ks], hh ? I1 : I0, zero4);
#pragma unroll
                        for (int r = 0; r < 4; ++r) { const int j = 16 * jt + 4 * fq + r; r2[g][r] = kc[r] * sc[128 + j]; r3[g][r] = kc[r] * sc[192 + j]; }
                    }
                    R2f[hh][ks2] = pack8(r2[0], r2[1]);
                    *(bf16x8*)(pack + PK_KDF + ((size_t)((dkt * 2 + ks2) * 64 + lane)) * 16) = pack8(r3[0], r3[1]);
                }
            }
#pragma unroll
            for (int it = 0; it < 4; ++it) {
                f32x4 c0 = zero4, c1 = zero4;
#pragma unroll
                for (int ks2 = 0; ks2 < 2; ++ks2) { c0 = MFMA16(R2f[0][ks2], Tf[it][ks2], c0); c1 = MFMA16(R2f[1][ks2], Tf[it][ks2], c1); }
                *(bf16x8*)(pack + PK_WKF + ((size_t)((it * 4 + ks) * 64 + lane)) * 16) = pack8(-c0, -c1);
            }
        }
        asm volatile("" ::: "memory");
        bf16x8 Vf[4][4];
#pragma unroll
        for (int t2 = 0; t2 < 4; ++t2)
#pragma unroll
            for (int ks = 0; ks < 4; ++ks)
                Vf[t2][ks] = *(const bf16x8*)((const bf16_t*)(ws + WS_VB) + (size_t)(tok0 + 16 * t2 + fr) * 1024 + h * 128 + 32 * ks + 8 * fq);
#pragma unroll
        for (int dvt = 0; dvt < 8; ++dvt) {
            bf16x8 R1f[2];
#pragma unroll
            for (int ks2 = 0; ks2 < 2; ++ks2) {
                const f32x4 v0 = MFMA16(Vf[2 * ks2][dvt >> 1], (dvt & 1) ? I1 : I0, zero4), v1 = MFMA16(Vf[2 * ks2 + 1][dvt >> 1], (dvt & 1) ? I1 : I0, zero4);
                R1f[ks2] = pack8(v0, v1);
            }
#pragma unroll
            for (int it = 0; it < 4; ++it) {
                f32x4 c = zero4;
#pragma unroll
                for (int ks2 = 0; ks2 < 2; ++ks2) c = MFMA16(Tf[it][ks2], R1f[ks2], c);
                u32x2 w; w.x = pk2(c.x, c.y); w.y = pk2(c.z, c.w);
                *(u32x2*)(pack + PK_WVC + ((size_t)((it * 8 + dvt) * 64 + lane)) * 8) = w;
            }
        }
        LDS_WAIT();
    }
}
constexpr int NSA2_EARLY = 116;
constexpr int SCAN_SPLIT = 1, SCAN_BLOCKS = 32 * SCAN_SPLIT, SCAN_STAGE = 57344;
#define SCAN_PIN(A_) asm volatile("" : "+v"(A_[0]), "+v"(A_[1]), "+v"(A_[2]), "+v"(A_[3]), "+v"(A_[4]), "+v"(A_[5]), "+v"(A_[6]), "+v"(A_[7]))
DI void scan_compute(const LAS unsigned char* cur, f32x4 (&U)[4], const float (&eg)[4], float gl, f32x4 (&S)[8], bf16_t* obp, int lane) {
    const LAS unsigned char* base = cur + lane * 16;
#define SCAN_LD(off_) (*(const LAS bf16x8*)(base + (off_)))
    bf16x8 A0[8], A1[8];
#pragma unroll
    for (int i = 0; i < 8; ++i) A0[i] = SCAN_LD(PK_WKF + i * 1024);
#pragma unroll
    for (int i = 0; i < 8; ++i) A1[i] = SCAN_LD(PK_WKF + (8 + i) * 1024);
    bf16x8 Sb[4];
#pragma unroll
    for (int ks = 0; ks < 4; ++ks) Sb[ks] = pack8(S[2 * ks], S[2 * ks + 1]);
    SCAN_PIN(A0);
#pragma unroll
    for (int ks = 0; ks < 4; ++ks) { U[0] = MFMA16(A0[ks], Sb[ks], U[0]); U[1] = MFMA16(A0[4 + ks], Sb[ks], U[1]); }
#pragma unroll
    for (int i = 0; i < 8; ++i) A0[i] = SCAN_LD(PK_QF + i * 1024);
    SCAN_PIN(A1);
#pragma unroll
    for (int ks = 0; ks < 4; ++ks) { U[2] = MFMA16(A1[ks], Sb[ks], U[2]); U[3] = MFMA16(A1[4 + ks], Sb[ks], U[3]); }
#pragma unroll
    for (int i = 0; i < 8; ++i) A1[i] = SCAN_LD(PK_QF + (8 + i) * 1024);
    bf16x8 Ub[2];
    Ub[0] = pack8(U[0], U[1]); Ub[1] = pack8(U[2], U[3]);
    f32x4 O[4];
#pragma unroll
    for (int it = 0; it < 4; ++it) O[it] = (f32x4){0.f, 0.f, 0.f, 0.f};
    SCAN_PIN(A0);
#pragma unroll
    for (int ks = 0; ks < 4; ++ks) { O[0] = MFMA16(Sb[ks], A0[ks], O[0]); O[1] = MFMA16(Sb[ks], A0[4 + ks], O[1]); }
#pragma unroll
    for (int i = 0; i < 8; ++i) A0[i] = SCAN_LD(PK_AQK + i * 1024);
    SCAN_PIN(A1);
#pragma unroll
    for (int ks = 0; ks < 4; ++ks) { O[2] = MFMA16(Sb[ks], A1[ks], O[2]); O[3] = MFMA16(Sb[ks], A1[4 + ks], O[3]); }
#pragma unroll
    for (int i = 0; i < 8; ++i) A1[i] = SCAN_LD(PK_KDF + i * 1024);
#pragma unroll
    for (int it = 0; it < 4; ++it) O[it] = O[it] * eg[it];
    SCAN_PIN(A0);
#pragma unroll
    for (int it = 0; it < 4; ++it) { O[it] = MFMA16(Ub[0], A0[2 * it], O[it]); O[it] = MFMA16(Ub[1], A0[2 * it + 1], O[it]); }
#pragma unroll
    for (int i = 0; i < 8; ++i) A0[i] = SCAN_LD(PK_KDF + (8 + i) * 1024);
#pragma unroll
    for (int it = 0; it < 4; ++it) { u32x2 o; o.x = pk2(O[it].x, O[it].y); o.y = pk2(O[it].z, O[it].w); *(u32x2*)(obp + (size_t)(16 * it) * 1024) = o; }
    SCAN_PIN(A1);
#pragma unroll
    for (int dkt = 0; dkt < 4; ++dkt) { f32x4 c = S[dkt] * gl; c = MFMA16(A1[2 * dkt], Ub[0], c); c = MFMA16(A1[2 * dkt + 1], Ub[1], c); S[dkt] = c; }
    SCAN_PIN(A0);
#pragma unroll
    for (int dkt = 0; dkt < 4; ++dkt) { f32x4 c = S[4 + dkt] * gl; c = MFMA16(A0[2 * dkt], Ub[0], c); c = MFMA16(A0[2 * dkt + 1], Ub[1], c); S[4 + dkt] = c; }
#undef SCAN_LD
}
#define SCAN_LOAD(X, nn) { const int idx_ = idx0 + (nn) * 8; const unsigned char* pk_ = ws + WS_PACK + (size_t)idx_ * PK_SIZE; \
    _Pragma("unroll") for (int i = 0; i < 7; ++i) pf##X[i] = *(const u32x4*)(pk_ + tid * 16 + i * 8192); \
    _Pragma("unroll") for (int it = 0; it < 4; ++it) wv##X[it] = *(const u32x2*)(pk_ + PK_WVC + ((size_t)((it * 8 + w) * 64 + lane)) * 8); \
    ex##X = tid < 64 ? EGp[(size_t)idx_ * 64 + tid] : GLp[idx_]; }
#define SCAN_STEP(n_, X, Y) { const int n = (n_); \
    const LAS unsigned char* cur = lds + (n & 1) * SCAN_STAGE; LAS unsigned char* nxt = lds + ((n + 1) & 1) * SCAN_STAGE; \
    f32x4 U[4]; float eg[4]; \
    const LAS float* exc = (const LAS float*)(lds + 2 * SCAN_STAGE + (n & 1) * 512); \
    _Pragma("unroll") for (int it = 0; it < 4; ++it) { U[it] = (f32x4){bflo(wv##X[it].x), bfhi(wv##X[it].x), bflo(wv##X[it].y), bfhi(wv##X[it].y)}; eg[it] = exc[16 * it + fr]; } \
    const float gl = exc[64]; \
    SCAN_LOAD(X, (n + 2 < 64 ? n + 2 : 63))             \
    if (comp) scan_compute(cur, U, eg, gl, S, ob + (size_t)(b * 4096 + 64 * n + fr) * 1024 + h * 128 + 16 * w + 4 * fq, lane); \
    { _Pragma("unroll") for (int i = 0; i < 7; ++i) *(LAS u32x4*)(nxt + tid * 16 + i * 8192) = pf##Y[i]; \
      if (tid <= 64) *(LAS float*)(lds + 2 * SCAN_STAGE + ((n + 1) & 1) * 512 + tid * 4) = ex##Y; } \
    asm volatile("s_waitcnt lgkmcnt(0)" ::: "memory"); __builtin_amdgcn_s_barrier(); asm volatile("" ::: "memory"); }
DI void d4_scan_prompt(CArgs& A, int l, int blk, LAS unsigned char* lds, int tid, int wave, int lane) {
    unsigned char* ws = A.ws;
    const int bh = blk / SCAN_SPLIT, half = blk % SCAN_SPLIT;
    const int b = bh >> 3, h = bh & 7, fr = lane & 15, fq = lane >> 4;
    const bool comp = SCAN_SPLIT == 1 ? true : wave < 8 / SCAN_SPLIT;
    const int w = half * (8 / SCAN_SPLIT) + (comp ? wave : 0);
    f32x4 S[8];
#pragma unroll
    for (int i = 0; i < 8; ++i) S[i] = (f32x4){0.f, 0.f, 0.f, 0.f};
    const float* EGp = (const float*)(ws + WS_EG);
    const float* GLp = (const float*)(ws + WS_GL);
    bf16_t* ob = (bf16_t*)(ws + WS_OB);
    const int idx0 = (b * 64) * 8 + h;
    u32x4 pfA[7], pfB[7];
    u32x2 wvA[4], wvB[4]; float exA, exB;
    SCAN_LOAD(A, 0)
    SCAN_LOAD(B, 1)
#pragma unroll
    for (int i = 0; i < 7; ++i) *(LAS u32x4*)(lds + tid * 16 + i * 8192) = pfA[i];
    if (tid <= 64) *(LAS float*)(lds + 2 * SCAN_STAGE + tid * 4) = exA;
    __syncthreads();
#pragma unroll 1
    for (int n2 = 0; n2 < 64; n2 += 2) {
        SCAN_STEP(n2, A, B)
        SCAN_STEP(n2 + 1, B, A)
    }
    if (comp) {
        float* so = A.out + O_PS + ((size_t)((l * 4 + b) * 8 + h)) * 16384;
#pragma unroll
        for (int dkt = 0; dkt < 8; ++dkt)
#pragma unroll
            for (int r = 0; r < 4; ++r) so[(size_t)(16 * dkt + 4 * fq + r) * 128 + 16 * w + fr] = S[dkt][r];
    }
}
DI void d4_sample_item(CArgs& A, int l, int item, LAS float* L, int tid, int wave, int lane) {
    unsigned char* ws = A.ws;
    const int b = item >> 3, h = item & 7, tok0 = TP + 4 * b;
    LAS float* sq = L;
    LAS float* sk = L + 512;
    LAS float* sv = L + 1024;
    LAS float* sgb = L + 1536;
    LAS float* dots = L + 1544;
    LAS float* red = L + 1600;
    const int dv = tid & 127, dkq = tid >> 7;
    for (int i2 = tid; i2 < 1536; i2 += NTHR) {
        const int part = i2 >> 9, i = (i2 >> 7) & 3, d = i2 & 127;
        const bf16_t* src = (const bf16_t*)(ws + (part == 0 ? WS_QN : part == 1 ? WS_KN : WS_VB));
        L[i2] = bf2f(src[(size_t)(tok0 + i) * 1024 + h * 128 + d]);
    }
    if (tid < 4) { sgb[tid] = ((const float*)(ws + WS_GG))[(size_t)(tok0 + tid) * 8 + h]; sgb[4 + tid] = ((const float*)(ws + WS_BETA))[(size_t)(tok0 + tid) * 8 + h]; }
    const float* S0 = IN_F(I_SDNS) + ((size_t)((l * 128 + b) * 8 + h)) * 16384;
    float s0[32];
#pragma unroll
    for (int u = 0; u < 32; ++u) s0[u] = S0[(size_t)(32 * dkq + u) * 128 + dv];
    __syncthreads();
#pragma unroll
    for (int u = 0; u < 4; ++u) {
        const int p = 4 * wave + u, i = (p >> 2) & 3, j = p & 3;
        const LAS float* a = (p < 16) ? sk + i * 128 : sq + i * 128;
        float s = a[lane] * sk[j * 128 + lane] + a[lane + 64] * sk[j * 128 + lane + 64];
        s = wave_sum(s);
        if (lane == 0) dots[p] = s;
    }
    __syncthreads();
    float G[4], bt[4], eG[4];
    { float acc = 0.f;
#pragma unroll
      for (int i = 0; i < 4; ++i) { acc += sgb[i]; G[i] = acc; bt[i] = sgb[4 + i]; eG[i] = __expf(acc); } }
    float Am[4][4], T[4][4];
#pragma unroll
    for (int i = 0; i < 4; ++i)
#pragma unroll
        for (int j = 0; j < 4; ++j) { Am[i][j] = (i > j) ? bt[i] * __expf(G[i] - G[j]) * dots[i * 4 + j] : 0.f; T[i][j] = (i == j) ? 1.f : 0.f; }
#pragma unroll
    for (int i = 1; i < 4; ++i)
#pragma unroll
        for (int c = 0; c < i; ++c) { float acc = 0.f;
#pragma unroll
            for (int j = c; j < i; ++j) acc -= Am[i][j] * T[j][c];
            T[i][c] = acc; }
    float pU[4] = {0.f, 0.f, 0.f, 0.f}, pQ[4] = {0.f, 0.f, 0.f, 0.f};
#pragma unroll 4
    for (int u = 0; u < 32; ++u) {
        const int dk = 32 * dkq + u;
        float kj[4], qj[4];
#pragma unroll
        for (int j = 0; j < 4; ++j) { kj[j] = sk[j * 128 + dk]; qj[j] = sq[j * 128 + dk]; }
#pragma unroll
        for (int i = 0; i < 4; ++i) {
            float wk = 0.f;
#pragma unroll
            for (int j = 0; j <= i; ++j) wk += T[i][j] * bt[j] * eG[j] * kj[j];
            pU[i] += wk * s0[u]; pQ[i] += qj[i] * s0[u];
        }
    }
#pragma unroll
    for (int i = 0; i < 4; ++i) { red[(i * 4 + dkq) * 128 + dv] = pU[i]; red[((4 + i) * 4 + dkq) * 128 + dv] = pQ[i]; }
    __syncthreads();
    float U[4];
#pragma unroll
    for (int i = 0; i < 4; ++i) {
        float wv = 0.f;
#pragma unroll
        for (int j = 0; j <= i; ++j) wv += T[i][j] * bt[j] * sv[j * 128 + dv];
        U[i] = wv - ((red[(i * 4 + 0) * 128 + dv] + red[(i * 4 + 1) * 128 + dv]) + (red[(i * 4 + 2) * 128 + dv] + red[(i * 4 + 3) * 128 + dv]));
    }
    if (dkq == 0) {
#pragma unroll
        for (int i = 0; i < 4; ++i) {
            float o = eG[i] * ((red[((4 + i) * 4 + 0) * 128 + dv] + red[((4 + i) * 4 + 1) * 128 + dv]) + (red[((4 + i) * 4 + 2) * 128 + dv] + red[((4 + i) * 4 + 3) * 128 + dv]));
#pragma unroll
            for (int j = 0; j <= i; ++j) o += __expf(G[i] - G[j]) * dots[16 + i * 4 + j] * U[j];
            ((bf16_t*)(ws + WS_OB))[(size_t)(tok0 + i) * 1024 + h * 128 + dv] = f2bf(o);
        }
    }
    const float gl = eG[3];
    float* So = A.out + O_SS + ((size_t)((l * 128 + b) * 8 + h)) * 16384;
#pragma unroll 4
    for (int u = 0; u < 32; ++u) {
        const int dk = 32 * dkq + u;
        float acc = gl * s0[u];
#pragma unroll
        for (int i = 0; i < 4; ++i) acc += __expf(G[3] - G[i]) * sk[i * 128 + dk] * U[i];
        So[(size_t)dk * 128 + dv] = acc;
    }
    __syncthreads();
}
DI void phase_d4(CArgs& A, int l, LAS unsigned char* lds, int tid, int wave, int lane) {
    if (blockIdx.x < SCAN_BLOCKS) { if (!(A.dup_mask >> 31)) d4_scan_prompt(A, l, blockIdx.x, lds, tid, wave, lane); }
    else if (!((A.dup_mask >> 30) & 1u)) {
        for (int it = blockIdx.x - SCAN_BLOCKS; it < 1024; it += gridDim.x - SCAN_BLOCKS) d4_sample_item(A, l, it, (LAS float*)lds, tid, wave, lane);
        for (int it = l * 1280 + (blockIdx.x - SCAN_BLOCKS); it < (l + 1) * 1280; it += gridDim.x - SCAN_BLOCKS) sample_conv_item(A, it, lds, tid);
    }
}
DI void phase_d5(CArgs& A, int l, int wave, int lane) {
    unsigned char* ws = A.ws;
    const int gw = blockIdx.x * NWAVES + wave, NGW = gridDim.x * NWAVES;
    const float* onw = IN_F(I_DNONORM) + l * 128;
    float wn[8];
#pragma unroll
    for (int e = 0; e < 8; ++e) wn[e] = onw[(8 * lane + e) & 127];
    for (int tok0 = gw; tok0 < TT / 2; tok0 += NGW) {
        u32x4 ro[4], rz[4];
#pragma unroll
        for (int q = 0; q < 4; ++q) {
            const size_t off = (size_t)(tok0 + (q >> 1) * (TT / 2)) * 1024 + (q & 1) * 512 + 8 * lane;
            ro[q] = *(const u32x4*)((const bf16_t*)(ws + WS_OB) + off); rz[q] = *(const u32x4*)((const bf16_t*)(ws + WS_ZB) + off);
        }
#pragma unroll
        for (int q = 0; q < 4; ++q) {
            const size_t off = (size_t)(tok0 + (q >> 1) * (TT / 2)) * 1024 + (q & 1) * 512 + 8 * lane;
            float o[8], z[8];
            unpack8(ro[q], o); unpack8(rz[q], z);
            float ss = 0.f;
#pragma unroll
            for (int e = 0; e < 8; ++e) ss += o[e] * o[e];
            ss = row16_sum(ss);
            const float r = rsqrtf(ss * (1.0f / 128.0f) + EPS);
            float y[8];
#pragma unroll
            for (int e = 0; e < 8; ++e) y[e] = o[e] * r * wn[e] * siluf_(z[e]);
            u32x4 w; w.x = pk2(y[0], y[1]); w.y = pk2(y[2], y[3]); w.z = pk2(y[4], y[5]); w.w = pk2(y[6], y[7]);
            *(u32x4*)((bf16_t*)(ws + WS_OB) + off) = w;
        }
    }
}
DI void phase_n1(CArgs& A, LAS unsigned char* lds, int tid, int rank, int nranks) {
    unsigned char* ws = A.ws;
    LAS float* blkS = (LAS float*)lds;
    if (nranks < 1) { rank = blockIdx.x; nranks = gridDim.x; }
    if (rank < 0) return;
    for (int it = rank; it < 128; it += nranks) {
        const int b = it >> 5, g = it & 31;
        const float* src = A.out + O_PKV + ((size_t)b * 4096 + 128 * g) * 1024;
        cmp_item(src, src + 128 * 1024, 1024, g < 31 ? 9 : 8, IN_F(I_CMPPOSW), IN_F(I_WCMP), (bf16_t*)(ws + WS_CKP) + (size_t)b * 4 * 256 * 64, (bf16_t*)(ws + WS_CVP) + (size_t)b * 4 * 64 * 256, 256, 8 * g, blkS, tid);
    }
}
struct AttnState { float m, l; f32x4 o[4]; };
template <int MODE>
DI void attend_block(const bf16_t* Kb, const bf16_t* Vb, const bf16x8 (&Qf)[2], int dist0, bool colsel, bool far, float biasfar, const LAS float* bp, AttnState& st, int fr, int fq) {
    f32x4 s[4];
    bf16x8 Kf[4][2], Vf[4][2];
#pragma unroll
    for (int kt = 0; kt < 4; ++kt) { const bf16_t* kp = Kb + (16 * kt + fr) * 64 + 8 * fq; Kf[kt][0] = *(const bf16x8*)kp; Kf[kt][1] = *(const bf16x8*)(kp + 32); }
#pragma unroll
    for (int dt = 0; dt < 4; ++dt) { const bf16_t* vp = Vb + (16 * dt + fr) * 64 + 8 * fq; Vf[dt][0] = *(const bf16x8*)vp; Vf[dt][1] = *(const bf16x8*)(vp + 32); }
    asm volatile("" : "+v"(Vf[0][0]), "+v"(Vf[0][1]), "+v"(Vf[1][0]), "+v"(Vf[1][1]), "+v"(Vf[2][0]), "+v"(Vf[2][1]), "+v"(Vf[3][0]), "+v"(Vf[3][1]));
#pragma unroll
    for (int kt = 0; kt < 4; ++kt) {
        f32x4 z = {0.f, 0.f, 0.f, 0.f};
        z = MFMA16(Kf[kt][0], Qf[0], z); z = MFMA16(Kf[kt][1], Qf[1], z);
        s[kt] = z;
    }
    float bm = -1e30f;
    float bv[4][4];
    {
        const LAS float* bq = far ? bp - (dist0 - 1024) : bp;
#pragma unroll
        for (int kt = 0; kt < 4; ++kt)
#pragma unroll
            for (int r = 0; r < 4; ++r) bv[kt][r] = bq[-(16 * kt + r)];
        asm volatile("" : "+v"(bv[0][0]), "+v"(bv[0][1]), "+v"(bv[0][2]), "+v"(bv[0][3]), "+v"(bv[1][0]), "+v"(bv[1][1]), "+v"(bv[1][2]), "+v"(bv[1][3]),
                          "+v"(bv[2][0]), "+v"(bv[2][1]), "+v"(bv[2][2]), "+v"(bv[2][3]), "+v"(bv[3][0]), "+v"(bv[3][1]), "+v"(bv[3][2]), "+v"(bv[3][3]));
    }
#pragma unroll
    for (int kt = 0; kt < 4; ++kt)
#pragma unroll
        for (int r = 0; r < 4; ++r) {
            const int dist = dist0 - 16 * kt - r;
            const bool valid = (MODE == 0) ? (colsel && dist >= 0) : (dist >= 0 && dist < 512);
            const float bias = far ? biasfar : bv[kt][r];
            const float v = valid ? s[kt][r] + bias : -1e30f;
            s[kt][r] = v; bm = fmaxf(bm, v);
        }
    bm = rows_max(bm);
    const float mn = fmaxf(st.m, bm), alpha = __expf(st.m - mn);
    st.m = mn;
    float ps = 0.f;
#pragma unroll
    for (int kt = 0; kt < 4; ++kt)
#pragma unroll
        for (int r = 0; r < 4; ++r) { const float p = (s[kt][r] > -1e29f) ? __expf(s[kt][r] - mn) : 0.f; s[kt][r] = p; ps += p; }
    st.l = st.l * alpha + ps;
    bf16x8 Pf[2]; Pf[0] = pack8(s[0], s[1]); Pf[1] = pack8(s[2], s[3]);
#pragma unroll
    for (int dt = 0; dt < 4; ++dt) {
        f32x4 c = st.o[dt] * alpha;
        c = MFMA16(Vf[dt][0], Pf[0], c); c = MFMA16(Vf[dt][1], Pf[1], c);
        st.o[dt] = c;
    }
}
template <bool LSRC>
DI void cmp_branch(const bf16_t* CK, const bf16_t* CV, const LAS unsigned char* CKL, const LAS unsigned char* CVL, int cvpitch, int NK, int nblk, const bf16x8 (&Qf)[2], int qpos, int qpos0, float g_cmp, const LAS float* bth, LAS float* scoreL, int lane,
                   f32x4 (&OUT)[4], unsigned long long (&msel)[4]) {
    const int fr = lane & 15, fq = lane >> 4, qa = fr >> 2, hh = fr & 3, qmax = qpos0 + 3;
    const int ncv = qmax >= 31 ? ((qmax - 31) >> 4) + 1 : 0;
    const int ntile = (ncv + 15) >> 4;
    f32x4 lg[16];
#pragma unroll
    for (int kt = 0; kt < 16; ++kt) {
        if (kt < ntile) {
            f32x4 z = {0.f, 0.f, 0.f, 0.f};
            if (LSRC) { const int row = 16 * kt + fr; const LAS unsigned char* kp = CKL + row * 128;
                z = MFMA16(*(const LAS bf16x8*)(kp + ((fq ^ (row & 7)) << 4)), Qf[0], z); z = MFMA16(*(const LAS bf16x8*)(kp + (((fq + 4) ^ (row & 7)) << 4)), Qf[1], z); }
            else { const bf16_t* kp = CK + (size_t)(16 * kt + fr) * 64 + 8 * fq;
                z = MFMA16(*(const bf16x8*)kp, Qf[0], z); z = MFMA16(*(const bf16x8*)(kp + 32), Qf[1], z); }
            {
                const int dist0 = qpos - (16 * (16 * kt + 4 * fq) + 31);
                float bv[4];
#pragma unroll
                for (int r = 0; r < 4; ++r) { int di = dist0 - 16 * r; di = di < -BT_OFF ? -BT_OFF : di; di = di > 1100 ? 1100 : di; bv[r] = bth[di]; }
                asm volatile("" : "+v"(bv[0]), "+v"(bv[1]), "+v"(bv[2]), "+v"(bv[3]));
#pragma unroll
                for (int r = 0; r < 4; ++r) z[r] = (dist0 - 16 * r >= 0) ? z[r] + bv[r] : -1e30f;
            }
            lg[kt] = z;
        } else lg[kt] = (f32x4){-1e30f, -1e30f, -1e30f, -1e30f};
    }
    float mx = -1e30f;
#pragma unroll
    for (int kt = 0; kt < 16; ++kt) mx = fmaxf(fmaxf(fmaxf(mx, lg[kt][0]), fmaxf(lg[kt][1], lg[kt][2])), lg[kt][3]);
    mx = rows_max(mx);
    float sm = 0.f;
#pragma unroll
    for (int kt = 0; kt < 16; ++kt)
#pragma unroll
        for (int r = 0; r < 4; ++r) { const float p = lg[kt][r] > -1e29f ? __expf(lg[kt][r] - mx) : 0.f; lg[kt][r] = p; sm += p; }
    sm = rows_sum(sm);
    const float inv = __builtin_amdgcn_rcpf(fmaxf(sm, 1e-30f));
#pragma unroll
    for (int kt = 0; kt < 16; ++kt) lg[kt] = lg[kt] * inv;
#pragma unroll
    for (int dt = 0; dt < 4; ++dt) OUT[dt] = (f32x4){0.f, 0.f, 0.f, 0.f};
#pragma unroll
    for (int s2 = 0; s2 < 8; ++s2) {
        if (2 * s2 < ntile) {
            const bf16x8 Pf = pack8(lg[2 * s2], lg[2 * s2 + 1]);
#pragma unroll
            for (int dt = 0; dt < 4; ++dt) {
                if (LSRC) { const int row = 16 * dt + fr; OUT[dt] = MFMA16(*(const LAS bf16x8*)(CVL + row * cvpitch + (((4 * s2 + fq) ^ (row & 7)) << 4)), Pf, OUT[dt]); }
                else OUT[dt] = MFMA16(*(const bf16x8*)(CV + (size_t)(16 * dt + fr) * NK + 32 * s2 + 8 * fq), Pf, OUT[dt]);
            }
        }
    }
#pragma unroll
    for (int dt = 0; dt < 4; ++dt) OUT[dt] = OUT[dt] * g_cmp;
    const int cur = qpos >> 6;
    const int ctu = __builtin_amdgcn_readfirstlane(cur >> 2);
    {
        float prevx3 = 0.f;
#pragma unroll
        for (int kt = 0; kt < 16; ++kt) {
            if (kt > ctu) {
                const int blk = 4 * kt + fq; const float sc = blk >= nblk ? -3e38f : -1.0f;
                unsigned uk = ~__float_as_uint(sc);
                if (hh == 0) scoreL[qa * 64 + blk] = __uint_as_float((uk & ~63u) | (unsigned)(63 - blk));
                continue;
            }
            f32x4 x = lg[kt];
#pragma unroll
            for (int r = 0; r < 4; ++r) x[r] = quad_sum(x[r]);
            const u32x2s cd = __builtin_amdgcn_permlane16_swap(__float_as_uint(x[3]), __float_as_uint(x[3]), false, false);
            const u32x2s ef = __builtin_amdgcn_permlane32_swap(cd.y, cd.y, false, false);
            const float up = fq == 2 ? __uint_as_float(ef.x) : __uint_as_float(cd.x);
            const float pv = fq > 0 ? up : prevx3;
            prevx3 = __uint_as_float(ef.y);
            const float pslc = 2.0f * (x[0] + x[1] + x[2]) + x[3] + pv;
            const int blk = 4 * kt + fq;
            const bool forced = (blk == 0) | (blk == cur) | (blk == cur - 1);
            float sc = forced ? 1e4f : (blk <= cur ? pslc : -1.0f);
            if (blk >= nblk) sc = -3e38f;
            unsigned uk = __float_as_uint(sc); uk = (uk & 0x80000000u) ? ~uk : (uk | 0x80000000u);
            if (hh == 0) scoreL[qa * 64 + blk] = __uint_as_float((uk & ~63u) | (unsigned)(63 - blk));
        }
    }
    LDS_WAIT();
#pragma unroll
    for (int q = 0; q < 4; ++q) {
        const unsigned s = __float_as_uint(scoreL[q * 64 + lane]);
        int rank = 0;
#pragma unroll
        for (int p4 = 0; p4 < 16; ++p4) {
            if (p4 <= ctu) {
                const f32x4 v = *(const LAS f32x4*)(scoreL + q * 64 + 4 * p4);
#pragma unroll
                for (int e = 0; e < 4; ++e) rank += (__float_as_uint(v[e]) > s) ? 1 : 0;
            }
        }
        const int curq = (qpos0 + q) >> 6;
        const unsigned long long vm = curq >= 63 ? ~0ull : ((1ull << (curq + 1)) - 1ull);
        msel[q] = __ballot(rank < 16) & vm;
    }
    LDS_WAIT();
}
constexpr int AT_SCORE = 16 * BT_STRIDE * 4;
constexpr int AP_SCORE = 4 * BT_STRIDE * 4;
constexpr int AT_MASK = AP_SCORE + 8 * 1024;
constexpr int AT_LIST = AT_MASK + 512;
constexpr int AT_RING = 29696;
constexpr int AT_CMPK = AT_RING + 49152;
constexpr int AT_CMPV = AT_CMPK + 32768;
static_assert(AT_CMPV + 32768 <= LDS_BARW, "attention LDS map");
constexpr int AS_CMPK = 29696, AS_CMPV = AS_CMPK + 16384;
constexpr int AS_PART = AS_CMPK; static_assert(AS_PART + 8 * 2 * 18 * 64 * 4 <= LDS_BARW, "partials fit below the barrier words");
DI void attn_sample_item(CArgs& A, int item, LAS unsigned char* lds, int wave) {
    unsigned char* ws = A.ws;
    const int lane = lane_id(), tid = wave * 64 + lane, fr = lane & 15, fq = lane >> 4, qa = fr >> 2, hh = fr & 3;
    const int b = item >> 2, kvh = item & 3, tok0 = TP + 4 * b, qpos0 = 2048;
    LAS float* BT4 = (LAS float*)lds;
    LAS float* scoreL = (LAS float*)(lds + AP_SCORE);
    LAS unsigned long long* maskL = (LAS unsigned long long*)(lds + AT_MASK);
    LAS float* part = (LAS float*)(lds + AS_PART);
    const bf16_t* CK = (const bf16_t*)(ws + WS_CKS) + (size_t)(b * 4 + kvh) * 128 * 64;
    const bf16_t* CV = (const bf16_t*)(ws + WS_CVS) + (size_t)(b * 4 + kvh) * 64 * 128;
    const bf16_t* KS = (const bf16_t*)(ws + WS_KSELS) + (size_t)(b * 4 + kvh) * 33 * 4096;
    const bf16_t* VS = (const bf16_t*)(ws + WS_VSELS) + (size_t)(b * 4 + kvh) * 33 * 4096;
    const bf16_t* KW = (const bf16_t*)(ws + WS_KWINS) + ((ptrdiff_t)(b * 4 + kvh) * 9 - 24) * 4096;
    const bf16_t* VW = (const bf16_t*)(ws + WS_VWINS) + ((ptrdiff_t)(b * 4 + kvh) * 9 - 24) * 4096;
    {
        const float* btg = (const float*)(ws + WS_BT) + (size_t)(4 * kvh) * BT_STRIDE;
        for (int i = tid; i < 4 * BT_STRIDE; i += NTHR) BT4[i] = btg[i];
#pragma unroll
        for (int i = 0; i < 2; ++i) {
            const int c = tid + 512 * i, r = c >> 3, c8 = c & 7, d = c >> 4, cc = c & 15;
            *(LAS u32x4*)(lds + AS_CMPK + r * 128 + ((c8 ^ (r & 7)) << 4)) = *(const u32x4*)(CK + (size_t)r * 64 + c8 * 8);
            *(LAS u32x4*)(lds + AS_CMPV + d * 256 + ((cc ^ (d & 7)) << 4)) = *(const u32x4*)(CV + (size_t)d * 128 + cc * 8);
        }
    }
    __syncthreads();
    const int qpos = qpos0 + qa, qmax = qpos0 + 3, qmin = qpos0, hg = 4 * kvh + hh, tok = tok0 + qa;
    const LAS float* bth = BT4 + hh * BT_STRIDE + BT_OFF;
    const float biasfar = bth[1024];
    const bf16_t* QB = (const bf16_t*)(ws + WS_QB);
    bf16x8 Qf[2];
    Qf[0] = *(const bf16x8*)(QB + (size_t)tok * 1024 + hg * 64 + 8 * fq);
    Qf[1] = *(const bf16x8*)(QB + (size_t)tok * 1024 + hg * 64 + 32 + 8 * fq);
    AttnState stS, stW;
    stS.m = -1e30f; stS.l = 0.f; stW.m = -1e30f; stW.l = 0.f;
#pragma unroll
    for (int dt = 0; dt < 4; ++dt) { stS.o[dt] = (f32x4){0.f, 0.f, 0.f, 0.f}; stW.o[dt] = (f32x4){0.f, 0.f, 0.f, 0.f}; }
    f32x4 OUT[4];
#pragma unroll
    for (int dt = 0; dt < 4; ++dt) OUT[dt] = (f32x4){0.f, 0.f, 0.f, 0.f};
    const int wlo = (qmin - 511) >> 6, whi = qmax >> 6;
    if (wave == 0) {
        const float g_cmp = ((const float*)(ws + WS_GATES))[(size_t)tok * 48 + hg * 3];
        unsigned long long msel[4];
        cmp_branch<true>(CK, CV, lds + AS_CMPK, lds + AS_CMPV, 256, 128, 33, Qf, qpos, qpos0, g_cmp, bth, scoreL, lane, OUT, msel);
        if (lane < 4) maskL[lane] = lane == 0 ? msel[0] : lane == 1 ? msel[1] : lane == 2 ? msel[2] : msel[3];
    } else {
        for (int blk = wlo + wave - 1; blk <= whi; blk += 7) {
            const int dist0 = qpos - 64 * blk - 4 * fq;
            attend_block<1>(KW + (size_t)blk * 4096, VW + (size_t)blk * 4096, Qf, dist0, true, false, biasfar, bth + dist0, stW, fr, fq);
        }
    }
    __syncthreads();
    {
        const unsigned long long m0 = maskL[0], m1 = maskL[1], m2 = maskL[2], m3 = maskL[3];
        const unsigned long long mymask = qa == 0 ? m0 : qa == 1 ? m1 : qa == 2 ? m2 : m3;
        unsigned long long um = m0 | m1 | m2 | m3;
        int idx = 0;
        while (um) {
            const int blk = __builtin_ctzll(um); um &= um - 1ull;
            if ((idx & 7) == wave) {
                const int bpos = 64 * blk, dist0 = qpos - bpos - 4 * fq;
                const bool far = (qmin - bpos - 63) >= 1024;
                attend_block<0>(KS + (size_t)blk * 4096, VS + (size_t)blk * 4096, Qf, dist0, ((mymask >> blk) & 1ull) != 0ull, far, biasfar, bth + dist0, stS, fr, fq);
            }
            ++idx;
        }
    }
    {
        LAS float* ps = part + (size_t)((wave * 2 + 0) * 18) * 64 + lane; LAS float* pw = part + (size_t)((wave * 2 + 1) * 18) * 64 + lane;
        ps[0] = stS.m; ps[64] = stS.l; pw[0] = stW.m; pw[64] = stW.l;
#pragma unroll
        for (int dt = 0; dt < 4; ++dt)
#pragma unroll
            for (int r = 0; r < 4; ++r) { ps[(2 + dt * 4 + r) * 64] = stS.o[dt][r]; pw[(2 + dt * 4 + r) * 64] = stW.o[dt][r]; }
    }
    __syncthreads();
    if (wave == 0) {
        const float* gp = (const float*)(ws + WS_GATES) + (size_t)tok * 48 + hg * 3;
#pragma unroll
        for (int br = 0; br < 2; ++br) {
            float M = -1e30f;
#pragma unroll
            for (int w2 = 0; w2 < 8; ++w2) M = fmaxf(M, part[(size_t)((w2 * 2 + br) * 18) * 64 + lane]);
            float L = 0.f; f32x4 O[4];
#pragma unroll
            for (int dt = 0; dt < 4; ++dt) O[dt] = (f32x4){0.f, 0.f, 0.f, 0.f};
#pragma unroll
            for (int w2 = 0; w2 < 8; ++w2) {
                const LAS float* pp = part + (size_t)((w2 * 2 + br) * 18) * 64 + lane;
                const float sc = __expf(pp[0] - M);
                L += pp[64] * sc;
#pragma unroll
                for (int dt = 0; dt < 4; ++dt)
#pragma unroll
                    for (int r = 0; r < 4; ++r) O[dt][r] += pp[(2 + dt * 4 + r) * 64] * sc;
            }
            L = rows_sum(L);
            const float g = gp[1 + br] / fmaxf(L, 1e-30f);
#pragma unroll
            for (int dt = 0; dt < 4; ++dt) OUT[dt] += O[dt] * g;
        }
        bf16_t* op = (bf16_t*)(ws + WS_OB) + (size_t)tok * 1024 + hg * 64 + 4 * fq;
#pragma unroll
        for (int dt = 0; dt < 4; ++dt) { u32x2 w; w.x = pk2(OUT[dt].x, OUT[dt].y); w.y = pk2(OUT[dt].z, OUT[dt].w); *(u32x2*)(op + 16 * dt) = w; }
    }
    __syncthreads();
}
constexpr float LOG2E = 1.4426950408889634f;
template <int KIND, bool FAR>
DI void ring_pair_qk(const bf16x8 (&Kf)[4][2], const bf16x8 (&Qf)[2][2], const int (&dist0)[2], const bool (&colsel)[2], float biasfar, const LAS float* bth, AttnState (&st)[2], f32x4 (&lacc)[2], bf16x8 (&Pf)[2][2]) {
    f32x4 s[2][4];
#pragma unroll
    for (int kt = 0; kt < 4; ++kt)
#pragma unroll
        for (int g = 0; g < 2; ++g) { f32x4 z = {0.f, 0.f, 0.f, 0.f}; z = MFMA16(Kf[kt][0], Qf[g][0], z); z = MFMA16(Kf[kt][1], Qf[g][1], z); s[g][kt] = z; }
    float bm[2];
#pragma unroll
    for (int g = 0; g < 2; ++g) {
        if (!FAR) {
            const LAS float* bp = bth + dist0[g];
#pragma unroll
            for (int kt = 0; kt < 4; ++kt)
#pragma unroll
                for (int r = 0; r < 4; ++r) s[g][kt][r] += bp[-(16 * kt + r)];
        } else {
#pragma unroll
            for (int kt = 0; kt < 4; ++kt) s[g][kt] = s[g][kt] + biasfar;
        }
        if (KIND == 1 || KIND == 4) {
#pragma unroll
            for (int kt = 0; kt < 4; ++kt)
#pragma unroll
                for (int r = 0; r < 4; ++r) s[g][kt][r] = (dist0[g] - 16 * kt - r >= 0) ? s[g][kt][r] : -1e30f;
        } else if (KIND == 3) {
#pragma unroll
            for (int kt = 0; kt < 4; ++kt)
#pragma unroll
                for (int r = 0; r < 4; ++r) s[g][kt][r] = (dist0[g] - 16 * kt - r < 512) ? s[g][kt][r] : -1e30f;
        }
        const float t0 = max3f(s[g][0][0], s[g][0][1], s[g][0][2]), t1 = max3f(s[g][0][3], s[g][1][0], s[g][1][1]), t2 = max3f(s[g][1][2], s[g][1][3], s[g][2][0]);
        const float t3 = max3f(s[g][2][1], s[g][2][2], s[g][2][3]), t4 = max3f(s[g][3][0], s[g][3][1], s[g][3][2]);
        float b = max3f(max3f(t0, t1, t2), max3f(t3, t4, s[g][3][3]), -1e30f);
        if (KIND < 2) b = colsel[g] ? b : -1e30f;
        bm[g] = b;
    }
#pragma unroll
    for (int g = 0; g < 2; ++g) bm[g] = rows_max(bm[g]);
#pragma unroll
    for (int g = 0; g < 2; ++g) {
        const float mn = max3f(st[g].m, bm[g], -1e20f);
        const float alpha = __builtin_amdgcn_exp2f((st[g].m - mn) * LOG2E);
        st[g].m = mn;
        float nm = -mn * LOG2E;
        if (KIND < 2) nm = colsel[g] ? nm : -1e30f;
#pragma unroll
        for (int kt = 0; kt < 4; ++kt) {
            const f32x4 e = s[g][kt] * LOG2E + nm;
#pragma unroll
            for (int r = 0; r < 4; ++r) s[g][kt][r] = __builtin_amdgcn_exp2f(e[r]);
        }
        Pf[g][0] = pack8(s[g][0], s[g][1]); Pf[g][1] = pack8(s[g][2], s[g][3]);
        lacc[g] = lacc[g] * alpha;
#pragma unroll
        for (int dt = 0; dt < 4; ++dt) st[g].o[dt] = st[g].o[dt] * alpha;
    }
}
DI void attn_prompt_item(CArgs& A, int b, int kvh, int qt, LAS unsigned char* lds, int tid_in, int wave, int lane_in) {
    unsigned char* ws = A.ws;
    const int lane = lane_id(), tid = wave * 64 + lane; (void)lane_in; (void)tid_in;
    const int fr = lane & 15, fq = lane >> 4, qa = fr >> 2, hh = fr & 3, hg = 4 * kvh + hh;
    LAS float* BT4 = (LAS float*)lds;
    LAS float* scoreL = (LAS float*)(lds + AP_SCORE + wave * 1024);
    LAS unsigned long long* maskL = (LAS unsigned long long*)(lds + AT_MASK);
    LAS int* listL = (LAS int*)(lds + AT_LIST);
    const bf16_t* CK = (const bf16_t*)(ws + WS_CKP) + (size_t)(b * 4 + kvh) * 256 * 64;
    const bf16_t* CV = (const bf16_t*)(ws + WS_CVP) + (size_t)(b * 4 + kvh) * 64 * 256;
    const bf16_t* KS = (const bf16_t*)(ws + WS_KSELP) + (size_t)(b * 4 + kvh) * 64 * 4096;
    const bf16_t* VS = (const bf16_t*)(ws + WS_VSELP) + (size_t)(b * 4 + kvh) * 64 * 4096;
    const bf16_t* KW = (const bf16_t*)(ws + WS_KWINP) + (size_t)(b * 4 + kvh) * 64 * 4096;
    const bf16_t* VW = (const bf16_t*)(ws + WS_VWINP) + (size_t)(b * 4 + kvh) * 64 * 4096;
    const bf16_t* QB = (const bf16_t*)(ws + WS_QB);
    bf16x8 Qf[2][2]; float g_cmpv[2], g_sel[2], g_win[2]; int qposg[2];
#pragma unroll
    for (int g = 0; g < 2; ++g) {
        const int qpos = 64 * qt + 8 * wave + 4 * g + qa, tok = b * 4096 + qpos;
        qposg[g] = qpos;
        Qf[g][0] = *(const bf16x8*)(QB + (size_t)tok * 1024 + hg * 64 + 8 * fq);
        Qf[g][1] = *(const bf16x8*)(QB + (size_t)tok * 1024 + hg * 64 + 32 + 8 * fq);
        const float* gp = (const float*)(ws + WS_GATES) + (size_t)tok * 48 + hg * 3;
        g_cmpv[g] = gp[0]; g_sel[g] = gp[1]; g_win[g] = gp[2];
    }
    {
        const float* btg = (const float*)(ws + WS_BT) + (size_t)(4 * kvh) * BT_STRIDE;
        for (int i = tid; i < 4 * BT_STRIDE; i += NTHR) BT4[i] = btg[i];
        const int ncv_t = 4 * qt + 3, ntl = (((ncv_t + 15) >> 4) + 1) & ~1;
        for (int c = tid; c < ntl * 128; c += NTHR) {
            const int r = c >> 3, c8 = c & 7;
            *(LAS u32x4*)(lds + AT_CMPK + r * 128 + ((c8 ^ (r & 7)) << 4)) = *(const u32x4*)(CK + (size_t)r * 64 + c8 * 8);
            const int d = c / (2 * ntl), cc = c - d * (2 * ntl);
            *(LAS u32x4*)(lds + AT_CMPV + d * 512 + ((cc ^ (d & 7)) << 4)) = *(const u32x4*)(CV + (size_t)d * 256 + cc * 8);
        }
    }
    __syncthreads();
    const LAS float* bth = BT4 + hh * BT_STRIDE + BT_OFF;
    const float biasfar = bth[1024];
    f32x4 OUT[2][4]; unsigned long long mymask[2], gmask[2];
    const int srow = tid >> 3, schunk = tid & 7;
    const int gch = (srow << 3) + (schunk ^ (srow & 7));
    { LAS unsigned char* bb0 = lds + AT_RING + wave * 1024;
      __builtin_amdgcn_global_load_lds((const unsigned*)(KS + gch * 8), (LAS unsigned*)bb0, 16, 0, 0);
      __builtin_amdgcn_global_load_lds((const unsigned*)(VS + gch * 8), (LAS unsigned*)(bb0 + 8192), 16, 0, 0); }
#pragma unroll
    for (int g = 0; g < 2; ++g) {
        const int qpos0 = 64 * qt + 8 * wave + 4 * g, qpos = qposg[g];
        const float g_cmp = g_cmpv[g];
        unsigned long long msel[4];
        cmp_branch<true>(CK, CV, lds + AT_CMPK, lds + AT_CMPV, 512, 256, 64, Qf[g], qpos, qpos0, g_cmp, bth, scoreL, lane, OUT[g], msel);
        mymask[g] = qa == 0 ? msel[0] : qa == 1 ? msel[1] : qa == 2 ? msel[2] : msel[3];
        gmask[g] = msel[0] | msel[1] | msel[2] | msel[3];
    }
    if (lane == 0) maskL[wave] = gmask[0] | gmask[1];
    __syncthreads();
    unsigned long long U = 0ull;
#pragma unroll
    for (int w2 = 0; w2 < 8; ++w2) U |= maskL[w2];
    const int nsel = __builtin_popcountll(U);
    const int wlo = qt >= 8 ? qt - 8 : 0, nwin = qt - wlo + 1, nst = ((A.dup_mask >> 29) & 1u) ? 2 : nsel + nwin;
    if (wave == 0) {
        if ((U >> lane) & 1ull) listL[__builtin_popcountll(U & ((1ull << lane) - 1ull))] = lane;
        if (lane < nwin) listL[nsel + lane] = 64 + wlo + lane;
    }
    __syncthreads();
#define LIST_E(si_) __builtin_amdgcn_readfirstlane(listL[si_])
#define RING_DMA(si_, slot_) do { const int e_ = LIST_E(si_); const bf16_t* kb_ = ((e_ >= 64) ? KW : KS) + (size_t)(e_ & 63) * 4096; const bf16_t* vb_ = ((e_ >= 64) ? VW : VS) + (size_t)(e_ & 63) * 4096; \
        LAS unsigned char* bb_ = lds + AT_RING + (slot_) * 16384 + wave * 1024; \
        __builtin_amdgcn_global_load_lds((const unsigned*)(kb_ + gch * 8), (LAS unsigned*)bb_, 16, 0, 0); \
        __builtin_amdgcn_global_load_lds((const unsigned*)(vb_ + gch * 8), (LAS unsigned*)(bb_ + 8192), 16, 0, 0); } while (0)
    asm volatile("s_waitcnt vmcnt(0)" ::: "memory");
    RING_DMA(1, 1);
    AttnState st[2]; f32x4 lacc[2];
    bf16x8 ONESf;
#pragma unroll
    for (int jj = 0; jj < 8; ++jj) ONESf[jj] = (fr == 0) ? (short)0x3F80 : (short)0;
#pragma unroll
    for (int g = 0; g < 2; ++g) { st[g].m = -1e30f; st[g].l = 0.f; lacc[g] = (f32x4){0.f, 0.f, 0.f, 0.f};
#pragma unroll
        for (int dt = 0; dt < 4; ++dt) st[g].o[dt] = (f32x4){0.f, 0.f, 0.f, 0.f}; }
    int slot = 0;
#pragma unroll 1
    for (int si = 0; si < nst; ++si) {
        if (si + 1 < nst) asm volatile("s_waitcnt vmcnt(2)" ::: "memory"); else asm volatile("s_waitcnt vmcnt(0)" ::: "memory");
        asm volatile("s_waitcnt lgkmcnt(0)" ::: "memory"); __builtin_amdgcn_s_barrier(); asm volatile("" ::: "memory");
        if (si + 2 < nst) { const int ns = slot == 0 ? 2 : slot - 1; RING_DMA(si + 2, ns); }
        if (si == nsel) {
#pragma unroll
            for (int g = 0; g < 2; ++g) {
                const float l = __shfl(lacc[g][0], fr);
                const float sc = g_sel[g] / fmaxf(l, 1e-30f);
#pragma unroll
                for (int dt = 0; dt < 4; ++dt) { OUT[g][dt] += st[g].o[dt] * sc; st[g].o[dt] = (f32x4){0.f, 0.f, 0.f, 0.f}; }
                st[g].m = -1e30f; lacc[g] = (f32x4){0.f, 0.f, 0.f, 0.f};
            }
        }
        const int e = listL[si]; const int blk = e & 63; const bool win = e >= 64;
        const bool a0 = win || ((gmask[0] >> blk) & 1ull), a1 = win || ((gmask[1] >> blk) & 1ull);
        if (a0 || a1) {
            const LAS unsigned char* kb = lds + AT_RING + slot * 16384; const LAS unsigned char* vb = kb + 8192;
            bf16x8 Kf[4][2];
#pragma unroll
            for (int t = 0; t < 4; ++t)
#pragma unroll
                for (int k2 = 0; k2 < 2; ++k2) { const int row = 16 * t + fr; Kf[t][k2] = *(const LAS bf16x8*)(kb + row * 128 + (((fq + 4 * k2) ^ (row & 7)) << 4)); }
            const int kind = win ? (blk == qt ? 4 : (blk == qt - 8 ? 3 : 2)) : (blk == qt ? 1 : 0);
            const bool far = !win && (qt - blk >= 17);
            bf16x8 Pf[2][2];
            const int dist0[2] = {qposg[0] - 64 * blk - 4 * fq, qposg[1] - 64 * blk - 4 * fq};
            const bool colsel[2] = {((mymask[0] >> blk) & 1ull) != 0ull, ((mymask[1] >> blk) & 1ull) != 0ull};
            if (win) {
                if (kind == 4) ring_pair_qk<4, false>(Kf, Qf, dist0, colsel, biasfar, bth, st, lacc, Pf);
                else if (kind == 3) ring_pair_qk<3, false>(Kf, Qf, dist0, colsel, biasfar, bth, st, lacc, Pf);
                else ring_pair_qk<2, false>(Kf, Qf, dist0, colsel, biasfar, bth, st, lacc, Pf);
            } else {
                if (kind == 1) ring_pair_qk<1, false>(Kf, Qf, dist0, colsel, biasfar, bth, st, lacc, Pf);
                else if (far) ring_pair_qk<0, true>(Kf, Qf, dist0, colsel, biasfar, bth, st, lacc, Pf);
                else ring_pair_qk<0, false>(Kf, Qf, dist0, colsel, biasfar, bth, st, lacc, Pf);
            }
#pragma unroll
            for (int dt = 0; dt < 4; ++dt) {
                const int row = 16 * dt + fr;
                const bf16x8 v0 = *(const LAS bf16x8*)(vb + row * 128 + ((fq ^ (row & 7)) << 4)), v1 = *(const LAS bf16x8*)(vb + row * 128 + (((fq + 4) ^ (row & 7)) << 4));
                { f32x4 c = st[0].o[dt]; c = MFMA16(v0, Pf[0][0], c); c = MFMA16(v1, Pf[0][1], c); st[0].o[dt] = c; }
                { f32x4 c = st[1].o[dt]; c = MFMA16(v0, Pf[1][0], c); c = MFMA16(v1, Pf[1][1], c); st[1].o[dt] = c; }
            }
#pragma unroll
            for (int g = 0; g < 2; ++g) { f32x4 c = lacc[g]; c = MFMA16(ONESf, Pf[g][0], c); c = MFMA16(ONESf, Pf[g][1], c); lacc[g] = c; }
        }
        slot = slot == 2 ? 0 : slot + 1;
    }
#pragma unroll
    for (int g = 0; g < 2; ++g) {
        const float l = __shfl(lacc[g][0], fr);
        const float sc = g_win[g] / fmaxf(l, 1e-30f);
        bf16_t* op = (bf16_t*)(ws + WS_OB) + (size_t)(b * 4096 + qposg[g]) * 1024 + hg * 64 + 4 * fq;
#pragma unroll
        for (int dt = 0; dt < 4; ++dt) { const f32x4 o = OUT[g][dt] + st[g].o[dt] * sc; u32x2 w; w.x = pk2(o.x, o.y); w.y = pk2(o.z, o.w); *(u32x2*)(op + 16 * dt) = w; }
    }
    __syncthreads();
#undef LIST_E
#undef RING_DMA
}
DI void phase_attn(CArgs& A, LAS unsigned char* lds, int tid, int wave, int lane) {
    unsigned char* ws = A.ws;
    if (!(A.dup_mask >> 31))
    for (int t = blockIdx.x; t < 1024; t += gridDim.x) {
        const int i = t & 255, r = t >> 8, bk = i & 15, j = i >> 4;
        const int qt = r == 0 ? 63 - j : r == 1 ? 47 - j : r == 2 ? 16 + j : j;
        attn_prompt_item(A, bk >> 2, bk & 3, qt, lds, tid, wave, lane);
    }
    if (!((A.dup_mask >> 30) & 1u))
    for (int it = blockIdx.x; it < 512; it += gridDim.x) attn_sample_item(A, it, lds, wave);
}
DI void phase_final(CArgs& A, int wave, int lane) {
    unsigned char* ws = A.ws;
    const int gw = blockIdx.x * NWAVES + wave, NGW = gridDim.x * NWAVES;
    const float* nw = IN_F(I_NFIN);
    f32x4 w4[4];
#pragma unroll
    for (int j = 0; j < 4; ++j) w4[j] = *((const f32x4*)nw + lane + 64 * j);
    for (int m = gw; m < TT; m += NGW) {
        const u32x2* xr = (const u32x2*)((const bf16_t*)(ws + WS_XB) + (size_t)m * D) + lane; f32x4 v[4]; float s = 0.f;
#pragma unroll
        for (int j = 0; j < 4; ++j) { const u32x2 b2 = xr[64 * j]; v[j] = (f32x4){bflo(b2.x), bfhi(b2.x), bflo(b2.y), bfhi(b2.y)}; s += (v[j].x * v[j].x + v[j].y * v[j].y) + (v[j].z * v[j].z + v[j].w * v[j].w); }
        s = wave_sum(s);
        const float rs = rsqrtf(s * (1.0f / 1024.0f) + EPS);
        f32x4* o = (f32x4*)(A.out + O_Y + (size_t)m * D) + lane;
#pragma unroll
        for (int j = 0; j < 4; ++j) o[64 * j] = v[j] * rs * w4[j];
    }
}
DI void sample_gemm_res(const bf16_t* Aop, const bf16_t* Bt, int K, const float* xs, const bf16_t* XBr, float* Xw_unused, bf16_t* XB, float* stats, int first, LAS unsigned char* lds, int wave) {
    const int lane = lane_id(), fr = lane & 15, fq = lane >> 4;
    LAS f32x4* part = (LAS f32x4*)lds;
    LAS float* red = (LAS float*)(lds + 65536);
    const int kw = K >> 3, nks = kw >> 5;
    for (int t = blockIdx.x; t < 256; t += gridDim.x) {
        const int rt = t >> 4, ct = t & 15;
        const bf16_t* ap = Aop + (size_t)(TP + 32 * rt + fr) * K + wave * kw + 8 * fq;
        const bf16_t* bp = Bt + (size_t)(64 * ct + fr) * K + wave * kw + 8 * fq;
        f32x4 acc[2][4];
#pragma unroll
        for (int m = 0; m < 2; ++m)
#pragma unroll
            for (int n = 0; n < 4; ++n) acc[m][n] = (f32x4){0.f, 0.f, 0.f, 0.f};
#pragma unroll 1
        for (int k0 = 0; k0 < nks; k0 += 4) {
            bf16x8 a[4][2], b[4][4];
#pragma unroll
            for (int j = 0; j < 4; ++j) {
                const int kk = (k0 + j < nks ? k0 + j : nks - 1) * 32;
#pragma unroll
                for (int m = 0; m < 2; ++m) a[j][m] = *(const bf16x8*)(ap + (size_t)(16 * m) * K + kk);
#pragma unroll
                for (int n = 0; n < 4; ++n) b[j][n] = *(const bf16x8*)(bp + (size_t)(16 * n) * K + kk);
            }
#pragma unroll
            for (int j = 0; j < 4; ++j) {
                if (k0 + j < nks) {
#pragma unroll
                    for (int m = 0; m < 2; ++m)
#pragma unroll
                        for (int n = 0; n < 4; ++n) acc[m][n] = MFMA16(b[j][n], a[j][m], acc[m][n]);
                }
            }
        }
#pragma unroll
        for (int m = 0; m < 2; ++m)
#pragma unroll
            for (int n = 0; n < 4; ++n) part[(wave * 8 + m * 4 + n) * 64 + lane] = acc[m][n];
        __syncthreads();
        const int mr = wave >> 2, nc = wave & 3;
        f32x4 sum = part[(0 * 8 + wave) * 64 + lane];
#pragma unroll
        for (int w2 = 1; w2 < 8; ++w2) sum += part[(w2 * 8 + wave) * 64 + lane];
        const int row = TP + 32 * rt + 16 * mr + fr, col = 64 * ct + 16 * nc + 4 * fq;
        f32x4 base;
        if (first) base = *(const f32x4*)(xs + (size_t)(row - TP) * D + col);
        else { const u32x2 b2 = *(const u32x2*)(XBr + (size_t)row * D + col); base = (f32x4){bflo(b2.x), bfhi(b2.x), bflo(b2.y), bfhi(b2.y)}; }
        const f32x4 o = base + sum;
        u32x2 w; w.x = pk2(o.x, o.y); w.y = pk2(o.z, o.w);
        *(u32x2*)(XB + (size_t)row * D + col) = w;
        float ss = (o.x * o.x + o.y * o.y) + (o.z * o.z + o.w * o.w);
        ss = rows_sum(ss);
        if (fq == 0) red[wave * 16 + fr] = ss;
        __syncthreads();
        if (nc == 0 && fq == 0) stats[(size_t)row * 16 + ct] = (red[(4 * mr + 0) * 16 + fr] + red[(4 * mr + 1) * 16 + fr]) + (red[(4 * mr + 2) * 16 + fr] + red[(4 * mr + 3) * 16 + fr]);
        __syncthreads();
    }
}
constexpr int NPH = 30;
__global__ void __launch_bounds__(NTHR, 2) mk_fwd(Args A_) {
    CArgs& A = *(CArgs*)__builtin_amdgcn_kernarg_segment_ptr();
    extern __shared__ __attribute__((aligned(16))) unsigned char lds_raw[];
    LAS unsigned char* lds = (LAS unsigned char*)lds_raw;
    const int wave0 = __builtin_amdgcn_readfirstlane((int)threadIdx.x >> 6);
    const int lane = lane_id(), wave = wave0, tid = wave0 * 64 + lane;
    unsigned char* ws = A.ws;
    volatile LAS unsigned* bw = (volatile LAS unsigned*)(lds + LDS_BARW);
    if (tid == 0) { bw[0] = 0u; bw[1] = 0u; bw[2] = 0u; bw[3] = 0u; }
    __syncthreads();
#if MK_PER_PHASE
    XcdBarrier bar; bar.w0 = 0; bar.bar = (unsigned*)(ws + WS_CTL); bar.x = 0; bar.st = bw;
#else
    XcdBarrier bar = xcd_barrier_post((unsigned*)(ws + WS_CTL), bw, (unsigned)wave0);
#endif
    const int lo = A.ph_lo, hi = A.ph_hi;
#define RUN(k) (lo <= (k) && (k) < hi)
#define REP(k) _Pragma("unroll 1") for (int rep_ = 0, nrep_ = 1 + (int)((A.dup_mask >> (k)) & 1u); rep_ < nrep_; ++rep_, __syncthreads()) { int tidr_ = wave0 * 64 + lane_id(); asm volatile("" : "+v"(tidr_)); const int tid = tidr_, lane = tid & 63, wave = wave0; (void)tid; (void)lane; (void)wave;
#define REPE }
#define FRESH { int tidr_ = wave0 * 64 + lane_id(); asm volatile("" : "+v"(tidr_)); const int tid = tidr_, lane = tid & 63, wave = wave0; (void)tid; (void)lane; (void)wave;
#define FRESHE }
#if MK_PER_PHASE
#define SEAM(k) do { } while (0)
#else
#define SEAM(k) do { if ((k) + 1 < hi) xcd_barrier(bar); } while (0)
#endif

    if (RUN(0)) { REP(0) phase_p0(A, lds, tid, wave, lane); REPE SEAM(0); }
#pragma unroll 1
    for (int l = 0; l < 4; ++l) {
        unsigned char* ws = A.ws; asm volatile("" : "+s"(ws));
        float* stats = (float*)(ws + WS_STATS); bf16_t* XB = (bf16_t*)(ws + WS_XB); bf16_t* OB = (bf16_t*)(ws + WS_OB); float* X = (float*)(ws + WS_X);
        int bx = blockIdx.x; asm volatile("" : "+s"(bx));
        const int pb = l < 2 ? 1 + 8 * l : 19 + 5 * (l - 2);
        if (l < 2) {
            if (RUN(pb)) {
                pg8::Gemm g{XB, (const bf16_t*)(ws + WS_WDNIN + l * SZ_WDNIN), TT, N_DNIN, D};
                pg8::StaticOrder S; S.init(TT, N_DNIN, gridDim.x, bx);
                EpiDnIn E{stats, (bf16_t*)(ws + WS_QKVB), (bf16_t*)(ws + WS_ZB), (float*)(ws + WS_AB)};
                REP(pb) pg8::gemm_phase<EpiDnIn, pg8::StaticOrder>(lds, g, S, E, nullptr, wave); REPE
                SEAM(pb);
            }
            if (RUN(pb + 1)) { REP(pb + 1) phase_d2(A, l, wave, lane); REPE SEAM(pb + 1); }
            if (RUN(pb + 2)) { REP(pb + 2) phase_d3(A, lds, wave, lane); REPE SEAM(pb + 2); }
            if (RUN(pb + 3)) { REP(pb + 3) phase_d4(A, l, lds, tid, wave, lane); REPE SEAM(pb + 3); }
            if (RUN(pb + 4)) { FRESH phase_d5(A, l, wave, lane); FRESHE SEAM(pb + 4); }
        } else {
            if (RUN(pb)) {
                pg8::Gemm g{XB, (const bf16_t*)(ws + WS_WNSAIN + (l - 2) * SZ_WNSAIN), TT, N_NSAIN, D};
                pg8::StaticOrder S; S.init(TT, N_NSAIN, gridDim.x, bx);
                const int early = gridDim.x == 256 ? NSA2_EARLY : 0;
                if (l == 2) S.slice(early, S.nwg);
                EpiNsaIn E{stats, (bf16_t*)(ws + WS_QB), (float*)(ws + WS_GATES)};
                REP(pb) pg8::gemm_phase<EpiNsaIn, pg8::StaticOrder>(lds, g, S, E, nullptr, wave); REPE
                if (l == 2) { __syncthreads(); const int nb1 = (330 - early) < (int)gridDim.x ? 330 - early : 330 % (int)gridDim.x; phase_n1(A, lds, wave0 * 64 + lane_id(), bx >= nb1 ? bx - nb1 : -1, (int)gridDim.x - nb1); }
                SEAM(pb);
            }
            if (RUN(pb + 1)) { REP(pb + 1) phase_attn(A, lds, tid, wave, lane); REPE SEAM(pb + 1); }
        }
        const int pm = l < 2 ? pb + 5 : pb + 2;
        if (RUN(pm)) {
            const bf16_t* wt = (const bf16_t*)(ws + (l < 2 ? WS_WDNOUT + l * SZ_WSQ : WS_WNSAOUT + (l - 2) * SZ_WSQ));
            pg8::Gemm g{OB, wt, TP, D, D};
            pg8::StaticOrder S; S.init(TP, D, gridDim.x, bx);
#if MK_PROBE & 1
            { EpiRes Ed{IN_F(I_XP), IN_F(I_XS), X, XB, stats, l == 0 ? 1 : 0, (float*)(ws + WS_QKVB), (bf16_t*)(ws + WS_QN), (float*)(ws + WS_GATES)};
              pg8::gemm_phase<EpiRes, pg8::StaticOrder>(lds, g, S, Ed, nullptr, wave0);
              sample_gemm_res(OB, wt, D, IN_F(I_XS), XB, (float*)(ws + WS_QKVB), (bf16_t*)(ws + WS_QN), (float*)(ws + WS_GATES), l == 0 ? 1 : 0, lds, wave0); __syncthreads(); }
#endif
            EpiRes E{IN_F(I_XP), IN_F(I_XS), X, XB, stats, l == 0 ? 1 : 0, X, XB, stats};
            pg8::gemm_phase<EpiRes, pg8::StaticOrder>(lds, g, S, E, nullptr, wave0);
            sample_gemm_res(OB, wt, D, IN_F(I_XS), XB, X, XB, stats, l == 0 ? 1 : 0, lds, wave0);
            SEAM(pm);
        }
        if (RUN(pm + 1)) {
            pg8::Gemm g{XB, (const bf16_t*)(ws + WS_WFFNIN + l * SZ_WFFNIN), TT, 2 * DFF, D};
            pg8::StaticOrder S; S.init(TT, 2 * DFF, gridDim.x, bx);
            EpiFfnIn E{stats, (bf16_t*)(ws + WS_ACT)};
            REP(pm + 1) pg8::gemm_phase<EpiFfnIn, pg8::StaticOrder>(lds, g, S, E, nullptr, wave); REPE
            SEAM(pm + 1);
        }
        if (RUN(pm + 2)) {
            const bf16_t* wt = (const bf16_t*)(ws + WS_WFFNOUT + l * SZ_WFFNOUT);
            pg8::Gemm g{(const bf16_t*)(ws + WS_ACT), wt, TP, D, DFF};
            pg8::StaticOrder S; S.init(TP, D, gridDim.x, bx);
#if MK_PROBE & 1
            { EpiRes Ed{IN_F(I_XP), IN_F(I_XS), X, XB, stats, 0, (float*)(ws + WS_QKVB), (bf16_t*)(ws + WS_QN), (float*)(ws + WS_GATES)};
              pg8::gemm_phase<EpiRes, pg8::StaticOrder>(lds, g, S, Ed, nullptr, wave0);
              sample_gemm_res((const bf16_t*)(ws + WS_ACT), wt, DFF, IN_F(I_XS), XB, (float*)(ws + WS_QKVB), (bf16_t*)(ws + WS_QN), (float*)(ws + WS_GATES), 0, lds, wave0); __syncthreads(); }
#endif
            EpiRes E{IN_F(I_XP), IN_F(I_XS), X, XB, stats, 0, X, XB, stats};
            pg8::gemm_phase<EpiRes, pg8::StaticOrder>(lds, g, S, E, nullptr, wave0);
            sample_gemm_res((const bf16_t*)(ws + WS_ACT), wt, DFF, IN_F(I_XS), XB, X, XB, stats, 0, lds, wave0);
            SEAM(pm + 2);
        }
        if (l == 1) {
            if (RUN(17)) {
                pg8::Gemm g{XB, (const bf16_t*)(ws + WS_WKV), TT, N_KV, D};
                pg8::StaticOrder S; S.init(TT, N_KV, gridDim.x, bx);
                EpiKV E{stats, A.out, ws};
                REP(17) pg8::gemm_phase<EpiKV, pg8::StaticOrder>(lds, g, S, E, nullptr, wave);
                    if (gridDim.x == 256 && bx >= 256 - NSA2_EARLY) {
                        pg8::Gemm g2{XB, (const bf16_t*)(ws + WS_WNSAIN), TT, N_NSAIN, D};
                        pg8::StaticOrder S2; S2.init(TT, N_NSAIN, NSA2_EARLY, bx - (256 - NSA2_EARLY)); S2.slice(0, NSA2_EARLY);
                        EpiNsaIn E2{stats, (bf16_t*)(ws + WS_QB), (float*)(ws + WS_GATES)};
                        __syncthreads();
                        pg8::gemm_phase<EpiNsaIn, pg8::StaticOrder>(lds, g2, S2, E2, nullptr, wave);
                    }
                REPE
                SEAM(17);
            }
        }
    }
    if (RUN(29)) {
        int tid_f = wave0 * 64 + lane_id(); asm volatile("" : "+v"(tid_f));
        phase_final(A, __builtin_amdgcn_readfirstlane(tid_f >> 6), tid_f & 63);
#if MK_PROBE & 4
        asm volatile("" ::: "memory"); phase_final(A, __builtin_amdgcn_readfirstlane(tid_f >> 6), tid_f & 63);
#endif
    }
#undef RUN
#undef REP
#undef REPE
#undef FRESH
#undef FRESHE
#undef SEAM
}

extern "C" void kernel_launch(void* const* d_in, const int* in_sizes, int n_in, void* d_out, int out_size, void* d_ws, size_t ws_size, hipStream_t stream) {
    static int grid = 0;
    if (grid == 0) {
        if (n_in != 25 || ws_size < WS_END) { fprintf(stderr, "kernel_launch: expected 25 inputs and >= %zu bytes of workspace (got %d, %zu)\n", (size_t)WS_END, n_in, ws_size); grid = -1; return; }
        int dev = 0, cus = 0, per_cu = 0;
        if (hipGetDevice(&dev) != hipSuccess || hipDeviceGetAttribute(&cus, hipDeviceAttributeMultiprocessorCount, dev) != hipSuccess) { grid = -1; return; }
        if (hipFuncSetAttribute((const void*)mk_fwd, hipFuncAttributeMaxDynamicSharedMemorySize, LDS_BYTES) != hipSuccess) { fprintf(stderr, "kernel_launch: hipFuncSetAttribute failed\n"); grid = -1; return; }
        if (hipOccupancyMaxActiveBlocksPerMultiprocessor(&per_cu, (const void*)mk_fwd, NTHR, LDS_BYTES) != hipSuccess || per_cu < 1)
            fprintf(stderr, "kernel_launch: occupancy query reports %d workgroups per CU\n", per_cu);
        (void)hipGetLastError();
        grid = cus > 0 ? cus : 256;
    }
    if (grid < 0) return;
    if (hipMemsetAsync((char*)d_ws + WS_CTL, 0, 65536, stream) != hipSuccess) { fprintf(stderr, "kernel_launch: memset failed\n"); return; }
    Args a{};
    for (int i = 0; i < 25; ++i) a.in[i] = d_in[i];
    a.out = (float*)d_out; a.ws = (unsigned char*)d_ws; a.dup_mask = MK_DUP_MASK; a.pad = 0u;
#if MK_PER_PHASE
    for (int k = 0; k < NPH; ++k) { a.ph_lo = k; a.ph_hi = k + 1; hipLaunchKernelGGL(mk_fwd, dim3(grid), dim3(NTHR), LDS_BYTES, stream, a); }
#else
    a.ph_lo = 0; a.ph_hi = NPH;
    hipLaunchKernelGGL(mk_fwd, dim3(grid), dim3(NTHR), LDS_BYTES, stream, a);
#if MK_XTRA_PH >= 0
    a.ph_lo = MK_XTRA_PH; a.ph_hi = MK_XTRA_PH + 1; a.dup_mask = MK_XTRA_MASK;
    hipLaunchKernelGGL(mk_fwd, dim3(grid), dim3(NTHR), LDS_BYTES, stream, a);
#endif
#endif
    const hipError_t le = hipPeekAtLastError();
    if (le != hipSuccess) fprintf(stderr, "kernel_launch: launch failed: %s\n", hipGetErrorName(le));
}
```
